# Optimizing an MI355X kernel written in HIP

```python
import math
import jax, jax.numpy as jnp
from jax import lax
import numpy as np

D_MODEL = 1024
BATCH = 32
SEQ = 256
DEPTH = 2
DEC_BATCH = 8
DEC_SEQ = 2048
PAST_LEN = 512

GRID_W = 64
EPS = 1e-6
QBLK = 128
ROPE_THETA = 10000.0

D_RNN = 512
RNN_BLOCKS = 8
RNN_BLK = D_RNN // RNN_BLOCKS
CONV_W = 4
CONV_PAD_L = 2
CONV_PAD_R = CONV_W - 1 - CONV_PAD_L
RG_C = 8.0

MLA_H = 8
MLA_NOPE = 64
MLA_ROPE = 32
MLA_V = 64
Q_RANK = 384
KV_RANK = 256
MLA_SCALE = (MLA_NOPE + MLA_ROPE) ** -0.5

DIFF_H = 4
DIFF_DK = 64
DIFF_DV = 2 * DIFF_DK
DIFF_SCALE = DIFF_DK ** -0.5

N_BRANCH = 3

IN_SPLITS = (D_RNN, D_RNN,
             Q_RANK, KV_RANK, MLA_ROPE, MLA_H * MLA_V,
             DIFF_H * 2 * DIFF_DK, DIFF_H * 2 * DIFF_DK,
             DIFF_H * DIFF_DV, DIFF_H * DIFF_DV,
             N_BRANCH * D_MODEL)
IN_COLS = sum(IN_SPLITS)

kernel_name = 'hybrid_diffusion_rglru_mla_diffattn_step'


def _rmsnorm(x, g):
    xf = x.astype(jnp.float32)
    y = xf * lax.rsqrt(jnp.mean(xf * xf, axis=-1, keepdims=True) + EPS)
    return (y * g.astype(jnp.float32)).astype(x.dtype)


def _split_cols(z):
    offs = np.cumsum(IN_SPLITS)[:-1].tolist()
    return jnp.split(z, offs, axis=-1)


def _rope_1d(x, pos):
    half = x.shape[-1] // 2
    inv = ROPE_THETA ** (-jnp.arange(half, dtype=jnp.float32) / half)
    ang = pos.astype(jnp.float32)[:, None] * inv[None, :]
    cos = jnp.cos(ang)[:, None, :]
    sin = jnp.sin(ang)[:, None, :]
    xf = x.astype(jnp.float32)
    x1, x2 = xf[..., :half], xf[..., half:]
    return jnp.concatenate([x1 * cos - x2 * sin, x1 * sin + x2 * cos], axis=-1).astype(x.dtype)


def _rope_2d(x, pos_row, pos_col):
    d = x.shape[-1] // 2
    return jnp.concatenate([_rope_1d(x[..., :d], pos_row), _rope_1d(x[..., d:], pos_col)], axis=-1)


def _dwconv(x, w, b):
    s = x.shape[1]
    xp = jnp.pad(x, ((0, 0), (CONV_PAD_L, CONV_PAD_R), (0, 0)))
    y = xp[:, 0:s] * w[0]
    for k in range(1, CONV_W):
        y = y + xp[:, k:k + s] * w[k]
    return y + b


def _lin_scan(a, b, h0, reverse):
    idx = -1 if reverse else 0
    b = b.at[:, idx].add(a[:, idx] * h0)

    def comb(e1, e2):
        a1, b1 = e1
        a2, b2 = e2
        return a1 * a2, a2 * b1 + b2

    _, h = lax.associative_scan(comb, (a, b), reverse=reverse, axis=1)
    return h


def _rglru_dir(xc, w_a, b_a, w_x, b_x, lam, h0, reverse):
    bn, s, _ = xc.shape
    xb = xc.reshape(bn, s, RNN_BLOCKS, RNN_BLK)
    r = jax.nn.sigmoid((jnp.einsum('bsnk,nkj->bsnj', xb, w_a.astype(jnp.float32)).reshape(bn, s, D_RNN)
                        + b_a.astype(jnp.float32)))
    i = jax.nn.sigmoid((jnp.einsum('bsnk,nkj->bsnj', xb, w_x.astype(jnp.float32)).reshape(bn, s, D_RNN)
                        + b_x.astype(jnp.float32)))
    log_a = -RG_C * r * jax.nn.softplus(-lam.astype(jnp.float32))
    a = jnp.exp(log_a)
    b = jnp.sqrt(-jnp.expm1(2.0 * log_a)) * (i * xc)
    return _lin_scan(a, b, h0, reverse)


def _sweep_queries(fn, qs):
    sq = qs[0].shape[1]
    blk = min(QBLK, sq)
    nb = sq // blk
    qb = tuple(jnp.moveaxis(q.reshape(q.shape[0], nb, blk, *q.shape[2:]), 1, 0) for q in qs)
    out = lax.map(lambda t: fn(*t), qb)
    out = jnp.moveaxis(out, 0, 1)
    return out.reshape(out.shape[0], sq, *out.shape[3:])


def _mla_up(ckv_n, w_ukv):
    bn, s, _ = ckv_n.shape
    kv = (ckv_n @ w_ukv).reshape(bn, s, MLA_H, MLA_NOPE + MLA_V)
    return kv[..., :MLA_NOPE], kv[..., MLA_NOPE:]


def _mla_attend(qn, qr, kn, kr, v):
    def blockfn(qn_b, qr_b):
        s = jnp.einsum('bqhd,bkhd->bhqk', qn_b, kn) + jnp.einsum('bqhr,bkr->bhqk', qr_b, kr)
        p = jax.nn.softmax(s.astype(jnp.float32) * MLA_SCALE, axis=-1).astype(v.dtype)
        return jnp.einsum('bhqk,bkhd->bqhd', p, v)
    return _sweep_queries(blockfn, (qn, qr))


def _diff_attend(q, k, v, lam):
    def blockfn(q_b):
        s = jnp.einsum('bqhcd,bkhcd->bchqk', q_b, k).astype(jnp.float32) * DIFF_SCALE
        p = jax.nn.softmax(s, axis=-1)
        pd = p[:, 0] - lam * p[:, 1]
        return jnp.einsum('bhqk,bkhd->bqhd', pd.astype(v.dtype), v)
    return _sweep_queries(blockfn, (q,))


def _layer(l, x, cond, lw, pos, ctx):
    (w_mod, b_mod, g_pre, g_post, w_in, conv_w, conv_b, w_rg_a, b_rg_a, w_rg_x, b_rg_x, rg_lam,
     q_norm, w_uq, kv_norm, w_ukv, lam_q1, lam_k1, lam_q2, lam_k2, diff_norm,
     w_br_rnn, w_br_mla, w_br_diff, w_out) = lw
    bn, s, _ = x.shape
    mod = jax.nn.silu(cond) @ w_mod + b_mod
    if mod.ndim == 2:
        mod = mod[:, None, :]
    shift, scale, gate = jnp.split(mod, 3, axis=-1)
    h = _rmsnorm(x, g_pre) * (1 + scale) + shift
    z = h @ w_in
    rx, rg, cq, ckv, kr, mg, dq, dk, dv, dg, mgate = _split_cols(z)

    xc = _dwconv(rx, conv_w, conv_b).astype(jnp.float32)
    if ctx is None:
        h0f = jnp.zeros((bn, D_RNN), jnp.float32)
        h0b = h0f
    else:
        h0f = ctx[4][:, 0].astype(jnp.float32)
        h0b = ctx[4][:, 1].astype(jnp.float32)
    hf = _rglru_dir(xc, w_rg_a[0], b_rg_a[0], w_rg_x[0], b_rg_x[0], rg_lam[0], h0f, False)
    hb = _rglru_dir(xc, w_rg_a[1], b_rg_a[1], w_rg_x[1], b_rg_x[1], rg_lam[1], h0b, True)
    y_rnn = (hf + hb).astype(x.dtype) * jax.nn.silu(rg)

    q = (_rmsnorm(cq, q_norm) @ w_uq).reshape(bn, s, MLA_H, MLA_NOPE + MLA_ROPE)
    qn, qr = q[..., :MLA_NOPE], q[..., MLA_NOPE:]
    ckv_n = _rmsnorm(ckv, kv_norm)
    kn, vm = _mla_up(ckv_n, w_ukv)
    kr_r = kr
    if pos is not None:
        qr = _rope_2d(qr, pos[0], pos[1])
        kr_r = _rope_2d(kr[:, :, None, :], pos[0], pos[1])[:, :, 0]
    if ctx is not None:
        kn_c, vm_c = _mla_up(ctx[0], w_ukv)
        kn_all = jnp.concatenate([kn_c, kn], axis=1)
        kr_all = jnp.concatenate([ctx[1], kr_r], axis=1)
        vm_all = jnp.concatenate([vm_c, vm], axis=1)
    else:
        kn_all, kr_all, vm_all = kn, kr_r, vm
    y_mla = _mla_attend(qn, qr, kn_all, kr_all, vm_all).reshape(bn, s, MLA_H * MLA_V) * jax.nn.silu(mg)

    qd = dq.reshape(bn, s, DIFF_H * 2, DIFF_DK)
    kd = dk.reshape(bn, s, DIFF_H * 2, DIFF_DK)
    if pos is not None:
        qd = _rope_2d(qd, pos[0], pos[1])
        kd = _rope_2d(kd, pos[0], pos[1])
    qd = qd.reshape(bn, s, DIFF_H, 2, DIFF_DK)
    kd_flat = kd.reshape(bn, s, DIFF_H, 2 * DIFF_DK)
    vd = dv.reshape(bn, s, DIFF_H, DIFF_DV)
    if ctx is not None:
        kd_all = jnp.concatenate([ctx[2], kd_flat], axis=1)
        vd_all = jnp.concatenate([ctx[3], vd], axis=1)
    else:
        kd_all, vd_all = kd_flat, vd
    kd_all = kd_all.reshape(bn, kd_all.shape[1], DIFF_H, 2, DIFF_DK)
    lam_init = 0.8 - 0.6 * math.exp(-0.3 * l)
    lam = (jnp.exp(jnp.sum(lam_q1.astype(jnp.float32) * lam_k1.astype(jnp.float32)))
           - jnp.exp(jnp.sum(lam_q2.astype(jnp.float32) * lam_k2.astype(jnp.float32))) + lam_init)
    od = _diff_attend(qd, kd_all, vd_all, lam)
    od = _rmsnorm(od, diff_norm) * (1.0 - lam_init)
    y_diff = od.reshape(bn, s, DIFF_H * DIFF_DV) * jax.nn.silu(dg)

    g = jax.nn.sigmoid(mgate).reshape(bn, s, N_BRANCH, D_MODEL)
    merged = (g[:, :, 0] * (y_rnn @ w_br_rnn) + g[:, :, 1] * (y_mla @ w_br_mla)
              + g[:, :, 2] * (y_diff @ w_br_diff))
    x_new = x + gate * _rmsnorm(merged @ w_out, g_post)
    if ctx is None:
        st = jnp.stack([hf[:, -1], hb[:, 0]], axis=1).astype(x.dtype)
        return x_new, (ckv_n, kr, kd_flat, vd, st)
    return x_new, None


def setup_inputs(seed: int = 0) -> dict:
    key = jax.random.key(seed)
    ks = iter(jax.random.split(key, 40))

    def nrm(shape, s):
        return jax.random.normal(next(ks), shape, jnp.float32) * s

    def gain(shape):
        return 1.0 + nrm(shape, 0.02)

    u = jax.random.uniform(next(ks), (DEPTH, 2, D_RNN), jnp.float32, minval=0.9, maxval=0.999)
    sa = u ** (1.0 / RG_C)
    rg_lam = jnp.log(sa) - jnp.log1p(-sa)
    return {
        'x_prompt': nrm((BATCH, SEQ, D_MODEL), 1.0),
        'x_sample': nrm((DEC_BATCH, DEC_SEQ, D_MODEL), 1.0),
        'cache_mla_ckv': nrm((DEC_BATCH, DEPTH, PAST_LEN, KV_RANK), 1.0),
        'cache_mla_krope': nrm((DEC_BATCH, DEPTH, PAST_LEN, MLA_ROPE), 1.0),
        'cache_diff_k': nrm((DEC_BATCH, DEPTH, PAST_LEN, DIFF_H, 2 * DIFF_DK), 1.0),
        'cache_diff_v': nrm((DEC_BATCH, DEPTH, PAST_LEN, DIFF_H, DIFF_DV), 1.0),
        'state_rnn': nrm((DEC_BATCH, DEPTH, 2, D_RNN), 0.5),
        'c': nrm((DEC_BATCH, D_MODEL), 1.0),
        'c_ctx': nrm((D_MODEL,), 1.0),
        'w_mod': nrm((DEPTH, D_MODEL, 3 * D_MODEL), 0.5 * D_MODEL ** -0.5),
        'b_mod': nrm((DEPTH, 3 * D_MODEL), 0.01),
        'g_pre': gain((DEPTH, D_MODEL)),
        'g_post': gain((DEPTH, D_MODEL)),
        'w_in': nrm((DEPTH, D_MODEL, IN_COLS), D_MODEL ** -0.5),
        'conv_w': nrm((DEPTH, CONV_W, D_RNN), CONV_W ** -0.5),
        'conv_b': nrm((DEPTH, D_RNN), 0.01),
        'w_rg_a': nrm((DEPTH, 2, RNN_BLOCKS, RNN_BLK, RNN_BLK), RNN_BLK ** -0.5),
        'b_rg_a': nrm((DEPTH, 2, D_RNN), 0.01),
        'w_rg_x': nrm((DEPTH, 2, RNN_BLOCKS, RNN_BLK, RNN_BLK), RNN_BLK ** -0.5),
        'b_rg_x': nrm((DEPTH, 2, D_RNN), 0.01),
        'rg_lam': rg_lam,
        'q_norm': gain((DEPTH, Q_RANK)),
        'w_uq': nrm((DEPTH, Q_RANK, MLA_H * (MLA_NOPE + MLA_ROPE)), Q_RANK ** -0.5),
        'kv_norm': gain((DEPTH, KV_RANK)),
        'w_ukv': nrm((DEPTH, KV_RANK, MLA_H * (MLA_NOPE + MLA_V)), KV_RANK ** -0.5),
        'lam_q1': nrm((DEPTH, DIFF_DK), 0.1),
        'lam_k1': nrm((DEPTH, DIFF_DK), 0.1),
        'lam_q2': nrm((DEPTH, DIFF_DK), 0.1),
        'lam_k2': nrm((DEPTH, DIFF_DK), 0.1),
        'diff_norm': gain((DEPTH, DIFF_DV)),
        'w_br_rnn': nrm((DEPTH, D_RNN, D_MODEL), D_RNN ** -0.5),
        'w_br_mla': nrm((DEPTH, MLA_H * MLA_V, D_MODEL), (MLA_H * MLA_V) ** -0.5),
        'w_br_diff': nrm((DEPTH, DIFF_H * DIFF_DV, D_MODEL), (DIFF_H * DIFF_DV) ** -0.5),
        'w_out': nrm((DEPTH, D_MODEL, D_MODEL), D_MODEL ** -0.5),
    }


def reference(x_prompt, x_sample, cache_mla_ckv, cache_mla_krope, cache_diff_k, cache_diff_v, state_rnn,
              c, c_ctx, w_mod, b_mod, g_pre, g_post, w_in, conv_w, conv_b, w_rg_a, b_rg_a, w_rg_x, b_rg_x,
              rg_lam, q_norm, w_uq, kv_norm, w_ukv, lam_q1, lam_k1, lam_q2, lam_k2, diff_norm,
              w_br_rnn, w_br_mla, w_br_diff, w_out):
    weights = (w_mod, b_mod, g_pre, g_post, w_in, conv_w, conv_b, w_rg_a, b_rg_a, w_rg_x, b_rg_x, rg_lam,
               q_norm, w_uq, kv_norm, w_ukv, lam_q1, lam_k1, lam_q2, lam_k2, diff_norm,
               w_br_rnn, w_br_mla, w_br_diff, w_out)

    xp = x_prompt
    ckv_l, kr_l, dk_l, dv_l, st_l = [], [], [], [], []
    for l in range(DEPTH):
        lw = [w[l] for w in weights]
        xp, (ckv_n, kr, kd, vd, st) = _layer(l, xp, c_ctx, lw, None, None)
        ckv_l.append(ckv_n)
        kr_l.append(kr)
        dk_l.append(kd)
        dv_l.append(vd)
        st_l.append(st)
    y_prompt = xp

    n_lat = x_sample.shape[1]
    rows = n_lat // GRID_W
    pos_row = jnp.repeat(jnp.arange(rows, dtype=jnp.int32), GRID_W)
    pos_col = jnp.tile(jnp.arange(GRID_W, dtype=jnp.int32), rows)
    xs = x_sample
    for l in range(DEPTH):
        lw = [w[l] for w in weights]
        ctx = (cache_mla_ckv[:, l], cache_mla_krope[:, l], cache_diff_k[:, l], cache_diff_v[:, l], state_rnn[:, l])
        xs, _ = _layer(l, xs, c, lw, (pos_row, pos_col), ctx)
    y_sample = xs

    new_mla_ckv = jnp.stack(ckv_l, axis=1)
    new_mla_krope = jnp.stack(kr_l, axis=1)
    new_diff_k = jnp.stack(dk_l, axis=1)
    new_diff_v = jnp.stack(dv_l, axis=1)
    new_state_rnn = jnp.stack(st_l, axis=1)
    return (y_prompt, y_sample, new_mla_ckv, new_mla_krope, new_diff_k, new_diff_v, new_state_rnn)
```

```cpp
#include <hip/hip_runtime.h>
#include <hip/hip_cooperative_groups.h>
#include <cstdio>
#include <cstdint>
namespace cg = cooperative_groups;

#define LAS __attribute__((address_space(3)))
typedef unsigned short bf16_t;
typedef short bf16x8 __attribute__((ext_vector_type(8)));
typedef short s16x4 __attribute__((ext_vector_type(4)));
typedef float f32x2 __attribute__((ext_vector_type(2)));
typedef float f32x4 __attribute__((ext_vector_type(4)));
typedef float f32x16 __attribute__((ext_vector_type(16)));
typedef unsigned u32x2 __attribute__((ext_vector_type(2)));
typedef unsigned u32x4 __attribute__((ext_vector_type(4)));
typedef __bf16 bf16x2_t __attribute__((ext_vector_type(2)));

constexpr int DM = 1024, NP = 8192, ND = 16384, NTOK = 24576, NKV = 28672, HALF_TOK = 12288;
constexpr int IN_COLS = 7328;
constexpr float EPS = 1e-6f;
constexpr float LOG2E = 1.4426950408889634f;
constexpr float SCALE_M = 0.10206207261596577f * LOG2E;
constexpr float SCALE_D = 0.125f * LOG2E;
constexpr size_t O_Y = 0, O_CKV = 25165824, O_KR = 29360128, O_DK = 29884416, O_DV = 38273024, O_ST = 46661632, O_TOTAL = 46727168;

constexpr size_t MiB = 1u << 20;
constexpr size_t WS_CTL = 0;
constexpr size_t CTL_MOD = 64 * 1024;
constexpr size_t CTL_ROPE = 320 * 1024;
constexpr size_t CTL_SSQ = 1 * MiB;
constexpr size_t WS_W = 3 * MiB;
constexpr size_t W_IN = 0;
constexpr size_t W_UQ = W_IN + (size_t)7424 * 1024 * 2;
constexpr size_t W_UKV = W_UQ + (size_t)768 * 384 * 2;
constexpr size_t W_BR = W_UKV + (size_t)1024 * 256 * 2;
constexpr size_t W_OUT = W_BR + (size_t)3072 * 512 * 2;
constexpr size_t W_RG = W_OUT + (size_t)1024 * 1024 * 2;
constexpr size_t W_END = W_RG + (size_t)32 * 4096 * 2;
static_assert(W_END <= 21 * MiB, "weight region");
constexpr size_t WS_H = 24 * MiB;
constexpr size_t WS_Y = 72 * MiB;
constexpr size_t Y_SLOT = (size_t)NTOK * 512 * 2;
constexpr size_t WS_A = 144 * MiB;
constexpr size_t A_CKV = 0;
constexpr size_t A_KR = 14 * MiB;
constexpr size_t A_Q = 16 * MiB;
constexpr size_t A_KV = 52 * MiB;
constexpr size_t A_DQ = 0;
constexpr size_t A_DK = 24 * MiB;
constexpr size_t A_DV = 52 * MiB;
constexpr size_t A_G = 0;
constexpr size_t A_O = 0;
constexpr size_t WS_END = 256 * MiB;
static_assert(A_KV + (size_t)NKV * 1024 * 2 <= 112 * MiB, "A region");

constexpr int LDS_BYTES = 147456;
constexpr int NTHREADS = 512;

struct Params { const float* in[34]; float* out; unsigned char* ws; };

__device__ __forceinline__ unsigned pk2(float lo, float hi) { f32x2 v = {lo, hi}; bf16x2_t b = __builtin_convertvector(v, bf16x2_t); return __builtin_bit_cast(unsigned, b); }
__device__ __forceinline__ float bflo(unsigned w) { return __uint_as_float(w << 16); }
__device__ __forceinline__ float bfhi(unsigned w) { return __uint_as_float(w & 0xffff0000u); }
__device__ __forceinline__ float bf2f(bf16_t x) { return __uint_as_float(((unsigned)x) << 16); }
__device__ __forceinline__ u32x4 pack8(const float* v) { u32x4 w; w.x = pk2(v[0], v[1]); w.y = pk2(v[2], v[3]); w.z = pk2(v[4], v[5]); w.w = pk2(v[6], v[7]); return w; }
__device__ __forceinline__ void unpack8(u32x4 w, float* v) { v[0] = bflo(w.x); v[1] = bfhi(w.x); v[2] = bflo(w.y); v[3] = bfhi(w.y); v[4] = bflo(w.z); v[5] = bfhi(w.z); v[6] = bflo(w.w); v[7] = bfhi(w.w); }
__device__ __forceinline__ float wave_sum(float v) {
#pragma unroll
    for (int o = 1; o < 64; o <<= 1) v += __shfl_xor(v, o);
    return v;
}
__device__ __forceinline__ float sigmoidf_(float x) { return 1.0f / (1.0f + __expf(-x)); }
__device__ __forceinline__ float siluf_(float x) { return x / (1.0f + __expf(-x)); }
__device__ __forceinline__ int kvrow_of(int r) { return r < NP ? r : NP + ((r - NP) >> 11) * 2560 + 512 + ((r - NP) & 2047); }
__device__ __forceinline__ int grp_of(int r) { return r < NP ? 0 : 1 + ((r - NP) >> 11); }
__device__ __forceinline__ int cache_row(int r, int l) { return r + 256 * ((r >> 8) + l); }
__device__ __forceinline__ int tid_now() { int t = threadIdx.x; asm volatile("; tid" : "+v"(t)); return t; }
namespace pg8 {
#define PG8_LAS __attribute__((address_space(3)))
constexpr int BM = 256, BK = 64, HALF = 128, HTB = HALF * BK * 2  , STAGE_BYTES = 8 * HTB, NXCD = 8, WGM = 8;
__host__ __device__ __forceinline__ int lds_byte(int r, int c) { const int st = (r >> 4) * 2 + (c >> 5), rr = r & 15, cc = c & 31, ob = rr * 64 + cc * 2; return st * 1024 + (ob ^ (((ob >> 9) & 1) << 5)); }
__host__ __device__ __forceinline__ void stage_rc(int b, int& R, int& C) { const int st = b / 1024, sb = b % 1024, swz = sb ^ (((sb >> 9) & 1) << 5); R = (st >> 1) * 16 + swz / 64; C = (st & 1) * 32 + (swz % 64) / 2; }
__host__ __device__ __forceinline__ int perm32(int rho) { const int n = rho >> 4, i = rho & 15; return 8 * (i >> 2) + 4 * n + (i & 3); }
struct Unit { int pm, pn; };
struct Gemm { const bf16_t* A; const bf16_t* Bt; int M, N, K; };
struct StaticOrder {
    int nM, nN, nwg, G, c;
    __host__ __device__ void init(int M, int N, int G_, int c_) { nM = M / BM; nN = N / BM; nwg = nM * nN; G = G_; c = c_; }
    __host__ __device__ bool next(int i, Unit& u) const {
        const long L = (long)i * G + c; if (L >= nwg) return false;
        int wgid = (int)L; { const int q = nwg / NXCD, r = nwg % NXCD, xcd = wgid % NXCD, off = wgid / NXCD; wgid = (xcd < r ? xcd * (q + 1) : r * (q + 1) + (xcd - r) * q) + off; }
        const int nig = WGM * nN, gid = wgid / nig, fm = gid * WGM, gsz = (nM - fm) < WGM ? (nM - fm) : WGM;
        u.pm = fm + ((wgid % nig) % gsz); u.pn = (wgid % nig) / gsz; return true;
    }
    __device__ __forceinline__ void a_ready(const Unit&) const {}
    __device__ __forceinline__ void done(const Unit&) const {}
};
template <class Epi, class Sched, bool ALIGN_EPI = false, bool SP2 = false>
__device__ __forceinline__ void gemm_phase(PG8_LAS unsigned char* lds, const Gemm g, const Sched& S, const Epi& E) {
    const int tid = tid_now(), wid = __builtin_amdgcn_readfirstlane(tid >> 6), lane = tid & 63, wr = wid >> 2, wc = wid & 3, fr = lane & 15, fq = lane >> 4;
    const int K = g.K, nt = K / BK;
    unsigned voffA[2], voffB[2];
#pragma unroll
    for (int i = 0; i < 2; ++i) { int R, C; stage_rc(tid * 16 + i * 8192, R, C); const int Rb = Epi::PERM ? ((R & ~31) + perm32(R & 31)) : R;
        voffA[i] = (unsigned)(R * K + C) * 2u; voffB[i] = (unsigned)(Rb * K + C) * 2u; }
    const size_t kstep = (size_t)(BK * 2);
    const size_t hstep = (size_t)HALF * K * 2;
    const size_t tstep = 2 * hstep;
    const unsigned ldsw = (unsigned)wid * 1024u;
    const int aoff = lds_byte(wr * 64 + fr, fq * 8), boff = lds_byte(wc * 32 + fr, fq * 8);
#define PG8_SA(b, h) (((b) * 2 + (h)) * HTB)
#define PG8_SB(b, h) ((4 + (b) * 2 + (h)) * HTB)
#define PG8_STAGE(bufoff, gbase, voff) do { _Pragma("unroll") for (int _i = 0; _i < 2; ++_i) \
        __builtin_amdgcn_global_load_lds((const unsigned*)((const char*)(gbase) + (voff)[_i]), (PG8_LAS unsigned*)(lds + (bufoff) + ldsw + _i * 8192), 16, 0, 0); } while (0)
#define PG8_LDA(dst, b, h) do { _Pragma("unroll") for (int m = 0; m < 4; ++m) _Pragma("unroll") for (int k = 0; k < 2; ++k) dst[m][k] = *(const PG8_LAS bf16x8*)(lds + PG8_SA(b, h) + aoff + m * 2048 + k * 1024); } while (0)
#define PG8_LDB(dst, b, h) do { _Pragma("unroll") for (int n = 0; n < 2; ++n) _Pragma("unroll") for (int k = 0; k < 2; ++k) dst[n][k] = *(const PG8_LAS bf16x8*)(lds + PG8_SB(b, h) + boff + n * 2048 + k * 1024); } while (0)
#define PG8_MMA(ai, bj, At, Bt) do { __builtin_amdgcn_s_setprio(1); _Pragma("unroll") for (int m = 0; m < 4; ++m) _Pragma("unroll") for (int n = 0; n < 2; ++n) _Pragma("unroll") for (int k = 0; k < 2; ++k) \
        acc[ai][bj][m][n] = __builtin_amdgcn_mfma_f32_16x16x32_bf16(Bt[n][k], At[m][k], acc[ai][bj][m][n], 0, 0, 0); __builtin_amdgcn_s_setprio(0); } while (0)
#define PG8_WAIT_V(n) asm volatile("s_waitcnt vmcnt(" #n ")" ::: "memory")
#define PG8_WAIT_L(n) asm volatile("s_waitcnt lgkmcnt(" #n ")" ::: "memory")
#define PG8_BAR __builtin_amdgcn_s_barrier()
#define PG8_SCHED __builtin_amdgcn_sched_barrier(0)
    Unit cur, nxt; int ui = 0;
    if (!S.next(0, cur)) return;
    f32x4 acc[2][2][4][2];
#pragma unroll
    for (int a = 0; a < 2; ++a)
#pragma unroll
        for (int b = 0; b < 2; ++b)
#pragma unroll
            for (int m = 0; m < 4; ++m)
#pragma unroll
                for (int n = 0; n < 2; ++n) acc[a][b][m][n] = (f32x4){0.f, 0.f, 0.f, 0.f};
    bf16x8 At[4][2], B0[2][2], B1[2][2];
    const char* cA = (const char*)g.A + (size_t)cur.pm * tstep; const char* cB = (const char*)g.Bt + (size_t)cur.pn * tstep;
    S.a_ready(cur);
    if constexpr (SP2) {
        PG8_STAGE(PG8_SB(0, 0), cB, voffB); PG8_STAGE(PG8_SB(0, 1), cB + hstep, voffB); PG8_STAGE(PG8_SA(0, 0), cA, voffA); PG8_STAGE(PG8_SA(0, 1), cA + hstep, voffA);
        if (wr == 1) PG8_BAR;
        PG8_WAIT_V(2); PG8_BAR;
        PG8_STAGE(PG8_SB(1, 0), cB + kstep, voffB); PG8_STAGE(PG8_SA(1, 0), cA + kstep, voffA); PG8_STAGE(PG8_SB(1, 1), cB + hstep + kstep, voffB);
        PG8_WAIT_V(6); PG8_BAR;
    } else {
        PG8_STAGE(PG8_SB(0, 0), cB, voffB); PG8_STAGE(PG8_SA(0, 0), cA, voffA); PG8_STAGE(PG8_SB(0, 1), cB + hstep, voffB); PG8_STAGE(PG8_SA(0, 1), cA + hstep, voffA);
        if (wr == 1) PG8_BAR;
        PG8_WAIT_V(4); PG8_BAR;
        PG8_STAGE(PG8_SB(1, 0), cB + kstep, voffB); PG8_STAGE(PG8_SA(1, 0), cA + kstep, voffA); PG8_STAGE(PG8_SB(1, 1), cB + hstep + kstep, voffB);
        PG8_WAIT_V(6); PG8_BAR;
    }
    for (;;) {
        const bool has_next = S.next(ui + 1, nxt);
        const char* nA = has_next ? (const char*)g.A + (size_t)nxt.pm * tstep : cA; const char* nB = has_next ? (const char*)g.Bt + (size_t)nxt.pn * tstep : cB;
#pragma unroll 1
        for (int t = 0; t < nt; t += 2) {
            const bool last = (t == nt - 2);
            const char* a1 = cA + (size_t)(t + 1) * kstep;
            const char* a2 = last ? nA : cA + (size_t)(t + 2) * kstep; const char* b2 = last ? nB : cB + (size_t)(t + 2) * kstep;
            const char* a3 = a2 + kstep; const char* b3 = b2 + kstep;
            if (last && has_next) S.a_ready(nxt);
            if constexpr (SP2) {
            PG8_LDB(B0, 0, 0); PG8_LDB(B1, 0, 1); PG8_SCHED; PG8_LDA(At, 0, 0); PG8_STAGE(PG8_SA(1, 1), a1 + hstep, voffA);
            PG8_WAIT_V(8); PG8_WAIT_L(0); PG8_BAR; PG8_MMA(0, 0, At, B0); PG8_MMA(0, 1, At, B1); PG8_BAR; PG8_SCHED;
            PG8_LDA(At, 0, 1); PG8_STAGE(PG8_SB(0, 0), b2, voffB); PG8_STAGE(PG8_SB(0, 1), b2 + hstep, voffB); PG8_STAGE(PG8_SA(0, 0), a2, voffA);
            PG8_WAIT_V(8); PG8_WAIT_L(0); PG8_BAR; PG8_MMA(1, 0, At, B0); PG8_MMA(1, 1, At, B1); PG8_BAR; PG8_SCHED;
            PG8_LDB(B0, 1, 0); PG8_LDB(B1, 1, 1); PG8_SCHED; PG8_LDA(At, 1, 0); PG8_STAGE(PG8_SA(0, 1), a2 + hstep, voffA);
            PG8_WAIT_V(8); PG8_WAIT_L(0); PG8_BAR; PG8_MMA(0, 0, At, B0); PG8_MMA(0, 1, At, B1); PG8_BAR; PG8_SCHED;
            PG8_LDA(At, 1, 1); PG8_STAGE(PG8_SB(1, 0), b3, voffB); PG8_STAGE(PG8_SB(1, 1), b3 + hstep, voffB); PG8_STAGE(PG8_SA(1, 0), a3, voffA);
            PG8_WAIT_V(8); PG8_WAIT_L(0); PG8_BAR; PG8_MMA(1, 0, At, B0); PG8_MMA(1, 1, At, B1); PG8_BAR; PG8_SCHED;
            } else {
            PG8_LDB(B0, 0, 0); PG8_SCHED; PG8_LDA(At, 0, 0); PG8_STAGE(PG8_SA(1, 1), a1 + hstep, voffA);
            PG8_WAIT_L(8); PG8_BAR; PG8_WAIT_L(0); PG8_MMA(0, 0, At, B0); PG8_BAR; PG8_SCHED;
            PG8_LDB(B1, 0, 1); PG8_STAGE(PG8_SB(0, 0), b2, voffB);
            PG8_BAR; PG8_WAIT_L(0); PG8_MMA(0, 1, At, B1); PG8_BAR;
            PG8_LDA(At, 0, 1); PG8_STAGE(PG8_SA(0, 0), a2, voffA);
            PG8_BAR; PG8_WAIT_L(0); PG8_MMA(1, 0, At, B0); PG8_BAR; PG8_SCHED;
            PG8_STAGE(PG8_SB(0, 1), b2 + hstep, voffB);
            PG8_WAIT_V(6); PG8_BAR; PG8_MMA(1, 1, At, B1); PG8_BAR;
            PG8_LDB(B0, 1, 0); PG8_SCHED; PG8_LDA(At, 1, 0); PG8_STAGE(PG8_SA(0, 1), a2 + hstep, voffA);
            PG8_WAIT_L(8); PG8_BAR; PG8_WAIT_L(0); PG8_MMA(0, 0, At, B0); PG8_BAR; PG8_SCHED;
            PG8_LDB(B1, 1, 1); PG8_STAGE(PG8_SB(1, 0), b3, voffB);
            PG8_BAR; PG8_WAIT_L(0); PG8_MMA(0, 1, At, B1); PG8_BAR;
            PG8_LDA(At, 1, 1); PG8_STAGE(PG8_SA(1, 0), a3, voffA);
            PG8_BAR; PG8_WAIT_L(0); PG8_MMA(1, 0, At, B0); PG8_BAR; PG8_SCHED;
            PG8_STAGE(PG8_SB(1, 1), b3 + hstep, voffB);
            PG8_WAIT_V(6); PG8_BAR; PG8_MMA(1, 1, At, B1); PG8_BAR;
            }
        }
        if constexpr (ALIGN_EPI) { if (wr == 0) PG8_BAR; }
        bool rst_ = true; if constexpr (!Epi::AFTER_DRAIN) { rst_ = E(acc, cur, wr, wc, fr, fq); S.done(cur); }
        if (!has_next) break;
        if (rst_) {
#pragma unroll
        for (int a = 0; a < 2; ++a)
#pragma unroll
            for (int b = 0; b < 2; ++b)
#pragma unroll
                for (int m = 0; m < 4; ++m)
#pragma unroll
                    for (int n = 0; n < 2; ++n) acc[a][b][m][n] = (f32x4){0.f, 0.f, 0.f, 0.f};
        }
        cur = nxt; cA = nA; cB = nB; ++ui;
        if constexpr (ALIGN_EPI) { if (wr == 1) PG8_BAR; }
    }
    PG8_WAIT_V(0);
    if constexpr (!ALIGN_EPI) { if (wr == 0) PG8_BAR; }
    PG8_BAR;
    if constexpr (Epi::AFTER_DRAIN) { E.fused(acc, cur, wr, wc, fr, fq, lds, wid, lane); S.done(cur); }
#undef PG8_SA
#undef PG8_SB
#undef PG8_STAGE
#undef PG8_LDA
#undef PG8_LDB
#undef PG8_MMA
#undef PG8_WAIT_V
#undef PG8_WAIT_L
#undef PG8_BAR
#undef PG8_SCHED
}
}
using pg8::Unit;
#define EPI_ROWS_BEGIN _Pragma("unroll") for (int ai = 0; ai < 2; ++ai) _Pragma("unroll") for (int m = 0; m < 4; ++m) { const int row = u.pm * 256 + ai * 128 + wr * 64 + m * 16 + fr;
#define EPI_COLS_BEGIN _Pragma("unroll") for (int bj = 0; bj < 2; ++bj) { const int col = u.pn * 256 + bj * 128 + wc * 32 + 8 * fq; \
    float v[8]; { const f32x4 a0 = acc[ai][bj][m][0], a1 = acc[ai][bj][m][1]; v[0] = a0[0]; v[1] = a0[1]; v[2] = a0[2]; v[3] = a0[3]; v[4] = a1[0]; v[5] = a1[1]; v[6] = a1[2]; v[7] = a1[3]; }
#define EPI_END } asm volatile("" ::: "memory"); }
__device__ __forceinline__ void st_bf16x8(bf16_t* p, const float* v) { *(u32x4*)p = pack8(v); }
__device__ __forceinline__ void st_f32x8(float* p, const float* v) { *(f32x4*)p = (f32x4){v[0], v[1], v[2], v[3]}; *(f32x4*)(p + 4) = (f32x4){v[4], v[5], v[6], v[7]}; }

template <int XL> __device__ __forceinline__ void rope8(float* v, bool second, const float* cs, const float* sn) {
    const f32x4 c0 = *(const f32x4*)cs, c1 = *(const f32x4*)(cs + 4), s0 = *(const f32x4*)sn, s1 = *(const f32x4*)(sn + 4);
    const float c[8] = {c0[0], c0[1], c0[2], c0[3], c1[0], c1[1], c1[2], c1[3]}, s[8] = {s0[0], s0[1], s0[2], s0[3], s1[0], s1[1], s1[2], s1[3]};
#pragma unroll
    for (int i = 0; i < 8; ++i) { const float p = __shfl_xor(v[i], XL); v[i] = v[i] * c[i] + (second ? p : -p) * s[i]; }
}

struct EpiG1 {
    static constexpr bool PERM = true, AFTER_DRAIN = false;
    bf16_t *RX, *CQ, *CKV, *KR; float* okr; const float* rope; int l;
    __device__ __forceinline__ bool operator()(f32x4 (&acc)[2][2][4][2], const Unit& u, int wr, int wc, int fr, int fq) const {
        const bool dec = u.pm >= 32;
        EPI_ROWS_BEGIN
            const int kvr = kvrow_of(row);
            EPI_COLS_BEGIN
                if (col < 512) st_bf16x8(RX + (size_t)row * 512 + col, v);
                else if (col < 896) st_bf16x8(CQ + (size_t)row * 384 + (col - 512), v);
                else if (col < 1152) st_bf16x8(CKV + (size_t)kvr * 256 + (col - 896), v);
                else if (col < 1184) {
                    const int e = col - 1152;
                    if (dec) { const int t = (row - NP) & 2047, pos = (fq & 2) ? (t & 63) : (t >> 6);
                        rope8<16>(v, (fq & 1) != 0, rope + pos * 8, rope + 512 + pos * 8); }
                    else st_f32x8(okr + (size_t)cache_row(row, l) * 32 + e, v);
                    st_bf16x8(KR + (size_t)kvr * 32 + e, v);
                }
            EPI_END
        return true;
    }
};
struct EpiQ {
    static constexpr bool PERM = true, AFTER_DRAIN = false;
    bf16_t* Q; const float* rope;
    __device__ __forceinline__ bool operator()(f32x4 (&acc)[2][2][4][2], const Unit& u, int wr, int wc, int fr, int fq) const {
        const bool dec = u.pm >= 32;
        EPI_ROWS_BEGIN
            EPI_COLS_BEGIN
                const int g32 = col >> 5;
                if (dec && (g32 % 3) == 2) { const int t = (row - NP) & 2047, pos = (fq & 2) ? (t & 63) : (t >> 6);
                    rope8<16>(v, (fq & 1) != 0, rope + pos * 8, rope + 512 + pos * 8); }
#pragma unroll
                for (int i = 0; i < 8; ++i) v[i] *= SCALE_M;
                st_bf16x8(Q + (size_t)row * 768 + col, v);
            EPI_END
        return true;
    }
};
struct EpiPlain {
    static constexpr bool PERM = true, AFTER_DRAIN = false;
    bf16_t* O; int ldc;
    __device__ __forceinline__ bool operator()(f32x4 (&acc)[2][2][4][2], const Unit& u, int wr, int wc, int fr, int fq) const {
        EPI_ROWS_BEGIN
            EPI_COLS_BEGIN
                st_bf16x8(O + (size_t)row * ldc + col, v);
            EPI_END
        return true;
    }
};
struct EpiG3 {
    static constexpr bool PERM = true, AFTER_DRAIN = false;
    bf16_t *DQ, *DK, *DV; float *odk, *odv; const float* rope; int l;
    __device__ __forceinline__ bool operator()(f32x4 (&acc)[2][2][4][2], const Unit& u, int wr, int wc, int fr, int fq) const {
        const bool dec = u.pm >= 32;
        EPI_ROWS_BEGIN
            const int kvr = kvrow_of(row);
            EPI_COLS_BEGIN
                if (col < 1024) {
                    if (dec) { const int t = (row - NP) & 2047, pos = ((col >> 5) & 1) ? (t & 63) : (t >> 6);
                        rope8<32>(v, (fq & 2) != 0, rope + pos * 16 + (fq & 1) * 8, rope + 1024 + pos * 16 + (fq & 1) * 8); }
                    if (col < 512) {
#pragma unroll
                        for (int i = 0; i < 8; ++i) v[i] *= SCALE_D;
                        st_bf16x8(DQ + (size_t)row * 512 + col, v);
                    } else {
                        if (!dec) st_f32x8(odk + (size_t)cache_row(row, l) * 512 + (col - 512), v);
                        st_bf16x8(DK + (size_t)kvr * 512 + (col - 512), v);
                    }
                } else {
                    if (!dec) st_f32x8(odv + (size_t)cache_row(row, l) * 512 + (col - 1024), v);
                    st_bf16x8(DV + (size_t)kvr * 512 + (col - 1024), v);
                }
            EPI_END
        return true;
    }
};
struct EpiG4 {
    static constexpr bool PERM = true, AFTER_DRAIN = false;
    bf16_t* Y; bf16_t* G; int row_off;
    __device__ __forceinline__ bool operator()(f32x4 (&acc)[2][2][4][2], const Unit& u, int wr, int wc, int fr, int fq) const {
        EPI_ROWS_BEGIN
            EPI_COLS_BEGIN
                if (col < 1536) {
                    const int slot = col >> 9, cc = col & 511;
                    bf16_t* p = Y + (size_t)slot * ((size_t)NTOK * 512) + (size_t)(row + row_off) * 512 + cc;
                    float pre[8]; unpack8(*(const u32x4*)p, pre);
#pragma unroll
                    for (int i = 0; i < 8; ++i) v[i] = pre[i] * siluf_(v[i]);
                    st_bf16x8(p, v);
                } else {
#pragma unroll
                    for (int i = 0; i < 8; ++i) v[i] = sigmoidf_(v[i]);
                    st_bf16x8(G + (size_t)row * 3072 + (col - 1536), v);
                }
            EPI_END
        return true;
    }
};
struct EpiG5 {
    static constexpr bool PERM = true, AFTER_DRAIN = false;
    const bf16_t* G; bf16_t* MG; int half;
    __device__ __forceinline__ bool operator()(f32x4 (&acc)[2][2][4][2], const Unit& u, int wr, int wc, int fr, int fq) const {
        const int br = u.pn >> 2, pn = u.pn & 3, pml = u.pm - br * 96 - half * 48;
#pragma unroll
        for (int ai = 0; ai < 2; ++ai)
#pragma unroll
            for (int m = 0; m < 4; ++m) { const int rl = pml * 256 + ai * 128 + wr * 64 + m * 16 + fr;
#pragma unroll
                for (int bj = 0; bj < 2; ++bj) { const int col = pn * 256 + bj * 128 + wc * 32 + 8 * fq;
                    float g0[8], f[8]; unpack8(*(const u32x4*)(G + (size_t)rl * 3072 + br * 1024 + col), g0);
                    if (br < 2) { float g1[8]; unpack8(*(const u32x4*)(G + (size_t)rl * 3072 + (br + 1) * 1024 + col), g1);
#pragma unroll
                        for (int i = 0; i < 8; ++i) f[i] = fmaxf(g0[i], 1e-30f) / fmaxf(g1[i], 1e-30f);
                        if (br == 0) {
#pragma unroll
                            for (int i = 0; i < 8; ++i) f[i] = g0[i] / fmaxf(g1[i], 1e-30f);
                        }
                    } else {
#pragma unroll
                        for (int i = 0; i < 8; ++i) f[i] = fmaxf(g0[i], 1e-30f);
                    }
                    f32x4& a0 = acc[ai][bj][m][0]; f32x4& a1 = acc[ai][bj][m][1];
                    a0[0] *= f[0]; a0[1] *= f[1]; a0[2] *= f[2]; a0[3] *= f[3]; a1[0] *= f[4]; a1[1] *= f[5]; a1[2] *= f[6]; a1[3] *= f[7];
                    if (br == 2) { const float v[8] = {a0[0], a0[1], a0[2], a0[3], a1[0], a1[1], a1[2], a1[3]};
                        st_bf16x8(MG + (size_t)(half * HALF_TOK + rl) * 1024 + col, v); }
                } }
        return br == 2;
    }
};
struct EpiG6 {
    static constexpr bool PERM = true, AFTER_DRAIN = false;
    bf16_t* O; float* ssq;
    __device__ __forceinline__ bool operator()(f32x4 (&acc)[2][2][4][2], const Unit& u, int wr, int wc, int fr, int fq) const {
        EPI_ROWS_BEGIN
            float s = 0.f;
            EPI_COLS_BEGIN
#pragma unroll
                for (int i = 0; i < 8; ++i) s += v[i] * v[i];
                st_bf16x8(O + (size_t)row * 1024 + col, v);
            }
            s += __shfl_xor(s, 16); s += __shfl_xor(s, 32);
            if (fq == 0) ssq[(size_t)row * 16 + u.pn * 4 + wc] = s;
        }
        return true;
    }
};
namespace att {
#define SBAR() __builtin_amdgcn_sched_barrier(0)
__device__ __forceinline__ int crow(int r, int hi) { return (r & 3) + 8 * (r >> 2) + 4 * hi; }
template <int DQK> __device__ __forceinline__ int kswz(int row, int chunk) {
    if constexpr (DQK == 64) return row * 128 + ((chunk ^ ((row >> 1) & 7)) << 4);
    else return row * 256 + ((chunk ^ (row & 15)) << 4);
}
template <int DQK> struct KTile { static constexpr int BYTES = DQK == 64 ? 8192 : 16384; };
template <int DV> __device__ __forceinline__ int v_st(int k, int c) { return ((k >> 3) * (DV / 32) + (c >> 5)) * 512 + ((k & 7) * 32 + (c & 31)) * 2; }
__device__ __forceinline__ int v_rd_base(int lane) { return ((lane & 3) << 3) | (((lane >> 2) & 3) << 6) | (((lane >> 4) & 1) << 5) | (((lane >> 5) & 1) << 8); }
template <int OFF> __device__ __forceinline__ s16x4 tr_read(int vb) {
    s16x4 r; asm volatile("ds_read_b64_tr_b16 %0, %1 offset:%2" : "=&v"(r) : "v"(vb), "i"(OFF) : "memory"); return r;
}
template <int DV, int D0> __device__ __forceinline__ void pv_one(f32x16& od, int vb, bf16x8 pa0, bf16x8 pa1, bf16x8 pa2, bf16x8 pa3) {
    constexpr int NB = DV / 32;
#define VOFF(ks, half) (((2 * (ks) + (half)) * NB + D0) * 512)
    const s16x4 l0 = tr_read<VOFF(0, 0)>(vb), h0 = tr_read<VOFF(0, 1)>(vb), l1 = tr_read<VOFF(1, 0)>(vb), h1 = tr_read<VOFF(1, 1)>(vb);
    const s16x4 l2 = tr_read<VOFF(2, 0)>(vb), h2 = tr_read<VOFF(2, 1)>(vb), l3 = tr_read<VOFF(3, 0)>(vb), h3 = tr_read<VOFF(3, 1)>(vb);
#undef VOFF
    asm volatile("s_waitcnt lgkmcnt(0)" ::: "memory"); SBAR();
#define PK(L, H) (bf16x8){L[0], L[1], L[2], L[3], H[0], H[1], H[2], H[3]}
    od = __builtin_amdgcn_mfma_f32_32x32x16_bf16(pa0, PK(l0, h0), od, 0, 0, 0);
    od = __builtin_amdgcn_mfma_f32_32x32x16_bf16(pa1, PK(l1, h1), od, 0, 0, 0);
    od = __builtin_amdgcn_mfma_f32_32x32x16_bf16(pa2, PK(l2, h2), od, 0, 0, 0);
    od = __builtin_amdgcn_mfma_f32_32x32x16_bf16(pa3, PK(l3, h3), od, 0, 0, 0);
#undef PK
}
template <int DV> __device__ __forceinline__ void pv_all(f32x16* o, int vb, bf16x8 pa0, bf16x8 pa1, bf16x8 pa2, bf16x8 pa3) {
    pv_one<DV, 0>(o[0], vb, pa0, pa1, pa2, pa3); pv_one<DV, 1>(o[1], vb, pa0, pa1, pa2, pa3);
    if constexpr (DV == 128) { pv_one<DV, 2>(o[2], vb, pa0, pa1, pa2, pa3); pv_one<DV, 3>(o[3], vb, pa0, pa1, pa2, pa3); }
}
constexpr float THRL = 6.0f;
__device__ __forceinline__ void partialSM(f32x16& p0, f32x16& p1, float& m_reg, float& alpha) {
    float pmax = p0[0];
#pragma unroll
    for (int r = 1; r < 16; ++r) pmax = fmaxf(pmax, p0[r]);
#pragma unroll
    for (int r = 0; r < 16; ++r) pmax = fmaxf(pmax, p1[r]);
    { auto rr = __builtin_amdgcn_permlane32_swap(__float_as_uint(pmax), __float_as_uint(pmax), false, false);
      pmax = fmaxf(__uint_as_float(rr[0]), __uint_as_float(rr[1])); }
    float mn;
    if (__builtin_expect(__all(pmax - m_reg <= THRL), 1)) { mn = m_reg; alpha = 1.f; }
    else { mn = fmaxf(m_reg, pmax); alpha = __builtin_amdgcn_exp2f(m_reg - mn); m_reg = mn; }
#pragma unroll
    for (int r = 0; r < 16; ++r) p0[r] = __builtin_amdgcn_exp2f(p0[r] - mn);
#pragma unroll
    for (int r = 0; r < 16; ++r) p1[r] -= mn;
}
__device__ __forceinline__ void finishSM(f32x16& p0, f32x16& p1, float alpha, float& l_reg, bf16x8& pa0, bf16x8& pa1, bf16x8& pa2, bf16x8& pa3) {
#pragma unroll
    for (int r = 0; r < 16; ++r) p1[r] = __builtin_amdgcn_exp2f(p1[r]);
    float ps = 0.f;
#pragma unroll
    for (int r = 0; r < 16; ++r) ps += p0[r];
#pragma unroll
    for (int r = 0; r < 16; ++r) ps += p1[r];
    l_reg = l_reg * alpha + ps;
#define PK4(P, B, OUT) do { u32x4 w = {pk2(P[B + 0], P[B + 1]), pk2(P[B + 2], P[B + 3]), pk2(P[B + 4], P[B + 5]), pk2(P[B + 6], P[B + 7])}; OUT = __builtin_bit_cast(bf16x8, w); } while (0)
    PK4(p0, 0, pa0); PK4(p0, 8, pa1); PK4(p1, 0, pa2); PK4(p1, 8, pa3);
#undef PK4
}
template <int DQK> __device__ __forceinline__ void qkt(f32x16& p0, f32x16& p1, const char* Ks, const bf16x8* qr, int r32, int hi) {
    p0 = f32x16{}; p1 = f32x16{};
#pragma unroll
    for (int d0 = 0; d0 < DQK / 16; ++d0) {
        const bf16x8 b0 = *reinterpret_cast<const bf16x8*>(Ks + kswz<DQK>(r32, 2 * d0 + hi));
        const bf16x8 b1 = *reinterpret_cast<const bf16x8*>(Ks + kswz<DQK>(32 + r32, 2 * d0 + hi));
        p0 = __builtin_amdgcn_mfma_f32_32x32x16_bf16(b0, qr[d0], p0, 0, 0, 0);
        p1 = __builtin_amdgcn_mfma_f32_32x32x16_bf16(b1, qr[d0], p1, 0, 0, 0);
    }
}
template <int DQK, int DV, int SDEPTH>
__device__ __forceinline__ void attn_core(const bf16_t* __restrict__ Qw, int ldq, const bf16_t* __restrict__ K1, int ldk1, const bf16_t* __restrict__ K2, int ldk2,
                                          const bf16_t* __restrict__ Vp, int ldv, int nkeys, char* lds, f32x16 (&o)[DV / 32], float& l_out) {
    constexpr int SHM_V = 64 * DV * 2, SHM_K = KTile<DQK>::BYTES;
    const int tid = tid_now(), wid = tid >> 6, lane = tid & 63, r32 = lane & 31, hi = lane >> 5;
    char* V_lds = lds; char* K_lds = lds + 2 * SHM_V;
    float* al_l = (float*)(lds + 2 * SHM_V + 2 * SHM_K) + wid * 64;
    float m_reg = -1e30f, l_reg = 0.f;
#pragma unroll
    for (int d = 0; d < DV / 32; ++d) o[d] = f32x16{};
    bf16x8 qr[DQK / 16];
    { const bf16_t* q = Qw + (size_t)(wid * 32 + r32) * ldq + hi * 8;
#pragma unroll
      for (int d0 = 0; d0 < DQK / 16; ++d0) qr[d0] = *reinterpret_cast<const bf16x8*>(q + d0 * 16); }
    const int kr_ = tid >> 3, kc_ = tid & 7;
    const int vr_ = DV == 64 ? (tid >> 3) : (tid >> 4), vc_ = DV == 64 ? (tid & 7) * 8 : (tid & 15) * 8;
    const int kst = kswz<DQK>(kr_, kc_);
    const int k2st = DQK == 96 ? kswz<DQK>(kr_, 8 + (kc_ >> 1)) + (kc_ & 1) * 8 : 0;
    const int vst0 = v_st<DV>(vr_, vc_), vst1 = v_st<DV>(32 + vr_, vc_);
    const int vb0 = (int)(uintptr_t)V_lds + v_rd_base(lane);
    struct Slot { bf16x8 k1; u32x2 k2; bf16x8 v0; bf16x8 v1; };
    Slot sE, sO;
#define SLOAD(S, k0) do { (S).k1 = *reinterpret_cast<const bf16x8*>(K1 + (size_t)((k0) + kr_) * ldk1 + kc_ * 8); \
        if constexpr (DQK == 96) (S).k2 = *reinterpret_cast<const u32x2*>(K2 + (size_t)((k0) + kr_) * ldk2 + kc_ * 4); \
        (S).v0 = *reinterpret_cast<const bf16x8*>(Vp + (size_t)((k0) + vr_) * ldv + vc_); \
        if constexpr (DV == 128) (S).v1 = *reinterpret_cast<const bf16x8*>(Vp + (size_t)((k0) + 32 + vr_) * ldv + vc_); } while (0)
#define SWRITE(b, S) do { *reinterpret_cast<bf16x8*>(K_lds + (b) * SHM_K + kst) = (S).k1; \
        if constexpr (DQK == 96) *reinterpret_cast<u32x2*>(K_lds + (b) * SHM_K + k2st) = (S).k2; \
        *reinterpret_cast<bf16x8*>(V_lds + (b) * SHM_V + vst0) = (S).v0; \
        if constexpr (DV == 128) *reinterpret_cast<bf16x8*>(V_lds + (b) * SHM_V + vst1) = (S).v1; } while (0)
#define RESC(a) do { if (__any((a) < 1.f)) { if (hi == 0) al_l[r32] = (a); asm volatile("s_waitcnt lgkmcnt(0)" ::: "memory"); \
        _Pragma("unroll") for (int d = 0; d < DV / 32; ++d) _Pragma("unroll") for (int r = 0; r < 16; ++r) o[d][r] *= al_l[crow(r, hi)]; } } while (0)
    if constexpr (SDEPTH == 0) {
        f32x16 p0, p1; float al; bf16x8 pa0, pa1, pa2, pa3; const int NT = nkeys / 64;
        __syncthreads();
        SLOAD(sE, 0); SWRITE(0, sE); SLOAD(sE, 64); __syncthreads();
#pragma unroll 1
        for (int j = 0; j < NT; ++j) {
            const int b = j & 1;
            SBAR(); qkt<DQK>(p0, p1, K_lds + b * SHM_K, qr, r32, hi);
            partialSM(p0, p1, m_reg, al); RESC(al);
            finishSM(p0, p1, al, l_reg, pa0, pa1, pa2, pa3); SBAR();
            pv_all<DV>(o, vb0 + b * SHM_V, pa0, pa1, pa2, pa3);
            if (j + 1 < NT) { SWRITE(b ^ 1, sE); if (j + 2 < NT) SLOAD(sE, (j + 2) * 64); }
            __syncthreads();
        }
    } else {
    f32x16 pA0, pA1, pB0, pB1; float alA, alB; bf16x8 pa0, pa1, pa2, pa3; const int NT = nkeys / 64;
    __syncthreads();
    SLOAD(sE, 0); SWRITE(0, sE); __syncthreads();
    qkt<DQK>(pA0, pA1, K_lds, qr, r32, hi); partialSM(pA0, pA1, m_reg, alA);
    if constexpr (SDEPTH == 2) { SLOAD(sO, 64); if (2 < NT) SLOAD(sE, 128); SWRITE(1, sO); } else { SLOAD(sE, 64); SWRITE(1, sE); }
    __syncthreads();
#pragma unroll 1
    for (int j = 1; j + 1 < NT; j += 2) {
        SBAR(); qkt<DQK>(pB0, pB1, K_lds + SHM_K, qr, r32, hi);
        finishSM(pA0, pA1, alA, l_reg, pa0, pa1, pa2, pa3); SBAR();
        if constexpr (SDEPTH == 2) SLOAD(sO, (j + 2) * 64); else SLOAD(sE, (j + 1) * 64);
        SBAR();
        pv_all<DV>(o, vb0, pa0, pa1, pa2, pa3); partialSM(pB0, pB1, m_reg, alB);
        __syncthreads(); SWRITE(0, sE);
        RESC(alB); __syncthreads();
        SBAR(); qkt<DQK>(pA0, pA1, K_lds, qr, r32, hi);
        finishSM(pB0, pB1, alB, l_reg, pa0, pa1, pa2, pa3); SBAR();
        if constexpr (SDEPTH == 2) { if (j + 3 < NT) SLOAD(sE, (j + 3) * 64); } else SLOAD(sE, (j + 2) * 64);
        SBAR();
        pv_all<DV>(o, vb0 + SHM_V, pa0, pa1, pa2, pa3); partialSM(pA0, pA1, m_reg, alA);
        __syncthreads(); if constexpr (SDEPTH == 2) SWRITE(1, sO); else SWRITE(1, sE);
        RESC(alA); __syncthreads();
    }
    SBAR(); qkt<DQK>(pB0, pB1, K_lds + SHM_K, qr, r32, hi);
    finishSM(pA0, pA1, alA, l_reg, pa0, pa1, pa2, pa3); SBAR();
    pv_all<DV>(o, vb0, pa0, pa1, pa2, pa3); partialSM(pB0, pB1, m_reg, alB);
    __syncthreads(); RESC(alB);
    finishSM(pB0, pB1, alB, l_reg, pa0, pa1, pa2, pa3); SBAR();
    pv_all<DV>(o, vb0 + SHM_V, pa0, pa1, pa2, pa3);
    }
    { auto rr = __builtin_amdgcn_permlane32_swap(__float_as_uint(l_reg), __float_as_uint(l_reg), false, false);
      l_out = __uint_as_float(rr[0]) + __uint_as_float(rr[1]); }
#undef SLOAD
#undef SWRITE
#undef RESC
}
}
typedef const float __attribute__((address_space(1)))* cfp_t;
constexpr int LDS_TAB = 146432;
struct Frame {
    unsigned char* lds; unsigned char* ws; float* out; const LAS cfp_t* in;
    int tid, lane, wave, vcu, G, bid;
};
#define IN_(k) ((const float*)F.in[k])

__device__ __forceinline__ void tr_item(const float* W, int ldw, int col0, int K, bf16_t* WT, int drow0, int kb, int nb, LAS float* scr, int lane, bool zero) {
    const int k0 = 64 * kb, n0 = 32 * nb;
    if (!zero) {
#pragma unroll 8
        for (int i = 0; i < 32; ++i) { const int kk = 2 * i + (lane >> 5); scr[kk * 33 + (lane & 31)] = W[(size_t)(k0 + kk) * ldw + col0 + n0 + (lane & 31)]; }
    }
    asm volatile("s_waitcnt lgkmcnt(0)" ::: "memory");
    const int c = lane & 7;
#pragma unroll
    for (int j = 0; j < 4; ++j) { const int n = (lane >> 3) + 8 * j; const LAS float* s = scr + (8 * c) * 33 + n;
        u32x4 o; o.x = pk2(s[0 * 33], s[1 * 33]); o.y = pk2(s[2 * 33], s[3 * 33]); o.z = pk2(s[4 * 33], s[5 * 33]); o.w = pk2(s[6 * 33], s[7 * 33]);
        if (zero) o = (u32x4){0u, 0u, 0u, 0u};
        *(u32x4*)(WT + (size_t)(drow0 + n0 + n) * K + k0 + 8 * c) = o; }
    asm volatile("s_waitcnt lgkmcnt(0)" ::: "memory");
}
__device__ __forceinline__ int win_src_col(int r) {
    if (r < 512) return r;
    if (r < 896) return 1024 + (r - 512);
    if (r < 1152) return 1408 + (r - 896);
    if (r < 1184) return 1664;
    if (r < 1280) return -1;
    if (r < 1792) return 2208 + (r - 1280);
    if (r < 2304) return 2720 + (r - 1792);
    if (r < 2816) return 3232 + (r - 2304);
    if (r < 3328) return 512 + (r - 2816);
    if (r < 3840) return 1696 + (r - 3328);
    if (r < 4352) return 3744 + (r - 3840);
    return 4256 + (r - 4352);
}
__device__ __forceinline__ void convert_weights(Frame& F, int l) {
    LAS float* scr = (LAS float*)(F.lds) + F.wave * 2176;
    unsigned char* Wb = F.ws + WS_W;
    const int gw = F.vcu * 8 + F.wave, NGW = F.G * 8;
    constexpr int I_IN = 16 * 232, I_UQ = 6 * 24, I_UKV = 4 * 32, I_BR = 8 * 32, I_OUT = 16 * 32, I_RG = 64;
    constexpr int NITEMS = I_IN + I_UQ + I_UKV + 3 * I_BR + I_OUT + I_RG;
    for (int it = gw; it < NITEMS; it += NGW) {
        int r = it;
        if (r < I_IN) { const int db = r % 232, kb = r / 232; const int sc = win_src_col(db * 32);
            tr_item(IN_(13) + (size_t)l * 1024 * IN_COLS, IN_COLS, sc < 0 ? 0 : sc, 1024, (bf16_t*)(Wb + W_IN), db * 32, kb, 0, scr, F.lane, sc < 0); continue; } r -= I_IN;
        if (r < I_UQ) { tr_item(IN_(22) + (size_t)l * 384 * 768, 768, 0, 384, (bf16_t*)(Wb + W_UQ), 0, r / 24, r % 24, scr, F.lane, false); continue; } r -= I_UQ;
        if (r < I_UKV) { tr_item(IN_(24) + (size_t)l * 256 * 1024, 1024, 0, 256, (bf16_t*)(Wb + W_UKV), 0, r / 32, r % 32, scr, F.lane, false); continue; } r -= I_UKV;
        if (r < 3 * I_BR) { const int b = r / I_BR, q = r % I_BR;
            tr_item((b == 0 ? IN_(30) : b == 1 ? IN_(31) : IN_(32)) + (size_t)l * 512 * 1024, 1024, 0, 512, (bf16_t*)(Wb + W_BR), b * 1024, q / 32, q % 32, scr, F.lane, false); continue; } r -= 3 * I_BR;
        if (r < I_OUT) { tr_item(IN_(33) + (size_t)l * 1024 * 1024, 1024, 0, 1024, (bf16_t*)(Wb + W_OUT), 0, r / 32, r % 32, scr, F.lane, false); continue; } r -= I_OUT;
        { const int mat = r >> 1, nb = r & 1, gate = mat >> 4, dn = mat & 15;
          const float* src = (gate ? IN_(18) : IN_(16)) + ((size_t)l * 16 + dn) * 4096;
          const int d = dn >> 3, n = dn & 7;
          tr_item(src, 64, 0, 64, (bf16_t*)(Wb + W_RG) + (size_t)((d * 2 + gate) * 8 + n) * 4096, 0, 0, nb, scr, F.lane, false); }
    }
}
__device__ __forceinline__ void phase0_mod_rope(Frame& F) {
    float* mod = (float*)(F.ws + CTL_MOD);
    if (F.bid < 96) {
        const int l = F.bid / 48, c0 = (F.bid % 48) * 64;
        LAS float* sc = (LAS float*)F.lds + 8 * 2176;
        LAS float* red = sc + 9 * 1024;
        for (int i = F.tid; i < 9 * 1024; i += NTHREADS) { const int g = i >> 10, k = i & 1023; const float x = g == 0 ? IN_(8)[k] : IN_(7)[(g - 1) * 1024 + k]; sc[i] = siluf_(x); }
        __syncthreads();
        float a[9];
#pragma unroll
        for (int g = 0; g < 9; ++g) a[g] = 0.f;
        const float* w = IN_(9) + (size_t)l * 1024 * 3072 + c0 + F.lane;
        for (int k = F.wave * 128; k < F.wave * 128 + 128; ++k) { const float wv = w[(size_t)k * 3072];
#pragma unroll
            for (int g = 0; g < 9; ++g) a[g] += sc[g * 1024 + k] * wv; }
#pragma unroll
        for (int g = 0; g < 9; ++g) red[(F.wave * 9 + g) * 64 + F.lane] = a[g];
        __syncthreads();
        for (int i = F.tid; i < 9 * 64; i += NTHREADS) { const int g = i >> 6, c = i & 63; float s = IN_(10)[l * 3072 + c0 + c];
#pragma unroll
            for (int wv = 0; wv < 8; ++wv) s += red[(wv * 9 + g) * 64 + c];
            mod[((size_t)l * 9 + g) * 3072 + c0 + c] = s; }
        __syncthreads();
    } else if (F.bid == 96) {
        float* rp = (float*)(F.ws + CTL_ROPE);
        for (int i = F.tid; i < 64 * 8; i += NTHREADS) { const int pos = i >> 3, j = i & 7; const float ang = (float)pos * powf(10000.0f, -(float)j / 8.0f); rp[i] = cosf(ang); rp[512 + i] = sinf(ang); }
        for (int i = F.tid; i < 64 * 16; i += NTHREADS) { const int pos = i >> 4, j = i & 15; const float ang = (float)pos * powf(10000.0f, -(float)j / 16.0f); rp[1024 + i] = cosf(ang); rp[2048 + i] = sinf(ang); }
    }
}
__device__ __forceinline__ const float* x_row_l0(Frame& F, int r) { return r < NP ? IN_(0) + (size_t)r * DM : IN_(1) + (size_t)(r - NP) * DM; }
__device__ __forceinline__ void prenorm_store(Frame& F, const f32x4* v, int r, int l) {
    float s = 0.f;
#pragma unroll
    for (int j = 0; j < 4; ++j) s += (v[j].x * v[j].x + v[j].y * v[j].y) + (v[j].z * v[j].z + v[j].w * v[j].w);
    const float rstd = 1.0f / sqrtf(wave_sum(s) * (1.0f / DM) + EPS);
    const float* mod = (const float*)(F.ws + CTL_MOD) + ((size_t)l * 9 + grp_of(r)) * 3072;
    const float* gp = IN_(11) + l * DM;
    bf16_t* h = (bf16_t*)(F.ws + WS_H) + (size_t)r * DM;
#pragma unroll
    for (int j = 0; j < 4; ++j) { const int c = 4 * F.lane + 256 * j;
        const f32x4 g = *(const f32x4*)(gp + c), sh = *(const f32x4*)(mod + c), sc = *(const f32x4*)(mod + 1024 + c);
        const f32x4 y = (v[j] * rstd * g) * (sc + 1.0f) + sh;
        u32x2 w; w.x = pk2(y.x, y.y); w.y = pk2(y.z, y.w); *(u32x2*)(h + c) = w; }
}
__device__ __forceinline__ void phase0_h(Frame& F) {
    const int gw = F.vcu * 8 + F.wave, NGW = F.G * 8;
    for (int r = gw; r < NTOK; r += NGW) { const f32x4* xr = (const f32x4*)x_row_l0(F, r) + F.lane; f32x4 v[4];
#pragma unroll
        for (int j = 0; j < 4; ++j) v[j] = xr[64 * j];
        prenorm_store(F, v, r, 0); }
}
__device__ __forceinline__ void phase_post(Frame& F, int l) {
    const int gw = F.vcu * 8 + F.wave, NGW = F.G * 8;
    const bf16_t* O = (const bf16_t*)(F.ws + WS_A + A_O);
    const float* ssq = (const float*)(F.ws + CTL_SSQ);
    const float* gpost = IN_(12) + l * DM;
    for (int r = gw; r < NTOK; r += NGW) {
        float sq = F.lane < 16 ? ssq[(size_t)r * 16 + F.lane] : 0.f;
        const float rstd = 1.0f / sqrtf(wave_sum(sq) * (1.0f / DM) + EPS);
        const float* xin = l == 0 ? x_row_l0(F, r) : F.out + O_Y + (size_t)r * DM;
        float* xo = F.out + O_Y + (size_t)r * DM;
        const float* gate = (const float*)(F.ws + CTL_MOD) + ((size_t)l * 9 + grp_of(r)) * 3072 + 2048;
        f32x4 v[4];
#pragma unroll
        for (int j = 0; j < 4; ++j) { const int c = 4 * F.lane + 256 * j;
            const u32x2 ow = *(const u32x2*)(O + (size_t)r * DM + c);
            const f32x4 o = {bflo(ow.x), bfhi(ow.x), bflo(ow.y), bfhi(ow.y)};
            const f32x4 x = *(const f32x4*)(xin + c), g = *(const f32x4*)(gpost + c), gt = *(const f32x4*)(gate + c);
            v[j] = x + gt * (o * rstd * g);
            *(f32x4*)(xo + c) = v[j]; }
        if (l == 0) prenorm_store(F, v, r, 1);
    }
}
constexpr int RN_XB = 0;
constexpr int RN_XF = 36864;
constexpr int RN_AA = RN_XF + 16384;
constexpr int RN_BB = RN_AA + 16384;
constexpr int RN_SEG = RN_BB + 16384;
constexpr int RN_CAR = RN_SEG + 4096;
__device__ __forceinline__ void rnn_item(Frame& F, int l, int seq, int n, int qt) {
    const bool dec = seq >= 32;
    const int S = dec ? 2048 : 256, tok0 = dec ? NP + (seq - 32) * 2048 : seq * 256, nck = S / 256;
    const int tid = F.tid, lane = F.lane, wave = F.wave;
    const bf16_t* RX = (const bf16_t*)(F.ws + WS_Y + 2 * Y_SLOT);
    bf16_t* HS = (bf16_t*)(F.ws + WS_Y);
    unsigned char* L = F.lds;
    const int oc0 = n * 64 + qt * 16;
    const float* cw = IN_(14) + (size_t)l * 4 * 512; const float* cb = IN_(15) + l * 512;
    const int tl = tid >> 1, chh = tid & 1;
    const int sj = tid & 15, sseg = tid >> 4;
    for (int dir = 0; dir < 2; ++dir) {
        const int jc = lane & 15;
        const float ba = IN_(17)[(l * 2 + dir) * 512 + oc0 + jc], bx = IN_(19)[(l * 2 + dir) * 512 + oc0 + jc];
        const float lam = IN_(20)[(l * 2 + dir) * 512 + oc0 + jc];
        const float sp8 = -8.0f * log1pf(__expf(-lam));
        const bf16_t* wt = (const bf16_t*)(F.ws + WS_W + W_RG);
        bf16x8 wa[2], wx[2];
#pragma unroll
        for (int ks = 0; ks < 2; ++ks) {
            wa[ks] = *(const bf16x8*)(wt + (size_t)((dir * 2 + 0) * 8 + n) * 4096 + (qt * 16 + jc) * 64 + ks * 32 + (lane >> 4) * 8);
            wx[ks] = *(const bf16x8*)(wt + (size_t)((dir * 2 + 1) * 8 + n) * 4096 + (qt * 16 + jc) * 64 + ks * 32 + (lane >> 4) * 8); }
        __syncthreads();
        if (tid < 16) ((float*)(L + RN_CAR))[tid] = dec ? IN_(6)[(((seq - 32) * 2 + l) * 2 + dir) * 512 + oc0 + tid] : 0.f;
        for (int cc = 0; cc < nck; ++cc) {
            const int ci = dir == 0 ? cc : nck - 1 - cc, c0 = ci * 256;
            {
#pragma unroll
                for (int g8 = 0; g8 < 4; ++g8) {
                    const int ch = chh * 32 + g8 * 8;
                    float acc8[8];
                    { const f32x4 b0 = *(const f32x4*)(cb + n * 64 + ch), b1 = *(const f32x4*)(cb + n * 64 + ch + 4);
                      acc8[0] = b0.x; acc8[1] = b0.y; acc8[2] = b0.z; acc8[3] = b0.w; acc8[4] = b1.x; acc8[5] = b1.y; acc8[6] = b1.z; acc8[7] = b1.w; }
#pragma unroll
                    for (int k = 0; k < 4; ++k) { const int t = c0 + tl - 2 + k;
                        if (t >= 0 && t < S) { float xv[8]; unpack8(*(const u32x4*)(RX + (size_t)(tok0 + t) * 512 + n * 64 + ch), xv);
                            const f32x4 w0 = *(const f32x4*)(cw + k * 512 + n * 64 + ch), w1 = *(const f32x4*)(cw + k * 512 + n * 64 + ch + 4);
                            acc8[0] += xv[0] * w0.x; acc8[1] += xv[1] * w0.y; acc8[2] += xv[2] * w0.z; acc8[3] += xv[3] * w0.w;
                            acc8[4] += xv[4] * w1.x; acc8[5] += xv[5] * w1.y; acc8[6] += xv[6] * w1.z; acc8[7] += xv[7] * w1.w; } }
                    *(u32x4*)(L + RN_XB + tl * 144 + ch * 2) = pack8(acc8);
                    if ((ch >> 4) == qt) { float* xf = (float*)(L + RN_XF) + tl * 16 + (ch & 15);
                        *(f32x4*)xf = (f32x4){acc8[0], acc8[1], acc8[2], acc8[3]}; *(f32x4*)(xf + 4) = (f32x4){acc8[4], acc8[5], acc8[6], acc8[7]}; }
                }
            }
            __syncthreads();
            {
#pragma unroll
                for (int rb = 0; rb < 2; ++rb) {
                    f32x4 ga = {0.f, 0.f, 0.f, 0.f}, gx = {0.f, 0.f, 0.f, 0.f};
#pragma unroll
                    for (int ks = 0; ks < 2; ++ks) {
                        const bf16x8 af = *(const bf16x8*)(L + RN_XB + (wave * 32 + rb * 16 + (lane & 15)) * 144 + (ks * 32 + (lane >> 4) * 8) * 2);
                        ga = __builtin_amdgcn_mfma_f32_16x16x32_bf16(af, wa[ks], ga, 0, 0, 0);
                        gx = __builtin_amdgcn_mfma_f32_16x16x32_bf16(af, wx[ks], gx, 0, 0, 0);
                    }
#pragma unroll
                    for (int i = 0; i < 4; ++i) { const int t = wave * 32 + rb * 16 + 4 * (lane >> 4) + i;
                        const float r = sigmoidf_(ga[i] + ba), ig = sigmoidf_(gx[i] + bx);
                        const float la = sp8 * r, a = __expf(la);
                        const float xc = ((const float*)(L + RN_XF))[t * 16 + jc];
                        const float b = sqrtf(-expm1f(2.0f * la)) * (ig * xc);
                        ((float*)(L + RN_AA))[t * 16 + jc] = a; ((float*)(L + RN_BB))[t * 16 + jc] = b; }
                }
            }
            __syncthreads();
            const float* AA = (const float*)(L + RN_AA); const float* BB = (const float*)(L + RN_BB); float* SG = (float*)(L + RN_SEG);
            float av[8], bv[8];
#pragma unroll
            for (int i = 0; i < 8; ++i) { const int t = dir == 0 ? sseg * 8 + i : sseg * 8 + 7 - i; av[i] = AA[t * 16 + sj]; bv[i] = BB[t * 16 + sj]; }
            { float A = 1.f, B = 0.f;
#pragma unroll
              for (int i = 0; i < 8; ++i) { A *= av[i]; B = av[i] * B + bv[i]; }
              SG[sseg * 16 + sj] = A; SG[512 + sseg * 16 + sj] = B; }
            __syncthreads();
            float h = ((const float*)(L + RN_CAR))[sj];
            if (dir == 0) { for (int s = 0; s < sseg; ++s) h = SG[s * 16 + sj] * h + SG[512 + s * 16 + sj]; }
            else { for (int s = 31; s > sseg; --s) h = SG[s * 16 + sj] * h + SG[512 + s * 16 + sj]; }
#pragma unroll
            for (int i = 0; i < 8; ++i) { const int t = dir == 0 ? sseg * 8 + i : sseg * 8 + 7 - i;
                h = av[i] * h + bv[i];
                bf16_t* hp = HS + (size_t)(tok0 + c0 + t) * 512 + oc0 + sj;
                float hv = h; if (dir == 1) hv += bf2f(*hp);
                *hp = (bf16_t)(pk2(hv, 0.f) & 0xffffu); }
            __syncthreads();
            if (sseg == (dir == 0 ? 31 : 0)) {
                ((float*)(L + RN_CAR))[sj] = h;
                if (!dec && cc == nck - 1) F.out[O_ST + ((size_t)(seq * 2 + l) * 2 + dir) * 512 + oc0 + sj] = h;
            }
        }
    }
    __syncthreads();
}
__device__ __forceinline__ void phase_rnn_prep(Frame& F, int l) {
#pragma unroll 1
    for (int k = 0; k < 5; ++k) {
        int seq, n, qt;
        if (k == 0) { const int v = F.vcu; seq = 32 + (v >> 5); n = (v & 31) >> 2; qt = v & 3; }
        else { const int p = F.vcu * 4 + k - 1; seq = p >> 5; n = (p & 31) >> 2; qt = p & 3; }
        rnn_item(F, l, seq, n, qt);
    }
    const int gw = F.vcu * 8 + F.wave, NGW = F.G * 8, lane = F.lane;
    bf16_t* CQ = (bf16_t*)(F.ws + WS_Y + Y_SLOT); bf16_t* CKV = (bf16_t*)(F.ws + WS_A + A_CKV); bf16_t* KR = (bf16_t*)(F.ws + WS_A + A_KR);
    const float* qn = IN_(21) + l * 384; const float* kn = IN_(23) + l * 256;
    for (int r = gw; r < NTOK; r += NGW) {
        float q[8], c[8]; float sq = 0.f, sc = 0.f;
        bf16_t* qp = CQ + (size_t)r * 384 + lane * 8; bf16_t* cp = CKV + (size_t)kvrow_of(r) * 256 + lane * 8;
        if (lane < 48) { unpack8(*(const u32x4*)qp, q);
#pragma unroll
            for (int i = 0; i < 8; ++i) sq += q[i] * q[i]; }
        if (lane < 32) { unpack8(*(const u32x4*)cp, c);
#pragma unroll
            for (int i = 0; i < 8; ++i) sc += c[i] * c[i]; }
        const float rq = 1.0f / sqrtf(wave_sum(sq) * (1.0f / 384.0f) + EPS), rc = 1.0f / sqrtf(wave_sum(sc) * (1.0f / 256.0f) + EPS);
        if (lane < 48) {
#pragma unroll
            for (int i = 0; i < 8; ++i) q[i] = q[i] * rq * qn[lane * 8 + i];
            *(u32x4*)qp = pack8(q); }
        if (lane < 32) {
#pragma unroll
            for (int i = 0; i < 8; ++i) c[i] = c[i] * rc * kn[lane * 8 + i];
            *(u32x4*)cp = pack8(c);
            if (r < NP) st_f32x8(F.out + O_CKV + (size_t)cache_row(r, l) * 256 + lane * 8, c); }
    }
    for (int i = gw; i < 4096; i += NGW) { const int b = i >> 9, j = i & 511; const int kvr = NP + b * 2560 + j;
        const float* s1 = IN_(2) + ((size_t)(b * 2 + l) * 512 + j) * 256;
        if (lane < 32) { const f32x4 a = *(const f32x4*)(s1 + lane * 8), bq = *(const f32x4*)(s1 + lane * 8 + 4); const float v[8] = {a.x, a.y, a.z, a.w, bq.x, bq.y, bq.z, bq.w};
            *(u32x4*)(CKV + (size_t)kvr * 256 + lane * 8) = pack8(v); }
        const float* s2 = IN_(3) + ((size_t)(b * 2 + l) * 512 + j) * 32;
        if (lane < 4) { const f32x4 a = *(const f32x4*)(s2 + lane * 8), bq = *(const f32x4*)(s2 + lane * 8 + 4); const float v[8] = {a.x, a.y, a.z, a.w, bq.x, bq.y, bq.z, bq.w};
            *(u32x4*)(KR + (size_t)kvr * 32 + lane * 8) = pack8(v); }
    }
}
__device__ __forceinline__ void convert_diff_ctx(Frame& F, int l) {
    const int gw = F.vcu * 8 + F.wave, NGW = F.G * 8, lane = F.lane;
    bf16_t* DK = (bf16_t*)(F.ws + WS_A + A_DK); bf16_t* DV = (bf16_t*)(F.ws + WS_A + A_DV);
    for (int i = gw; i < 8192; i += NGW) { const int which = i >> 12, b = (i >> 9) & 7, j = i & 511; const int kvr = NP + b * 2560 + j;
        const float* s = (which ? IN_(5) : IN_(4)) + ((size_t)(b * 2 + l) * 512 + j) * 512 + lane * 8;
        const f32x4 a = *(const f32x4*)s, bq = *(const f32x4*)(s + 4); const float v[8] = {a.x, a.y, a.z, a.w, bq.x, bq.y, bq.z, bq.w};
        *(u32x4*)((which ? DV : DK) + (size_t)kvr * 512 + lane * 8) = pack8(v); }
}
constexpr int ATT_STASH = 65536;
#ifndef ATT_SDEPTH_M
#define ATT_SDEPTH_M 1
#endif
#ifndef ATT_SDEPTH_D
#define ATT_SDEPTH_D 0
#endif
__device__ __forceinline__ void mla_unit(Frame& F, int tok0, int kv0, int nkeys, int h) {
    const bf16_t* Q = (const bf16_t*)(F.ws + WS_A + A_Q); const bf16_t* KV = (const bf16_t*)(F.ws + WS_A + A_KV); const bf16_t* KR = (const bf16_t*)(F.ws + WS_A + A_KR);
    bf16_t* OM = (bf16_t*)(F.ws + WS_Y + Y_SLOT);
    f32x16 o[2]; float l;
    att::attn_core<96, 64, ATT_SDEPTH_M>(Q + (size_t)tok0 * 768 + h * 96, 768, KV + (size_t)kv0 * 1024 + h * 128, 1024, KR + (size_t)kv0 * 32, 32,
                           KV + (size_t)kv0 * 1024 + h * 128 + 64, 1024, nkeys, (char*)F.lds, o, l);
    const int lane = F.lane, r32 = lane & 31, hi = lane >> 5;
    float* li = (float*)(F.lds + 2 * 8192 + 2 * 16384) + F.wave * 64 + 32;
    if (hi == 0) li[r32] = l;
    asm volatile("s_waitcnt lgkmcnt(0)" ::: "memory");
#pragma unroll
    for (int r = 0; r < 16; ++r) { const int q = att::crow(r, hi); const float rl = __builtin_amdgcn_rcpf(li[q]);
        bf16_t* op = OM + (size_t)(tok0 + F.wave * 32 + q) * 512 + h * 64 + r32;
#pragma unroll
        for (int d = 0; d < 2; ++d) op[d * 32] = (bf16_t)(pk2(o[d][r] * rl, 0.f) & 0xffffu); }
}
__device__ __forceinline__ void phase_mla(Frame& F) {
    const int x = F.vcu >> 5, j = F.vcu & 31;
#pragma unroll 1
    for (int u = 0; u < 3; ++u) {
        int tok0, kv0, nkeys, h;
        if (u < 2) { const int idx = j * 2 + u, pair = x * 8 + (idx >> 3), qb = idx & 7, b = pair >> 3; h = pair & 7; tok0 = NP + b * 2048 + qb * 256; kv0 = NP + b * 2560; nkeys = 2560; }
        else { const int b = F.vcu >> 3; h = F.vcu & 7; tok0 = b * 256; kv0 = b * 256; nkeys = 256; }
        mla_unit(F, tok0, kv0, nkeys, h);
    }
}
__device__ __forceinline__ void diff_pass(Frame& F, int l, int tok0, int kv0, int nkeys, int h, int pass, float lam, float lam_init) {
    const bf16_t* DQ = (const bf16_t*)(F.ws + WS_A + A_DQ); const bf16_t* DK = (const bf16_t*)(F.ws + WS_A + A_DK); const bf16_t* DV = (const bf16_t*)(F.ws + WS_A + A_DV);
    bf16_t* OD = (bf16_t*)(F.ws + WS_Y + 2 * Y_SLOT);
    const int lane = F.lane, r32 = lane & 31, hi = lane >> 5;
    float* li = (float*)(F.lds + 2 * 16384 + 2 * 8192) + F.wave * 64 + 32;
    unsigned* stash = (unsigned*)(F.lds + ATT_STASH + F.wave * 8192);
    f32x16 o[4]; float lsum;
    const int coff = h * 128 + (pass == 0 ? 64 : 0);
    att::attn_core<64, 128, ATT_SDEPTH_D>(DQ + (size_t)tok0 * 512 + coff, 512, DK + (size_t)kv0 * 512 + coff, 512, nullptr, 0,
                            DV + (size_t)kv0 * 512 + h * 128, 512, nkeys, (char*)F.lds, o, lsum);
    if (hi == 0) li[r32] = lsum;
    asm volatile("s_waitcnt lgkmcnt(0)" ::: "memory");
    if (pass == 0) {
#pragma unroll
        for (int r = 0; r < 16; r += 2) { const float rl0 = lam * __builtin_amdgcn_rcpf(li[att::crow(r, hi)]), rl1 = lam * __builtin_amdgcn_rcpf(li[att::crow(r + 1, hi)]);
#pragma unroll
            for (int d = 0; d < 4; ++d) stash[(d * 8 + (r >> 1)) * 64 + lane] = pk2(o[d][r] * rl0, o[d][r + 1] * rl1); }
        asm volatile("s_waitcnt lgkmcnt(0)" ::: "memory");
    } else {
        const float* dn = IN_(29) + l * 128;
        const float g0 = dn[r32], g1 = dn[32 + r32], g2 = dn[64 + r32], g3 = dn[96 + r32];
#pragma unroll
        for (int r = 0; r < 16; r += 2) {
            const float rl0 = __builtin_amdgcn_rcpf(li[att::crow(r, hi)]), rl1 = __builtin_amdgcn_rcpf(li[att::crow(r + 1, hi)]);
            float e0[4], e1[4]; float s0 = 0.f, s1 = 0.f;
#pragma unroll
            for (int d = 0; d < 4; ++d) { const unsigned w = stash[(d * 8 + (r >> 1)) * 64 + lane];
                e0[d] = o[d][r] * rl0 - bflo(w); e1[d] = o[d][r + 1] * rl1 - bfhi(w); s0 += e0[d] * e0[d]; s1 += e1[d] * e1[d]; }
#pragma unroll
            for (int m = 1; m < 32; m <<= 1) { s0 += __shfl_xor(s0, m); s1 += __shfl_xor(s1, m); }
            const float k0 = (1.0f - lam_init) / sqrtf(s0 * (1.0f / 128.0f) + EPS), k1 = (1.0f - lam_init) / sqrtf(s1 * (1.0f / 128.0f) + EPS);
            bf16_t* p0 = OD + (size_t)(tok0 + F.wave * 32 + att::crow(r, hi)) * 512 + h * 128 + r32;
            bf16_t* p1 = OD + (size_t)(tok0 + F.wave * 32 + att::crow(r + 1, hi)) * 512 + h * 128 + r32;
            p0[0] = (bf16_t)(pk2(e0[0] * k0 * g0, 0.f) & 0xffffu); p0[32] = (bf16_t)(pk2(e0[1] * k0 * g1, 0.f) & 0xffffu);
            p0[64] = (bf16_t)(pk2(e0[2] * k0 * g2, 0.f) & 0xffffu); p0[96] = (bf16_t)(pk2(e0[3] * k0 * g3, 0.f) & 0xffffu);
            p1[0] = (bf16_t)(pk2(e1[0] * k1 * g0, 0.f) & 0xffffu); p1[32] = (bf16_t)(pk2(e1[1] * k1 * g1, 0.f) & 0xffffu);
            p1[64] = (bf16_t)(pk2(e1[2] * k1 * g2, 0.f) & 0xffffu); p1[96] = (bf16_t)(pk2(e1[3] * k1 * g3, 0.f) & 0xffffu);
        }
    }
}
__device__ __forceinline__ void phase_diff(Frame& F, int l) {
    const float lam_init = 0.8f - 0.6f * expf(-0.3f * (float)l);
    const float d1 = wave_sum(IN_(25)[l * 64 + F.lane] * IN_(26)[l * 64 + F.lane]), d2 = wave_sum(IN_(27)[l * 64 + F.lane] * IN_(28)[l * 64 + F.lane]);
    const float lam = expf(d1) - expf(d2) + lam_init;
    const int x = F.vcu >> 5, j = F.vcu & 31;
    const int nsteps = (F.vcu & 1) == 0 ? 4 : 2;
#pragma unroll 1
    for (int st = 0; st < nsteps; ++st) {
        int tok0, kv0, nkeys, h;
        if (st < 2) { const int pair = x * 4 + (j >> 3), qb = j & 7, b = pair >> 2; h = pair & 3; tok0 = NP + b * 2048 + qb * 256; kv0 = NP + b * 2560; nkeys = 2560; }
        else { const int p = F.vcu >> 1, b = p >> 2; h = p & 3; tok0 = b * 256; kv0 = b * 256; nkeys = 256; }
        diff_pass(F, l, tok0, kv0, nkeys, h, st & 1, lam, lam_init);
    }
}
#define GEMM_CALL(EPI, SCHED, g, S, E) pg8::gemm_phase<EPI, SCHED, true, true>((PG8_LAS unsigned char*)F.lds, g, S, E)
struct BrOrder {
    int c, half;
    __device__ __forceinline__ bool next(int i, pg8::Unit& u) const { if (c >= 192 || i >= 3) return false; u.pm = i * 96 + half * 48 + (c >> 2); u.pn = i * 4 + (c & 3); return true; }
    __device__ __forceinline__ void a_ready(const pg8::Unit&) const {}
    __device__ __forceinline__ void done(const pg8::Unit&) const {}
};
__device__ __forceinline__ void phase_g1(Frame& F, int l) {
    pg8::Gemm g{(const bf16_t*)(F.ws + WS_H), (const bf16_t*)(F.ws + WS_W + W_IN), NTOK, 1280, 1024};
    pg8::StaticOrder S; S.init(NTOK, 1280, F.G, F.bid);
    EpiG1 E{(bf16_t*)(F.ws + WS_Y + 2 * Y_SLOT), (bf16_t*)(F.ws + WS_Y + Y_SLOT), (bf16_t*)(F.ws + WS_A + A_CKV), (bf16_t*)(F.ws + WS_A + A_KR),
            F.out + O_KR, (const float*)(F.ws + CTL_ROPE), l};
    GEMM_CALL(EpiG1, pg8::StaticOrder, g, S, E);
}
__device__ __forceinline__ void phase_g2(Frame& F) {
    { pg8::Gemm g{(const bf16_t*)(F.ws + WS_Y + Y_SLOT), (const bf16_t*)(F.ws + WS_W + W_UQ), NTOK, 768, 384};
      pg8::StaticOrder S; S.init(NTOK, 768, F.G, F.bid);
      EpiQ E{(bf16_t*)(F.ws + WS_A + A_Q), (const float*)(F.ws + CTL_ROPE)};
      GEMM_CALL(EpiQ, pg8::StaticOrder, g, S, E); }
    { pg8::Gemm g{(const bf16_t*)(F.ws + WS_A + A_CKV), (const bf16_t*)(F.ws + WS_W + W_UKV), NKV, 1024, 256};
      pg8::StaticOrder S; S.init(NKV, 1024, F.G, (F.bid + F.G - (288 % F.G)) % F.G);
      EpiPlain E{(bf16_t*)(F.ws + WS_A + A_KV), 1024};
      GEMM_CALL(EpiPlain, pg8::StaticOrder, g, S, E); }
}
__device__ __forceinline__ void phase_g3(Frame& F, int l) {
    convert_diff_ctx(F, l);
    pg8::Gemm g{(const bf16_t*)(F.ws + WS_H), (const bf16_t*)(F.ws + WS_W + W_IN) + (size_t)1280 * 1024, NTOK, 1536, 1024};
    pg8::StaticOrder S; S.init(NTOK, 1536, F.G, F.bid);
    EpiG3 E{(bf16_t*)(F.ws + WS_A + A_DQ), (bf16_t*)(F.ws + WS_A + A_DK), (bf16_t*)(F.ws + WS_A + A_DV), F.out + O_DK, F.out + O_DV, (const float*)(F.ws + CTL_ROPE) + 1024, l};
    GEMM_CALL(EpiG3, pg8::StaticOrder, g, S, E);
}
__device__ __forceinline__ void phase_g4(Frame& F, int half) {
    pg8::Gemm g{(const bf16_t*)(F.ws + WS_H) + (size_t)half * HALF_TOK * 1024, (const bf16_t*)(F.ws + WS_W + W_IN) + (size_t)2816 * 1024, HALF_TOK, 4608, 1024};
    pg8::StaticOrder S; S.init(HALF_TOK, 4608, F.G, F.bid);
    EpiG4 E{(bf16_t*)(F.ws + WS_Y), (bf16_t*)(F.ws + WS_A + A_G), half * HALF_TOK};
    GEMM_CALL(EpiG4, pg8::StaticOrder, g, S, E);
}
__device__ __forceinline__ void phase_g5(Frame& F, int half) {
    pg8::Gemm g{(const bf16_t*)(F.ws + WS_Y), (const bf16_t*)(F.ws + WS_W + W_BR), 3 * NTOK, 3072, 512};
    BrOrder S{F.bid, half};
    EpiG5 E{(const bf16_t*)(F.ws + WS_A + A_G), (bf16_t*)(F.ws + WS_H), half};
    GEMM_CALL(EpiG5, BrOrder, g, S, E);
}
__device__ __forceinline__ void phase_g6(Frame& F) {
    pg8::Gemm g{(const bf16_t*)(F.ws + WS_H), (const bf16_t*)(F.ws + WS_W + W_OUT), NTOK, 1024, 1024};
    pg8::StaticOrder S; S.init(NTOK, 1024, F.G, F.bid);
    EpiG6 E{(bf16_t*)(F.ws + WS_A + A_O), (float*)(F.ws + CTL_SSQ)};
    GEMM_CALL(EpiG6, pg8::StaticOrder, g, S, E);
}

constexpr int NPHASES = 2 + 2 * 12;
__global__ void __launch_bounds__(NTHREADS, 2) hybrid_step_megakernel(Params p) {
    extern __shared__ __attribute__((aligned(16))) unsigned char lds[];
    cg::grid_group grid = cg::this_grid();
    if (threadIdx.x < 34) ((LAS cfp_t*)(lds + LDS_TAB))[threadIdx.x] = (cfp_t)p.in[threadIdx.x];
    __syncthreads();
#pragma unroll 1
    for (int ph = 0; ph < NPHASES; ++ph) {
        const int l = ph < 2 ? 0 : (ph - 2) / 12, k = ph < 2 ? ph : 2 + (ph - 2) % 12;
#define FRAME() int zv, zs; asm volatile("v_mov_b32 %0, 0" : "=v"(zv)); asm volatile("s_mov_b32 %0, 0" : "=s"(zs)); Frame F; \
        F.lds = lds; F.ws = p.ws + zs; F.out = p.out + zs; F.in = (const LAS cfp_t*)(lds + LDS_TAB); \
        F.tid = threadIdx.x + zv; F.lane = F.tid & 63; F.wave = __builtin_amdgcn_readfirstlane(F.tid >> 6); \
        F.G = gridDim.x; F.bid = blockIdx.x + zs; F.vcu = (F.bid % 8) * (F.G / 8) + F.bid / 8;
        switch (k) {
            case 0: { FRAME(); phase0_mod_rope(F); convert_weights(F, 0); } break;
            case 1: { FRAME(); phase0_h(F); } break;
            case 2: { FRAME(); phase_g1(F, l); } break;
            case 3: { FRAME(); phase_rnn_prep(F, l); } break;
            case 4: { FRAME(); phase_g2(F); } break;
            case 5: { FRAME(); phase_mla(F); } break;
            case 6: { FRAME(); phase_g3(F, l); } break;
            case 7: { FRAME(); phase_diff(F, l); } break;
            case 8: { FRAME(); phase_g4(F, 0); } break;
            case 9: { FRAME(); phase_g5(F, 0); } break;
            case 10: { FRAME(); phase_g4(F, 1); } break;
            case 11: { FRAME(); phase_g5(F, 1); } break;
            case 12: { FRAME(); phase_g6(F); } break;
            default: { FRAME(); phase_post(F, l); if (l == 0) convert_weights(F, 1); } break;
        }
#undef FRAME
        if (ph + 1 < NPHASES) grid.sync();
    }
}

extern "C" void kernel_launch(void* const* d_in, const int* in_sizes, int n_in, void* d_out, int out_size, void* d_ws, size_t ws_size, hipStream_t stream) {
    static int grid = 0;
    if (grid == 0) {
        if (n_in != 34 || out_size != (int)O_TOTAL || ws_size < WS_END) { fprintf(stderr, "kernel_launch: unexpected shapes: n_in %d out %d ws %zu (need >= %zu)\n", n_in, out_size, ws_size, (size_t)WS_END); grid = -1; return; }
        int dev = 0, cus = 0, per_cu = 0;
        if (hipGetDevice(&dev) != hipSuccess || hipDeviceGetAttribute(&cus, hipDeviceAttributeMultiprocessorCount, dev) != hipSuccess) { grid = -1; return; }
        if (hipFuncSetAttribute((const void*)hybrid_step_megakernel, hipFuncAttributeMaxDynamicSharedMemorySize, LDS_BYTES) != hipSuccess) { fprintf(stderr, "kernel_launch: hipFuncSetAttribute failed\n"); grid = -1; return; }
        if (hipOccupancyMaxActiveBlocksPerMultiprocessor(&per_cu, (const void*)hybrid_step_megakernel, NTHREADS, LDS_BYTES) != hipSuccess || per_cu < 1) { fprintf(stderr, "kernel_launch: occupancy query says %d blocks/CU\n", per_cu); per_cu = 1; }
        (void)hipGetLastError();
        grid = cus;
        if (grid != 256) fprintf(stderr, "kernel_launch: %d CUs (expected 256)\n", grid);
    }
    if (grid < 0) return;
    Params p{};
    for (int i = 0; i < 34; ++i) p.in[i] = (const float*)d_in[i];
    p.out = (float*)d_out; p.ws = (unsigned char*)d_ws;
    void* args[] = {&p};
    hipError_t e = hipLaunchCooperativeKernel((const void*)hybrid_step_megakernel, dim3(grid), dim3(NTHREADS), args, LDS_BYTES, stream);
    if (e != hipSuccess) fprintf(stderr, "kernel_launch: cooperative launch failed: %s (grid %d)\n", hipGetErrorString(e), grid);
}
```

```cpp
#include <hip/hip_runtime.h>
#include <hip/hip_cooperative_groups.h>
#include <cstdio>
#include <cstdint>
namespace cg = cooperative_groups;

#define LAS __attribute__((address_space(3)))
typedef unsigned short bf16_t;
typedef short bf16x8 __attribute__((ext_vector_type(8)));
typedef short s16x4 __attribute__((ext_vector_type(4)));
typedef float f32x2 __attribute__((ext_vector_type(2)));
typedef float f32x4 __attribute__((ext_vector_type(4)));
typedef float f32x16 __attribute__((ext_vector_type(16)));
typedef unsigned u32x2 __attribute__((ext_vector_type(2)));
typedef unsigned u32x4 __attribute__((ext_vector_type(4)));
typedef __bf16 bf16x2_t __attribute__((ext_vector_type(2)));

constexpr int DM = 1024, NP = 8192, ND = 16384, NTOK = 24576, NKV = 28672, HALF_TOK = 12288;
constexpr int IN_COLS = 7328;
constexpr float EPS = 1e-6f;
constexpr float LOG2E = 1.4426950408889634f;
constexpr float SCALE_M = 0.10206207261596577f * LOG2E;
constexpr float SCALE_D = 0.125f * LOG2E;
constexpr size_t O_Y = 0, O_CKV = 25165824, O_KR = 29360128, O_DK = 29884416, O_DV = 38273024, O_ST = 46661632, O_TOTAL = 46727168;

constexpr size_t MiB = 1u << 20;
constexpr size_t WS_CTL = 0;
constexpr size_t CTL_MOD = 64 * 1024;
constexpr size_t CTL_ROPE = 320 * 1024;
constexpr size_t CTL_SSQ = 1 * MiB;
constexpr size_t WS_W = 3 * MiB;
constexpr size_t W_IN = 0;
constexpr size_t W_UQ = W_IN + (size_t)7424 * 1024 * 2;
constexpr size_t W_UKV = W_UQ + (size_t)768 * 384 * 2;
constexpr size_t W_BR = W_UKV + (size_t)1024 * 256 * 2;
constexpr size_t W_OUT = W_BR + (size_t)3072 * 512 * 2;
constexpr size_t W_RG = W_OUT + (size_t)1024 * 1024 * 2;
constexpr size_t W_END = W_RG + (size_t)32 * 4096 * 2;
static_assert(W_END <= 21 * MiB, "weight region");
constexpr size_t WS_H = 24 * MiB;
constexpr size_t WS_Y = 72 * MiB;
constexpr size_t Y_SLOT = (size_t)NTOK * 512 * 2;
constexpr size_t WS_A = 144 * MiB;
constexpr size_t A_CKV = 0;
constexpr size_t A_KR = 14 * MiB;
constexpr size_t A_Q = 16 * MiB;
constexpr size_t A_KV = 52 * MiB;
constexpr size_t A_DQ = 0;
constexpr size_t A_DK = 24 * MiB;
constexpr size_t A_DV = 52 * MiB;
constexpr size_t A_G = 0;
constexpr size_t A_O = 0;
constexpr size_t WS_END = 256 * MiB;
static_assert(A_KV + (size_t)NKV * 1024 * 2 <= 112 * MiB, "A region");

constexpr int LDS_BYTES = 147456;
constexpr int NTHREADS = 512;

struct Params { const float* in[34]; float* out; unsigned char* ws; };

__device__ __forceinline__ unsigned pk2(float lo, float hi) { f32x2 v = {lo, hi}; bf16x2_t b = __builtin_convertvector(v, bf16x2_t); return __builtin_bit_cast(unsigned, b); }
__device__ __forceinline__ float bflo(unsigned w) { return __uint_as_float(w << 16); }
__device__ __forceinline__ float bfhi(unsigned w) { return __uint_as_float(w & 0xffff0000u); }
__device__ __forceinline__ float bf2f(bf16_t x) { return __uint_as_float(((unsigned)x) << 16); }
__device__ __forceinline__ u32x4 pack8(const float* v) { u32x4 w; w.x = pk2(v[0], v[1]); w.y = pk2(v[2], v[3]); w.z = pk2(v[4], v[5]); w.w = pk2(v[6], v[7]); return w; }
__device__ __forceinline__ void unpack8(u32x4 w, float* v) { v[0] = bflo(w.x); v[1] = bfhi(w.x); v[2] = bflo(w.y); v[3] = bfhi(w.y); v[4] = bflo(w.z); v[5] = bfhi(w.z); v[6] = bflo(w.w); v[7] = bfhi(w.w); }
__device__ __forceinline__ float wave_sum(float v) {
#pragma unroll
    for (int o = 1; o < 64; o <<= 1) v += __shfl_xor(v, o);
    return v;
}
__device__ __forceinline__ float sigmoidf_(float x) { return 1.0f / (1.0f + __expf(-x)); }
__device__ __forceinline__ float siluf_(float x) { return x / (1.0f + __expf(-x)); }
__device__ __forceinline__ int kvrow_of(int r) { return r < NP ? r : NP + ((r - NP) >> 11) * 2560 + 512 + ((r - NP) & 2047); }
__device__ __forceinline__ int grp_of(int r) { return r < NP ? 0 : 1 + ((r - NP) >> 11); }
__device__ __forceinline__ int cache_row(int r, int l) { return r + 256 * ((r >> 8) + l); }
__device__ __forceinline__ int tid_now() { int t = threadIdx.x; asm volatile("; tid" : "+v"(t)); return t; }
namespace pg8 {
#define PG8_LAS __attribute__((address_space(3)))
constexpr int BM = 256, BK = 64, HALF = 128, HTB = HALF * BK * 2  , STAGE_BYTES = 8 * HTB, NXCD = 8, WGM = 8;
__host__ __device__ __forceinline__ int lds_byte(int r, int c) { const int st = (r >> 4) * 2 + (c >> 5), rr = r & 15, cc = c & 31, ob = rr * 64 + cc * 2; return st * 1024 + (ob ^ (((ob >> 9) & 1) << 5)); }
__host__ __device__ __forceinline__ void stage_rc(int b, int& R, int& C) { const int st = b / 1024, sb = b % 1024, swz = sb ^ (((sb >> 9) & 1) << 5); R = (st >> 1) * 16 + swz / 64; C = (st & 1) * 32 + (swz % 64) / 2; }
__host__ __device__ __forceinline__ int perm32(int rho) { const int n = rho >> 4, i = rho & 15; return 8 * (i >> 2) + 4 * n + (i & 3); }
struct Unit { int pm, pn; };
struct Gemm { const bf16_t* A; const bf16_t* Bt; int M, N, K; };
struct StaticOrder {
    int nM, nN, nwg, G, c;
    __host__ __device__ void init(int M, int N, int G_, int c_) { nM = M / BM; nN = N / BM; nwg = nM * nN; G = G_; c = c_; }
    __host__ __device__ bool next(int i, Unit& u) const {
        const long L = (long)i * G + c; if (L >= nwg) return false;
        int wgid = (int)L; { const int q = nwg / NXCD, r = nwg % NXCD, xcd = wgid % NXCD, off = wgid / NXCD; wgid = (xcd < r ? xcd * (q + 1) : r * (q + 1) + (xcd - r) * q) + off; }
        const int nig = WGM * nN, gid = wgid / nig, fm = gid * WGM, gsz = (nM - fm) < WGM ? (nM - fm) : WGM;
        u.pm = fm + ((wgid % nig) % gsz); u.pn = (wgid % nig) / gsz; return true;
    }
    __device__ __forceinline__ void a_ready(const Unit&) const {}
    __device__ __forceinline__ void done(const Unit&) const {}
};
template <class Epi, class Sched, bool ALIGN_EPI = false, bool SP2 = false>
__device__ __forceinline__ void gemm_phase(PG8_LAS unsigned char* lds, const Gemm g, const Sched& S, const Epi& E) {
    const int tid = tid_now(), wid = __builtin_amdgcn_readfirstlane(tid >> 6), lane = tid & 63, wr = wid >> 2, wc = wid & 3, fr = lane & 15, fq = lane >> 4;
    const int K = g.K, nt = K / BK;
    unsigned voffA[2], voffB[2];
#pragma unroll
    for (int i = 0; i < 2; ++i) { int R, C; stage_rc(tid * 16 + i * 8192, R, C); const int Rb = Epi::PERM ? ((R & ~31) + perm32(R & 31)) : R;
        voffA[i] = (unsigned)(R * K + C) * 2u; voffB[i] = (unsigned)(Rb * K + C) * 2u; }
    const size_t kstep = (size_t)(BK * 2);
    const size_t hstep = (size_t)HALF * K * 2;
    const size_t tstep = 2 * hstep;
    const unsigned ldsw = (unsigned)wid * 1024u;
    const int aoff = lds_byte(wr * 64 + fr, fq * 8), boff = lds_byte(wc * 32 + fr, fq * 8);
#define PG8_SA(b, h) (((b) * 2 + (h)) * HTB)
#define PG8_SB(b, h) ((4 + (b) * 2 + (h)) * HTB)
#define PG8_STAGE(bufoff, gbase, voff) do { _Pragma("unroll") for (int _i = 0; _i < 2; ++_i) \
        __builtin_amdgcn_global_load_lds((const unsigned*)((const char*)(gbase) + (voff)[_i]), (PG8_LAS unsigned*)(lds + (bufoff) + ldsw + _i * 8192), 16, 0, 0); } while (0)
#define PG8_LDA(dst, b, h) do { _Pragma("unroll") for (int m = 0; m < 4; ++m) _Pragma("unroll") for (int k = 0; k < 2; ++k) dst[m][k] = *(const PG8_LAS bf16x8*)(lds + PG8_SA(b, h) + aoff + m * 2048 + k * 1024); } while (0)
#define PG8_LDB(dst, b, h) do { _Pragma("unroll") for (int n = 0; n < 2; ++n) _Pragma("unroll") for (int k = 0; k < 2; ++k) dst[n][k] = *(const PG8_LAS bf16x8*)(lds + PG8_SB(b, h) + boff + n * 2048 + k * 1024); } while (0)
#define PG8_MMA(ai, bj, At, Bt) do { __builtin_amdgcn_s_setprio(1); _Pragma("unroll") for (int m = 0; m < 4; ++m) _Pragma("unroll") for (int n = 0; n < 2; ++n) _Pragma("unroll") for (int k = 0; k < 2; ++k) \
        acc[ai][bj][m][n] = __builtin_amdgcn_mfma_f32_16x16x32_bf16(Bt[n][k], At[m][k], acc[ai][bj][m][n], 0, 0, 0); __builtin_amdgcn_s_setprio(0); } while (0)
#define PG8_WAIT_V(n) asm volatile("s_waitcnt vmcnt(" #n ")" ::: "memory")
#define PG8_WAIT_L(n) asm volatile("s_waitcnt lgkmcnt(" #n ")" ::: "memory")
#define PG8_BAR __builtin_amdgcn_s_barrier()
#define PG8_SCHED __builtin_amdgcn_sched_barrier(0)
    Unit cur, nxt; int ui = 0;
    if (!S.next(0, cur)) return;
    f32x4 acc[2][2][4][2];
#pragma unroll
    for (int a = 0; a < 2; ++a)
#pragma unroll
        for (int b = 0; b < 2; ++b)
#pragma unroll
            for (int m = 0; m < 4; ++m)
#pragma unroll
                for (int n = 0; n < 2; ++n) acc[a][b][m][n] = (f32x4){0.f, 0.f, 0.f, 0.f};
    bf16x8 At[4][2], B0[2][2], B1[2][2];
    const char* cA = (const char*)g.A + (size_t)cur.pm * tstep; const char* cB = (const char*)g.Bt + (size_t)cur.pn * tstep;
    S.a_ready(cur);
    if constexpr (SP2) {
        PG8_STAGE(PG8_SB(0, 0), cB, voffB); PG8_STAGE(PG8_SB(0, 1), cB + hstep, voffB); PG8_STAGE(PG8_SA(0, 0), cA, voffA); PG8_STAGE(PG8_SA(0, 1), cA + hstep, voffA);
        if (wr == 1) PG8_BAR;
        PG8_WAIT_V(2); PG8_BAR;
        PG8_STAGE(PG8_SB(1, 0), cB + kstep, voffB); PG8_STAGE(PG8_SA(1, 0), cA + kstep, voffA); PG8_STAGE(PG8_SB(1, 1), cB + hstep + kstep, voffB);
        PG8_WAIT_V(6); PG8_BAR;
    } else {
        PG8_STAGE(PG8_SB(0, 0), cB, voffB); PG8_STAGE(PG8_SA(0, 0), cA, voffA); PG8_STAGE(PG8_SB(0, 1), cB + hstep, voffB); PG8_STAGE(PG8_SA(0, 1), cA + hstep, voffA);
        if (wr == 1) PG8_BAR;
        PG8_WAIT_V(4); PG8_BAR;
        PG8_STAGE(PG8_SB(1, 0), cB + kstep, voffB); PG8_STAGE(PG8_SA(1, 0), cA + kstep, voffA); PG8_STAGE(PG8_SB(1, 1), cB + hstep + kstep, voffB);
        PG8_WAIT_V(6); PG8_BAR;
    }
    for (;;) {
        const bool has_next = S.next(ui + 1, nxt);
        const char* nA = has_next ? (const char*)g.A + (size_t)nxt.pm * tstep : cA; const char* nB = has_next ? (const char*)g.Bt + (size_t)nxt.pn * tstep : cB;
#pragma unroll 1
        for (int t = 0; t < nt; t += 2) {
            const bool last = (t == nt - 2);
            const char* a1 = cA + (size_t)(t + 1) * kstep;
            const char* a2 = last ? nA : cA + (size_t)(t + 2) * kstep; const char* b2 = last ? nB : cB + (size_t)(t + 2) * kstep;
            const char* a3 = a2 + kstep; const char* b3 = b2 + kstep;
            if (last && has_next) S.a_ready(nxt);
            if constexpr (SP2) {
            PG8_LDB(B0, 0, 0); PG8_LDB(B1, 0, 1); PG8_SCHED; PG8_LDA(At, 0, 0); PG8_STAGE(PG8_SA(1, 1), a1 + hstep, voffA);
            PG8_WAIT_V(8); PG8_WAIT_L(0); PG8_BAR; PG8_MMA(0, 0, At, B0); PG8_MMA(0, 1, At, B1); PG8_BAR; PG8_SCHED;
            PG8_LDA(At, 0, 1); PG8_STAGE(PG8_SB(0, 0), b2, voffB); PG8_STAGE(PG8_SB(0, 1), b2 + hstep, voffB); PG8_STAGE(PG8_SA(0, 0), a2, voffA);
            PG8_WAIT_V(8); PG8_WAIT_L(0); PG8_BAR; PG8_MMA(1, 0, At, B0); PG8_MMA(1, 1, At, B1); PG8_BAR; PG8_SCHED;
            PG8_LDB(B0, 1, 0); PG8_LDB(B1, 1, 1); PG8_SCHED; PG8_LDA(At, 1, 0); PG8_STAGE(PG8_SA(0, 1), a2 + hstep, voffA);
            PG8_WAIT_V(8); PG8_WAIT_L(0); PG8_BAR; PG8_MMA(0, 0, At, B0); PG8_MMA(0, 1, At, B1); PG8_BAR; PG8_SCHED;
            PG8_LDA(At, 1, 1); PG8_STAGE(PG8_SB(1, 0), b3, voffB); PG8_STAGE(PG8_SB(1, 1), b3 + hstep, voffB); PG8_STAGE(PG8_SA(1, 0), a3, voffA);
            PG8_WAIT_V(8); PG8_WAIT_L(0); PG8_BAR; PG8_MMA(1, 0, At, B0); PG8_MMA(1, 1, At, B1); PG8_BAR; PG8_SCHED;
            } else {
            PG8_LDB(B0, 0, 0); PG8_SCHED; PG8_LDA(At, 0, 0); PG8_STAGE(PG8_SA(1, 1), a1 + hstep, voffA);
            PG8_WAIT_L(8); PG8_BAR; PG8_WAIT_L(0); PG8_MMA(0, 0, At, B0); PG8_BAR; PG8_SCHED;
            PG8_LDB(B1, 0, 1); PG8_STAGE(PG8_SB(0, 0), b2, voffB);
            PG8_BAR; PG8_WAIT_L(0); PG8_MMA(0, 1, At, B1); PG8_BAR;
            PG8_LDA(At, 0, 1); PG8_STAGE(PG8_SA(0, 0), a2, voffA);
            PG8_BAR; PG8_WAIT_L(0); PG8_MMA(1, 0, At, B0); PG8_BAR; PG8_SCHED;
            PG8_STAGE(PG8_SB(0, 1), b2 + hstep, voffB);
            PG8_WAIT_V(6); PG8_BAR; PG8_MMA(1, 1, At, B1); PG8_BAR;
            PG8_LDB(B0, 1, 0); PG8_SCHED; PG8_LDA(At, 1, 0); PG8_STAGE(PG8_SA(0, 1), a2 + hstep, voffA);
            PG8_WAIT_L(8); PG8_BAR; PG8_WAIT_L(0); PG8_MMA(0, 0, At, B0); PG8_BAR; PG8_SCHED;
            PG8_LDB(B1, 1, 1); PG8_STAGE(PG8_SB(1, 0), b3, voffB);
            PG8_BAR; PG8_WAIT_L(0); PG8_MMA(0, 1, At, B1); PG8_BAR;
            PG8_LDA(At, 1, 1); PG8_STAGE(PG8_SA(1, 0), a3, voffA);
            PG8_BAR; PG8_WAIT_L(0); PG8_MMA(1, 0, At, B0); PG8_BAR; PG8_SCHED;
            PG8_STAGE(PG8_SB(1, 1), b3 + hstep, voffB);
            PG8_WAIT_V(6); PG8_BAR; PG8_MMA(1, 1, At, B1); PG8_BAR;
            }
        }
        if constexpr (ALIGN_EPI) { if (wr == 0) PG8_BAR; }
        bool rst_ = true; if constexpr (!Epi::AFTER_DRAIN) { rst_ = E(acc, cur, wr, wc, fr, fq); S.done(cur); }
        if (!has_next) break;
        if (rst_) {
#pragma unroll
        for (int a = 0; a < 2; ++a)
#pragma unroll
            for (int b = 0; b < 2; ++b)
#pragma unroll
                for (int m = 0; m < 4; ++m)
#pragma unroll
                    for (int n = 0; n < 2; ++n) acc[a][b][m][n] = (f32x4){0.f, 0.f, 0.f, 0.f};
        }
        cur = nxt; cA = nA; cB = nB; ++ui;
        if constexpr (ALIGN_EPI) { if (wr == 1) PG8_BAR; }
    }
    PG8_WAIT_V(0);
    if constexpr (!ALIGN_EPI) { if (wr == 0) PG8_BAR; }
    PG8_BAR;
    if constexpr (Epi::AFTER_DRAIN) { E.fused(acc, cur, wr, wc, fr, fq, lds, wid, lane); S.done(cur); }
#undef PG8_SA
#undef PG8_SB
#undef PG8_STAGE
#undef PG8_LDA
#undef PG8_LDB
#undef PG8_MMA
#undef PG8_WAIT_V
#undef PG8_WAIT_L
#undef PG8_BAR
#undef PG8_SCHED
}
}
using pg8::Unit;
#define EPI_ROWS_BEGIN _Pragma("unroll") for (int ai = 0; ai < 2; ++ai) _Pragma("unroll") for (int m = 0; m < 4; ++m) { const int row = u.pm * 256 + ai * 128 + wr * 64 + m * 16 + fr;
#define EPI_COLS_BEGIN _Pragma("unroll") for (int bj = 0; bj < 2; ++bj) { const int col = u.pn * 256 + bj * 128 + wc * 32 + 8 * fq; \
    float v[8]; { const f32x4 a0 = acc[ai][bj][m][0], a1 = acc[ai][bj][m][1]; v[0] = a0[0]; v[1] = a0[1]; v[2] = a0[2]; v[3] = a0[3]; v[4] = a1[0]; v[5] = a1[1]; v[6] = a1[2]; v[7] = a1[3]; }
#define EPI_END } asm volatile("" ::: "memory"); }
__device__ __forceinline__ void st_bf16x8(bf16_t* p, const float* v) { *(u32x4*)p = pack8(v); }
__device__ __forceinline__ void st_f32x8(float* p, const float* v) { *(f32x4*)p = (f32x4){v[0], v[1], v[2], v[3]}; *(f32x4*)(p + 4) = (f32x4){v[4], v[5], v[6], v[7]}; }

template <int XL> __device__ __forceinline__ void rope8(float* v, bool second, const float* cs, const float* sn) {
    const f32x4 c0 = *(const f32x4*)cs, c1 = *(const f32x4*)(cs + 4), s0 = *(const f32x4*)sn, s1 = *(const f32x4*)(sn + 4);
    const float c[8] = {c0[0], c0[1], c0[2], c0[3], c1[0], c1[1], c1[2], c1[3]}, s[8] = {s0[0], s0[1], s0[2], s0[3], s1[0], s1[1], s1[2], s1[3]};
#pragma unroll
    for (int i = 0; i < 8; ++i) { const float p = __shfl_xor(v[i], XL); v[i] = v[i] * c[i] + (second ? p : -p) * s[i]; }
}

struct EpiG1 {
    static constexpr bool PERM = true, AFTER_DRAIN = false;
    bf16_t *RX, *CQ, *CKV, *KR; float* okr; const float* rope; int l;
    __device__ __forceinline__ bool operator()(f32x4 (&acc)[2][2][4][2], const Unit& u, int wr, int wc, int fr, int fq) const {
        const bool dec = u.pm >= 32;
        EPI_ROWS_BEGIN
            const int kvr = kvrow_of(row);
            EPI_COLS_BEGIN
                if (col < 512) st_bf16x8(RX + (size_t)row * 512 + col, v);
                else if (col < 896) st_bf16x8(CQ + (size_t)row * 384 + (col - 512), v);
                else if (col < 1152) st_bf16x8(CKV + (size_t)kvr * 256 + (col - 896), v);
                else if (col < 1184) {
                    const int e = col - 1152;
                    if (dec) { const int t = (row - NP) & 2047, pos = (fq & 2) ? (t & 63) : (t >> 6);
                        rope8<16>(v, (fq & 1) != 0, rope + pos * 8, rope + 512 + pos * 8); }
                    else st_f32x8(okr + (size_t)cache_row(row, l) * 32 + e, v);
                    st_bf16x8(KR + (size_t)kvr * 32 + e, v);
                }
            EPI_END
        return true;
    }
};
struct EpiQ {
    static constexpr bool PERM = true, AFTER_DRAIN = false;
    bf16_t* Q; const float* rope;
    __device__ __forceinline__ bool operator()(f32x4 (&acc)[2][2][4][2], const Unit& u, int wr, int wc, int fr, int fq) const {
        const bool dec = u.pm >= 32;
        EPI_ROWS_BEGIN
            EPI_COLS_BEGIN
                const int g32 = col >> 5;
                if (dec && (g32 % 3) == 2) { const int t = (row - NP) & 2047, pos = (fq & 2) ? (t & 63) : (t >> 6);
                    rope8<16>(v, (fq & 1) != 0, rope + pos * 8, rope + 512 + pos * 8); }
#pragma unroll
                for (int i = 0; i < 8; ++i) v[i] *= SCALE_M;
                st_bf16x8(Q + (size_t)row * 768 + col, v);
            EPI_END
        return true;
    }
};
struct EpiPlain {
    static constexpr bool PERM = true, AFTER_DRAIN = false;
    bf16_t* O; int ldc;
    __device__ __forceinline__ bool operator()(f32x4 (&acc)[2][2][4][2], const Unit& u, int wr, int wc, int fr, int fq) const {
        EPI_ROWS_BEGIN
            EPI_COLS_BEGIN
                st_bf16x8(O + (size_t)row * ldc + col, v);
            EPI_END
        return true;
    }
};
struct EpiG3 {
    static constexpr bool PERM = true, AFTER_DRAIN = false;
    bf16_t *DQ, *DK, *DV; float *odk, *odv; const float* rope; int l;
    __device__ __forceinline__ bool operator()(f32x4 (&acc)[2][2][4][2], const Unit& u, int wr, int wc, int fr, int fq) const {
        const bool dec = u.pm >= 32;
        EPI_ROWS_BEGIN
            const int kvr = kvrow_of(row);
            EPI_COLS_BEGIN
                if (col < 1024) {
                    if (dec) { const int t = (row - NP) & 2047, pos = ((col >> 5) & 1) ? (t & 63) : (t >> 6);
                        rope8<32>(v, (fq & 2) != 0, rope + pos * 16 + (fq & 1) * 8, rope + 1024 + pos * 16 + (fq & 1) * 8); }
                    if (col < 512) {
#pragma unroll
                        for (int i = 0; i < 8; ++i) v[i] *= SCALE_D;
                        st_bf16x8(DQ + (size_t)row * 512 + col, v);
                    } else {
                        if (!dec) st_f32x8(odk + (size_t)cache_row(row, l) * 512 + (col - 512), v);
                        st_bf16x8(DK + (size_t)kvr * 512 + (col - 512), v);
                    }
                } else {
                    if (!dec) st_f32x8(odv + (size_t)cache_row(row, l) * 512 + (col - 1024), v);
                    st_bf16x8(DV + (size_t)kvr * 512 + (col - 1024), v);
                }
            EPI_END
        return true;
    }
};
struct EpiG4 {
    static constexpr bool PERM = true, AFTER_DRAIN = false;
    bf16_t* Y; bf16_t* G; int row_off;
    __device__ __forceinline__ bool operator()(f32x4 (&acc)[2][2][4][2], const Unit& u, int wr, int wc, int fr, int fq) const {
        EPI_ROWS_BEGIN
            EPI_COLS_BEGIN
                if (col < 1536) {
                    const int slot = col >> 9, cc = col & 511;
                    bf16_t* p = Y + (size_t)slot * ((size_t)NTOK * 512) + (size_t)(row + row_off) * 512 + cc;
                    float pre[8]; unpack8(*(const u32x4*)p, pre);
#pragma unroll
                    for (int i = 0; i < 8; ++i) v[i] = pre[i] * siluf_(v[i]);
                    st_bf16x8(p, v);
                } else {
#pragma unroll
                    for (int i = 0; i < 8; ++i) v[i] = sigmoidf_(v[i]);
                    st_bf16x8(G + (size_t)row * 3072 + (col - 1536), v);
                }
            EPI_END
        return true;
    }
};
struct EpiG5 {
    static constexpr bool PERM = true, AFTER_DRAIN = false;
    const bf16_t* G; bf16_t* MG; int half;
    __device__ __forceinline__ bool operator()(f32x4 (&acc)[2][2][4][2], const Unit& u, int wr, int wc, int fr, int fq) const {
        const int br = u.pn >> 2, pn = u.pn & 3, pml = u.pm - br * 96 - half * 48;
#pragma unroll
        for (int ai = 0; ai < 2; ++ai)
#pragma unroll
            for (int m = 0; m < 4; ++m) { const int rl = pml * 256 + ai * 128 + wr * 64 + m * 16 + fr;
#pragma unroll
                for (int bj = 0; bj < 2; ++bj) { const int col = pn * 256 + bj * 128 + wc * 32 + 8 * fq;
                    float g0[8], f[8]; unpack8(*(const u32x4*)(G + (size_t)rl * 3072 + br * 1024 + col), g0);
                    if (br < 2) { float g1[8]; unpack8(*(const u32x4*)(G + (size_t)rl * 3072 + (br + 1) * 1024 + col), g1);
#pragma unroll
                        for (int i = 0; i < 8; ++i) f[i] = fmaxf(g0[i], 1e-30f) / fmaxf(g1[i], 1e-30f);
                        if (br == 0) {
#pragma unroll
                            for (int i = 0; i < 8; ++i) f[i] = g0[i] / fmaxf(g1[i], 1e-30f);
                        }
                    } else {
#pragma unroll
                        for (int i = 0; i < 8; ++i) f[i] = fmaxf(g0[i], 1e-30f);
                    }
                    f32x4& a0 = acc[ai][bj][m][0]; f32x4& a1 = acc[ai][bj][m][1];
                    a0[0] *= f[0]; a0[1] *= f[1]; a0[2] *= f[2]; a0[3] *= f[3]; a1[0] *= f[4]; a1[1] *= f[5]; a1[2] *= f[6]; a1[3] *= f[7];
                    if (br == 2) { const float v[8] = {a0[0], a0[1], a0[2], a0[3], a1[0], a1[1], a1[2], a1[3]};
                        st_bf16x8(MG + (size_t)(half * HALF_TOK + rl) * 1024 + col, v); }
                } }
        return br == 2;
    }
};
struct EpiG6 {
    static constexpr bool PERM = true, AFTER_DRAIN = false;
    bf16_t* O; float* ssq;
    __device__ __forceinline__ bool operator()(f32x4 (&acc)[2][2][4][2], const Unit& u, int wr, int wc, int fr, int fq) const {
        EPI_ROWS_BEGIN
            float s = 0.f;
            EPI_COLS_BEGIN
#pragma unroll
                for (int i = 0; i < 8; ++i) s += v[i] * v[i];
                st_bf16x8(O + (size_t)row * 1024 + col, v);
            }
            s += __shfl_xor(s, 16); s += __shfl_xor(s, 32);
            if (fq == 0) ssq[(size_t)row * 16 + u.pn * 4 + wc] = s;
        }
        return true;
    }
};
namespace att {
#define SBAR() __builtin_amdgcn_sched_barrier(0)
__device__ __forceinline__ int crow(int r, int hi) { return (r & 3) + 8 * (r >> 2) + 4 * hi; }
template <int DQK> __device__ __forceinline__ int kswz(int row, int chunk) {
    if constexpr (DQK == 64) return row * 128 + ((chunk ^ ((row >> 1) & 7)) << 4);
    else return row * 256 + ((chunk ^ (row & 15)) << 4);
}
template <int DQK> struct KTile { static constexpr int BYTES = DQK == 64 ? 8192 : 16384; };
template <int DV> __device__ __forceinline__ int v_st(int k, int c) { return ((k >> 3) * (DV / 32) + (c >> 5)) * 512 + ((k & 7) * 32 + (c & 31)) * 2; }
__device__ __forceinline__ int v_rd_base(int lane) { return ((lane & 3) << 3) | (((lane >> 2) & 3) << 6) | (((lane >> 4) & 1) << 5) | (((lane >> 5) & 1) << 8); }
template <int OFF> __device__ __forceinline__ s16x4 tr_read(int vb) {
    s16x4 r; asm volatile("ds_read_b64_tr_b16 %0, %1 offset:%2" : "=&v"(r) : "v"(vb), "i"(OFF) : "memory"); return r;
}
template <int DV, int D0> __device__ __forceinline__ void pv_one(f32x16& od, int vb, bf16x8 pa0, bf16x8 pa1, bf16x8 pa2, bf16x8 pa3) {
    constexpr int NB = DV / 32;
#define VOFF(ks, half) (((2 * (ks) + (half)) * NB + D0) * 512)
    const s16x4 l0 = tr_read<VOFF(0, 0)>(vb), h0 = tr_read<VOFF(0, 1)>(vb), l1 = tr_read<VOFF(1, 0)>(vb), h1 = tr_read<VOFF(1, 1)>(vb);
    const s16x4 l2 = tr_read<VOFF(2, 0)>(vb), h2 = tr_read<VOFF(2, 1)>(vb), l3 = tr_read<VOFF(3, 0)>(vb), h3 = tr_read<VOFF(3, 1)>(vb);
#undef VOFF
    asm volatile("s_waitcnt lgkmcnt(0)" ::: "memory"); SBAR();
#define PK(L, H) (bf16x8){L[0], L[1], L[2], L[3], H[0], H[1], H[2], H[3]}
    od = __builtin_amdgcn_mfma_f32_32x32x16_bf16(pa0, PK(l0, h0), od, 0, 0, 0);
    od = __builtin_amdgcn_mfma_f32_32x32x16_bf16(pa1, PK(l1, h1), od, 0, 0, 0);
    od = __builtin_amdgcn_mfma_f32_32x32x16_bf16(pa2, PK(l2, h2), od, 0, 0, 0);
    od = __builtin_amdgcn_mfma_f32_32x32x16_bf16(pa3, PK(l3, h3), od, 0, 0, 0);
#undef PK
}
template <int DV> __device__ __forceinline__ void pv_all(f32x16* o, int vb, bf16x8 pa0, bf16x8 pa1, bf16x8 pa2, bf16x8 pa3) {
    pv_one<DV, 0>(o[0], vb, pa0, pa1, pa2, pa3); pv_one<DV, 1>(o[1], vb, pa0, pa1, pa2, pa3);
    if constexpr (DV == 128) { pv_one<DV, 2>(o[2], vb, pa0, pa1, pa2, pa3); pv_one<DV, 3>(o[3], vb, pa0, pa1, pa2, pa3); }
}
constexpr float THRL = 6.0f;
__device__ __forceinline__ void partialSM(f32x16& p0, f32x16& p1, float& m_reg, float& alpha) {
    float pmax = p0[0];
#pragma unroll
    for (int r = 1; r < 16; ++r) pmax = fmaxf(pmax, p0[r]);
#pragma unroll
    for (int r = 0; r < 16; ++r) pmax = fmaxf(pmax, p1[r]);
    { auto rr = __builtin_amdgcn_permlane32_swap(__float_as_uint(pmax), __float_as_uint(pmax), false, false);
      pmax = fmaxf(__uint_as_float(rr[0]), __uint_as_float(rr[1])); }
    float mn;
    if (__builtin_expect(__all(pmax - m_reg <= THRL), 1)) { mn = m_reg; alpha = 1.f; }
    else { mn = fmaxf(m_reg, pmax); alpha = __builtin_amdgcn_exp2f(m_reg - mn); m_reg = mn; }
#pragma unroll
    for (int r = 0; r < 16; ++r) p0[r] = __builtin_amdgcn_exp2f(p0[r] - mn);
#pragma unroll
    for (int r = 0; r < 16; ++r) p1[r] -= mn;
}
__device__ __forceinline__ void finishSM(f32x16& p0, f32x16& p1, float alpha, float& l_reg, bf16x8& pa0, bf16x8& pa1, bf16x8& pa2, bf16x8& pa3) {
#pragma unroll
    for (int r = 0; r < 16; ++r) p1[r] = __builtin_amdgcn_exp2f(p1[r]);
    float ps = 0.f;
#pragma unroll
    for (int r = 0; r < 16; ++r) ps += p0[r];
#pragma unroll
    for (int r = 0; r < 16; ++r) ps += p1[r];
    l_reg = l_reg * alpha + ps;
#define PK4(P, B, OUT) do { u32x4 w = {pk2(P[B + 0], P[B + 1]), pk2(P[B + 2], P[B + 3]), pk2(P[B + 4], P[B + 5]), pk2(P[B + 6], P[B + 7])}; OUT = __builtin_bit_cast(bf16x8, w); } while (0)
    PK4(p0, 0, pa0); PK4(p0, 8, pa1); PK4(p1, 0, pa2); PK4(p1, 8, pa3);
#undef PK4
}
template <int DQK> __device__ __forceinline__ void qkt(f32x16& p0, f32x16& p1, const char* Ks, const bf16x8* qr, int r32, int hi) {
    p0 = f32x16{}; p1 = f32x16{};
#pragma unroll
    for (int d0 = 0; d0 < DQK / 16; ++d0) {
        const bf16x8 b0 = *reinterpret_cast<const bf16x8*>(Ks + kswz<DQK>(r32, 2 * d0 + hi));
        const bf16x8 b1 = *reinterpret_cast<const bf16x8*>(Ks + kswz<DQK>(32 + r32, 2 * d0 + hi));
        p0 = __builtin_amdgcn_mfma_f32_32x32x16_bf16(b0, qr[d0], p0, 0, 0, 0);
        p1 = __builtin_amdgcn_mfma_f32_32x32x16_bf16(b1, qr[d0], p1, 0, 0, 0);
    }
}
template <int DQK, int DV, int SDEPTH>
__device__ __forceinline__ void attn_core(const bf16_t* __restrict__ Qw, int ldq, const bf16_t* __restrict__ K1, int ldk1, const bf16_t* __restrict__ K2, int ldk2,
                                          const bf16_t* __restrict__ Vp, int ldv, int nkeys, char* lds, f32x16 (&o)[DV / 32], float& l_out) {
    constexpr int SHM_V = 64 * DV * 2, SHM_K = KTile<DQK>::BYTES;
    const int tid = tid_now(), wid = tid >> 6, lane = tid & 63, r32 = lane & 31, hi = lane >> 5;
    char* V_lds = lds; char* K_lds = lds + 2 * SHM_V;
    float* al_l = (float*)(lds + 2 * SHM_V + 2 * SHM_K) + wid * 64;
    float m_reg = -1e30f, l_reg = 0.f;
#pragma unroll
    for (int d = 0; d < DV / 32; ++d) o[d] = f32x16{};
    bf16x8 qr[DQK / 16];
    { const bf16_t* q = Qw + (size_t)(wid * 32 + r32) * ldq + hi * 8;
#pragma unroll
      for (int d0 = 0; d0 < DQK / 16; ++d0) qr[d0] = *reinterpret_cast<const bf16x8*>(q + d0 * 16); }
    const int kr_ = tid >> 3, kc_ = tid & 7;
    const int vr_ = DV == 64 ? (tid >> 3) : (tid >> 4), vc_ = DV == 64 ? (tid & 7) * 8 : (tid & 15) * 8;
    const int kst = kswz<DQK>(kr_, kc_);
    const int k2st = DQK == 96 ? kswz<DQK>(kr_, 8 + (kc_ >> 1)) + (kc_ & 1) * 8 : 0;
    const int vst0 = v_st<DV>(vr_, vc_), vst1 = v_st<DV>(32 + vr_, vc_);
    const int vb0 = (int)(uintptr_t)V_lds + v_rd_base(lane);
    struct Slot { bf16x8 k1; u32x2 k2; bf16x8 v0; bf16x8 v1; };
    Slot sE, sO;
#define SLOAD(S, k0) do { (S).k1 = *reinterpret_cast<const bf16x8*>(K1 + (size_t)((k0) + kr_) * ldk1 + kc_ * 8); \
        if constexpr (DQK == 96) (S).k2 = *reinterpret_cast<const u32x2*>(K2 + (size_t)((k0) + kr_) * ldk2 + kc_ * 4); \
        (S).v0 = *reinterpret_cast<const bf16x8*>(Vp + (size_t)((k0) + vr_) * ldv + vc_); \
        if constexpr (DV == 128) (S).v1 = *reinterpret_cast<const bf16x8*>(Vp + (size_t)((k0) + 32 + vr_) * ldv + vc_); } while (0)
#define SWRITE(b, S) do { *reinterpret_cast<bf16x8*>(K_lds + (b) * SHM_K + kst) = (S).k1; \
        if constexpr (DQK == 96) *reinterpret_cast<u32x2*>(K_lds + (b) * SHM_K + k2st) = (S).k2; \
        *reinterpret_cast<bf16x8*>(V_lds + (b) * SHM_V + vst0) = (S).v0; \
        if constexpr (DV == 128) *reinterpret_cast<bf16x8*>(V_lds + (b) * SHM_V + vst1) = (S).v1; } while (0)
#define RESC(a) do { if (__any((a) < 1.f)) { if (hi == 0) al_l[r32] = (a); asm volatile("s_waitcnt lgkmcnt(0)" ::: "memory"); \
        _Pragma("unroll") for (int d = 0; d < DV / 32; ++d) _Pragma("unroll") for (int r = 0; r < 16; ++r) o[d][r] *= al_l[crow(r, hi)]; } } while (0)
    if constexpr (SDEPTH == 0) {
        f32x16 p0, p1; float al; bf16x8 pa0, pa1, pa2, pa3; const int NT = nkeys / 64;
        __syncthreads();
        SLOAD(sE, 0); SWRITE(0, sE); SLOAD(sE, 64); __syncthreads();
#pragma unroll 1
        for (int j = 0; j < NT; ++j) {
            const int b = j & 1;
            SBAR(); qkt<DQK>(p0, p1, K_lds + b * SHM_K, qr, r32, hi);
            partialSM(p0, p1, m_reg, al); RESC(al);
            finishSM(p0, p1, al, l_reg, pa0, pa1, pa2, pa3); SBAR();
            pv_all<DV>(o, vb0 + b * SHM_V, pa0, pa1, pa2, pa3);
            if (j + 1 < NT) { SWRITE(b ^ 1, sE); if (j + 2 < NT) SLOAD(sE, (j + 2) * 64); }
            __syncthreads();
        }
    } else {
    f32x16 pA0, pA1, pB0, pB1; float alA, alB; bf16x8 pa0, pa1, pa2, pa3; const int NT = nkeys / 64;
    __syncthreads();
    SLOAD(sE, 0); SWRITE(0, sE); __syncthreads();
    qkt<DQK>(pA0, pA1, K_lds, qr, r32, hi); partialSM(pA0, pA1, m_reg, alA);
    if constexpr (SDEPTH == 2) { SLOAD(sO, 64); if (2 < NT) SLOAD(sE, 128); SWRITE(1, sO); } else { SLOAD(sE, 64); SWRITE(1, sE); }
    __syncthreads();
#pragma unroll 1
    for (int j = 1; j + 1 < NT; j += 2) {
        SBAR(); qkt<DQK>(pB0, pB1, K_lds + SHM_K, qr, r32, hi);
        finishSM(pA0, pA1, alA, l_reg, pa0, pa1, pa2, pa3); SBAR();
        if constexpr (SDEPTH == 2) SLOAD(sO, (j + 2) * 64); else SLOAD(sE, (j + 1) * 64);
        SBAR();
        pv_all<DV>(o, vb0, pa0, pa1, pa2, pa3); partialSM(pB0, pB1, m_reg, alB);
        __syncthreads(); SWRITE(0, sE);
        RESC(alB); __syncthreads();
        SBAR(); qkt<DQK>(pA0, pA1, K_lds, qr, r32, hi);
        finishSM(pB0, pB1, alB, l_reg, pa0, pa1, pa2, pa3); SBAR();
        if constexpr (SDEPTH == 2) { if (j + 3 < NT) SLOAD(sE, (j + 3) * 64); } else SLOAD(sE, (j + 2) * 64);
        SBAR();
        pv_all<DV>(o, vb0 + SHM_V, pa0, pa1, pa2, pa3); partialSM(pA0, pA1, m_reg, alA);
        __syncthreads(); if constexpr (SDEPTH == 2) SWRITE(1, sO); else SWRITE(1, sE);
        RESC(alA); __syncthreads();
    }
    SBAR(); qkt<DQK>(pB0, pB1, K_lds + SHM_K, qr, r32, hi);
    finishSM(pA0, pA1, alA, l_reg, pa0, pa1, pa2, pa3); SBAR();
    pv_all<DV>(o, vb0, pa0, pa1, pa2, pa3); partialSM(pB0, pB1, m_reg, alB);
    __syncthreads(); RESC(alB);
    finishSM(pB0, pB1, alB, l_reg, pa0, pa1, pa2, pa3); SBAR();
    pv_all<DV>(o, vb0 + SHM_V, pa0, pa1, pa2, pa3);
    }
    { auto rr = __builtin_amdgcn_permlane32_swap(__float_as_uint(l_reg), __float_as_uint(l_reg), false, false);
      l_out = __uint_as_float(rr[0]) + __uint_as_float(rr[1]); }
#undef SLOAD
#undef SWRITE
#undef RESC
}
}
typedef const float __attribute__((address_space(1)))* cfp_t;
constexpr int LDS_TAB = 146432;
struct Frame {
    unsigned char* lds; unsigned char* ws; float* out; const LAS cfp_t* in;
    int tid, lane, wave, vcu, G, bid;
};
#define IN_(k) ((const float*)F.in[k])

__device__ __forceinline__ void tr_item(const float* W, int ldw, int col0, int K, bf16_t* WT, int drow0, int kb, int nb, LAS float* scr, int lane, bool zero) {
    const int k0 = 64 * kb, n0 = 32 * nb;
    if (!zero) {
#pragma unroll 8
        for (int i = 0; i < 32; ++i) { const int kk = 2 * i + (lane >> 5); scr[kk * 33 + (lane & 31)] = W[(size_t)(k0 + kk) * ldw + col0 + n0 + (lane & 31)]; }
    }
    asm volatile("s_waitcnt lgkmcnt(0)" ::: "memory");
    const int c = lane & 7;
#pragma unroll
    for (int j = 0; j < 4; ++j) { const int n = (lane >> 3) + 8 * j; const LAS float* s = scr + (8 * c) * 33 + n;
        u32x4 o; o.x = pk2(s[0 * 33], s[1 * 33]); o.y = pk2(s[2 * 33], s[3 * 33]); o.z = pk2(s[4 * 33], s[5 * 33]); o.w = pk2(s[6 * 33], s[7 * 33]);
        if (zero) o = (u32x4){0u, 0u, 0u, 0u};
        *(u32x4*)(WT + (size_t)(drow0 + n0 + n) * K + k0 + 8 * c) = o; }
    asm volatile("s_waitcnt lgkmcnt(0)" ::: "memory");
}
__device__ __forceinline__ int win_src_col(int r) {
    if (r < 512) return r;
    if (r < 896) return 1024 + (r - 512);
    if (r < 1152) return 1408 + (r - 896);
    if (r < 1184) return 1664;
    if (r < 1280) return -1;
    if (r < 1792) return 2208 + (r - 1280);
    if (r < 2304) return 2720 + (r - 1792);
    if (r < 2816) return 3232 + (r - 2304);
    if (r < 3328) return 512 + (r - 2816);
    if (r < 3840) return 1696 + (r - 3328);
    if (r < 4352) return 3744 + (r - 3840);
    return 4256 + (r - 4352);
}
__device__ __forceinline__ void convert_weights(Frame& F, int l) {
    LAS float* scr = (LAS float*)(F.lds) + F.wave * 2176;
    unsigned char* Wb = F.ws + WS_W;
    const int gw = F.vcu * 8 + F.wave, NGW = F.G * 8;
    constexpr int I_IN = 16 * 232, I_UQ = 6 * 24, I_UKV = 4 * 32, I_BR = 8 * 32, I_OUT = 16 * 32, I_RG = 64;
    constexpr int NITEMS = I_IN + I_UQ + I_UKV + 3 * I_BR + I_OUT + I_RG;
    for (int it = gw; it < NITEMS; it += NGW) {
        int r = it;
        if (r < I_IN) { const int db = r % 232, kb = r / 232; const int sc = win_src_col(db * 32);
            tr_item(IN_(13) + (size_t)l * 1024 * IN_COLS, IN_COLS, sc < 0 ? 0 : sc, 1024, (bf16_t*)(Wb + W_IN), db * 32, kb, 0, scr, F.lane, sc < 0); continue; } r -= I_IN;
        if (r < I_UQ) { tr_item(IN_(22) + (size_t)l * 384 * 768, 768, 0, 384, (bf16_t*)(Wb + W_UQ), 0, r / 24, r % 24, scr, F.lane, false); continue; } r -= I_UQ;
        if (r < I_UKV) { tr_item(IN_(24) + (size_t)l * 256 * 1024, 1024, 0, 256, (bf16_t*)(Wb + W_UKV), 0, r / 32, r % 32, scr, F.lane, false); continue; } r -= I_UKV;
        if (r < 3 * I_BR) { const int b = r / I_BR, q = r % I_BR;
            tr_item((b == 0 ? IN_(30) : b == 1 ? IN_(31) : IN_(32)) + (size_t)l * 512 * 1024, 1024, 0, 512, (bf16_t*)(Wb + W_BR), b * 1024, q / 32, q % 32, scr, F.lane, false); continue; } r -= 3 * I_BR;
        if (r < I_OUT) { tr_item(IN_(33) + (size_t)l * 1024 * 1024, 1024, 0, 1024, (bf16_t*)(Wb + W_OUT), 0, r / 32, r % 32, scr, F.lane, false); continue; } r -= I_OUT;
        { const int mat = r >> 1, nb = r & 1, gate = mat >> 4, dn = mat & 15;
          const float* src = (gate ? IN_(18) : IN_(16)) + ((size_t)l * 16 + dn) * 4096;
          const int d = dn >> 3, n = dn & 7;
          tr_item(src, 64, 0, 64, (bf16_t*)(Wb + W_RG) + (size_t)((d * 2 + gate) * 8 + n) * 4096, 0, 0, nb, scr, F.lane, false); }
    }
}
__device__ __forceinline__ void phase0_mod_rope(Frame& F) {
    float* mod = (float*)(F.ws + CTL_MOD);
    if (F.bid < 96) {
        const int l = F.bid / 48, c0 = (F.bid % 48) * 64;
        LAS float* sc = (LAS float*)F.lds + 8 * 2176;
        LAS float* red = sc + 9 * 1024;
        for (int i = F.tid; i < 9 * 1024; i += NTHREADS) { const int g = i >> 10, k = i & 1023; const float x = g == 0 ? IN_(8)[k] : IN_(7)[(g - 1) * 1024 + k]; sc[i] = siluf_(x); }
        __syncthreads();
        float a[9];
#pragma unroll
        for (int g = 0; g < 9; ++g) a[g] = 0.f;
        const float* w = IN_(9) + (size_t)l * 1024 * 3072 + c0 + F.lane;
        for (int k = F.wave * 128; k < F.wave * 128 + 128; ++k) { const float wv = w[(size_t)k * 3072];
#pragma unroll
            for (int g = 0; g < 9; ++g) a[g] += sc[g * 1024 + k] * wv; }
#pragma unroll
        for (int g = 0; g < 9; ++g) red[(F.wave * 9 + g) * 64 + F.lane] = a[g];
        __syncthreads();
        for (int i = F.tid; i < 9 * 64; i += NTHREADS) { const int g = i >> 6, c = i & 63; float s = IN_(10)[l * 3072 + c0 + c];
#pragma unroll
            for (int wv = 0; wv < 8; ++wv) s += red[(wv * 9 + g) * 64 + c];
            mod[((size_t)l * 9 + g) * 3072 + c0 + c] = s; }
        __syncthreads();
    } else if (F.bid == 96) {
        float* rp = (float*)(F.ws + CTL_ROPE);
        for (int i = F.tid; i < 64 * 8; i += NTHREADS) { const int pos = i >> 3, j = i & 7; const float ang = (float)pos * powf(10000.0f, -(float)j / 8.0f); rp[i] = cosf(ang); rp[512 + i] = sinf(ang); }
        for (int i = F.tid; i < 64 * 16; i += NTHREADS) { const int pos = i >> 4, j = i & 15; const float ang = (float)pos * powf(10000.0f, -(float)j / 16.0f); rp[1024 + i] = cosf(ang); rp[2048 + i] = sinf(ang); }
    }
}
__device__ __forceinline__ const float* x_row_l0(Frame& F, int r) { return r < NP ? IN_(0) + (size_t)r * DM : IN_(1) + (size_t)(r - NP) * DM; }
__device__ __forceinline__ void prenorm_store(Frame& F, const f32x4* v, int r, int l) {
    float s = 0.f;
#pragma unroll
    for (int j = 0; j < 4; ++j) s += (v[j].x * v[j].x + v[j].y * v[j].y) + (v[j].z * v[j].z + v[j].w * v[j].w);
    const float rstd = 1.0f / sqrtf(wave_sum(s) * (1.0f / DM) + EPS);
    const float* mod = (const float*)(F.ws + CTL_MOD) + ((size_t)l * 9 + grp_of(r)) * 3072;
    const float* gp = IN_(11) + l * DM;
    bf16_t* h = (bf16_t*)(F.ws + WS_H) + (size_t)r * DM;
#pragma unroll
    for (int j = 0; j < 4; ++j) { const int c = 4 * F.lane + 256 * j;
        const f32x4 g = *(const f32x4*)(gp + c), sh = *(const f32x4*)(mod + c), sc = *(const f32x4*)(mod + 1024 + c);
        const f32x4 y = (v[j] * rstd * g) * (sc + 1.0f) + sh;
        u32x2 w; w.x = pk2(y.x, y.y); w.y = pk2(y.z, y.w); *(u32x2*)(h + c) = w; }
}
__device__ __forceinline__ void phase0_h(Frame& F) {
    const int gw = F.vcu * 8 + F.wave, NGW = F.G * 8;
    for (int r = gw; r < NTOK; r += NGW) { const f32x4* xr = (const f32x4*)x_row_l0(F, r) + F.lane; f32x4 v[4];
#pragma unroll
        for (int j = 0; j < 4; ++j) v[j] = xr[64 * j];
        prenorm_store(F, v, r, 0); }
}
__device__ __forceinline__ void phase_post(Frame& F, int l) {
    const int gw = F.vcu * 8 + F.wave, NGW = F.G * 8;
    const bf16_t* O = (const bf16_t*)(F.ws + WS_A + A_O);
    const float* ssq = (const float*)(F.ws + CTL_SSQ);
    const float* gpost = IN_(12) + l * DM;
    for (int r = gw; r < NTOK; r += NGW) {
        float sq = F.lane < 16 ? ssq[(size_t)r * 16 + F.lane] : 0.f;
        const float rstd = 1.0f / sqrtf(wave_sum(sq) * (1.0f / DM) + EPS);
        const float* xin = l == 0 ? x_row_l0(F, r) : F.out + O_Y + (size_t)r * DM;
        float* xo = F.out + O_Y + (size_t)r * DM;
        const float* gate = (const float*)(F.ws + CTL_MOD) + ((size_t)l * 9 + grp_of(r)) * 3072 + 2048;
        f32x4 v[4];
#pragma unroll
        for (int j = 0; j < 4; ++j) { const int c = 4 * F.lane + 256 * j;
            const u32x2 ow = *(const u32x2*)(O + (size_t)r * DM + c);
            const f32x4 o = {bflo(ow.x), bfhi(ow.x), bflo(ow.y), bfhi(ow.y)};
            const f32x4 x = *(const f32x4*)(xin + c), g = *(const f32x4*)(gpost + c), gt = *(const f32x4*)(gate + c);
            v[j] = x + gt * (o * rstd * g);
            *(f32x4*)(xo + c) = v[j]; }
        if (l == 0) prenorm_store(F, v, r, 1);
    }
}
constexpr int RN_XB = 0;
constexpr int RN_XF = 36864;
constexpr int RN_AA = RN_XF + 16384;
constexpr int RN_BB = RN_AA + 16384;
constexpr int RN_SEG = RN_BB + 16384;
constexpr int RN_CAR = RN_SEG + 4096;
__device__ __forceinline__ void rnn_item(Frame& F, int l, int seq, int n, int qt) {
    const bool dec = seq >= 32;
    const int S = dec ? 2048 : 256, tok0 = dec ? NP + (seq - 32) * 2048 : seq * 256, nck = S / 256;
    const int tid = F.tid, lane = F.lane, wave = F.wave;
    const bf16_t* RX = (const bf16_t*)(F.ws + WS_Y + 2 * Y_SLOT);
    bf16_t* HS = (bf16_t*)(F.ws + WS_Y);
    unsigned char* L = F.lds;
    const int oc0 = n * 64 + qt * 16;
    const float* cw = IN_(14) + (size_t)l * 4 * 512; const float* cb = IN_(15) + l * 512;
    const int tl = tid >> 1, chh = tid & 1;
    const int sj = tid & 15, sseg = tid >> 4;
    for (int dir = 0; dir < 2; ++dir) {
        const int jc = lane & 15;
        const float ba = IN_(17)[(l * 2 + dir) * 512 + oc0 + jc], bx = IN_(19)[(l * 2 + dir) * 512 + oc0 + jc];
        const float lam = IN_(20)[(l * 2 + dir) * 512 + oc0 + jc];
        const float sp8 = -8.0f * log1pf(__expf(-lam));
        const bf16_t* wt = (const bf16_t*)(F.ws + WS_W + W_RG);
        bf16x8 wa[2], wx[2];
#pragma unroll
        for (int ks = 0; ks < 2; ++ks) {
            wa[ks] = *(const bf16x8*)(wt + (size_t)((dir * 2 + 0) * 8 + n) * 4096 + (qt * 16 + jc) * 64 + ks * 32 + (lane >> 4) * 8);
            wx[ks] = *(const bf16x8*)(wt + (size_t)((dir * 2 + 1) * 8 + n) * 4096 + (qt * 16 + jc) * 64 + ks * 32 + (lane >> 4) * 8); }
        __syncthreads();
        if (tid < 16) ((float*)(L + RN_CAR))[tid] = dec ? IN_(6)[(((seq - 32) * 2 + l) * 2 + dir) * 512 + oc0 + tid] : 0.f;
        for (int cc = 0; cc < nck; ++cc) {
            const int ci = dir == 0 ? cc : nck - 1 - cc, c0 = ci * 256;
            {
#pragma unroll
                for (int g8 = 0; g8 < 4; ++g8) {
                    const int ch = chh * 32 + g8 * 8;
                    float acc8[8];
                    { const f32x4 b0 = *(const f32x4*)(cb + n * 64 + ch), b1 = *(const f32x4*)(cb + n * 64 + ch + 4);
                      acc8[0] = b0.x; acc8[1] = b0.y; acc8[2] = b0.z; acc8[3] = b0.w; acc8[4] = b1.x; acc8[5] = b1.y; acc8[6] = b1.z; acc8[7] = b1.w; }
#pragma unroll
                    for (int k = 0; k < 4; ++k) { const int t = c0 + tl - 2 + k;
                        if (t >= 0 && t < S) { float xv[8]; unpack8(*(const u32x4*)(RX + (size_t)(tok0 + t) * 512 + n * 64 + ch), xv);
                            const f32x4 w0 = *(const f32x4*)(cw + k * 512 + n * 64 + ch), w1 = *(const f32x4*)(cw + k * 512 + n * 64 + ch + 4);
                            acc8[0] += xv[0] * w0.x; acc8[1] += xv[1] * w0.y; acc8[2] += xv[2] * w0.z; acc8[3] += xv[3] * w0.w;
                            acc8[4] += xv[4] * w1.x; acc8[5] += xv[5] * w1.y; acc8[6] += xv[6] * w1.z; acc8[7] += xv[7] * w1.w; } }
                    *(u32x4*)(L + RN_XB + tl * 144 + ch * 2) = pack8(acc8);
                    if ((ch >> 4) == qt) { float* xf = (float*)(L + RN_XF) + tl * 16 + (ch & 15);
                        *(f32x4*)xf = (f32x4){acc8[0], acc8[1], acc8[2], acc8[3]}; *(f32x4*)(xf + 4) = (f32x4){acc8[4], acc8[5], acc8[6], acc8[7]}; }
                }
            }
            __syncthreads();
            {
#pragma unroll
                for (int rb = 0; rb < 2; ++rb) {
                    f32x4 ga = {0.f, 0.f, 0.f, 0.f}, gx = {0.f, 0.f, 0.f, 0.f};
#pragma unroll
                    for (int ks = 0; ks < 2; ++ks) {
                        const bf16x8 af = *(const bf16x8*)(L + RN_XB + (wave * 32 + rb * 16 + (lane & 15)) * 144 + (ks * 32 + (lane >> 4) * 8) * 2);
                        ga = __builtin_amdgcn_mfma_f32_16x16x32_bf16(af, wa[ks], ga, 0, 0, 0);
                        gx = __builtin_amdgcn_mfma_f32_16x16x32_bf16(af, wx[ks], gx, 0, 0, 0);
                    }
#pragma unroll
                    for (int i = 0; i < 4; ++i) { const int t = wave * 32 + rb * 16 + 4 * (lane >> 4) + i;
                        const float r = sigmoidf_(ga[i] + ba), ig = sigmoidf_(gx[i] + bx);
                        const float la = sp8 * r, a = __expf(la);
                        const float xc = ((const float*)(L + RN_XF))[t * 16 + jc];
                        const float b = sqrtf(-expm1f(2.0f * la)) * (ig * xc);
                        ((float*)(L + RN_AA))[t * 16 + jc] = a; ((float*)(L + RN_BB))[t * 16 + jc] = b; }
                }
            }
            __syncthreads();
            const float* AA = (const float*)(L + RN_AA); const float* BB = (const float*)(L + RN_BB); float* SG = (float*)(L + RN_SEG);
            float av[8], bv[8];
#pragma unroll
            for (int i = 0; i < 8; ++i) { const int t = dir == 0 ? sseg * 8 + i : sseg * 8 + 7 - i; av[i] = AA[t * 16 + sj]; bv[i] = BB[t * 16 + sj]; }
            { float A = 1.f, B = 0.f;
#pragma unroll
              for (int i = 0; i < 8; ++i) { A *= av[i]; B = av[i] * B + bv[i]; }
              SG[sseg * 16 + sj] = A; SG[512 + sseg * 16 + sj] = B; }
            __syncthreads();
            float h = ((const float*)(L + RN_CAR))[sj];
            if (dir == 0) { for (int s = 0; s < sseg; ++s) h = SG[s * 16 + sj] * h + SG[512 + s * 16 + sj]; }
            else { for (int s = 31; s > sseg; --s) h = SG[s * 16 + sj] * h + SG[512 + s * 16 + sj]; }
#pragma unroll
            for (int i = 0; i < 8; ++i) { const int t = dir == 0 ? sseg * 8 + i : sseg * 8 + 7 - i;
                h = av[i] * h + bv[i];
                bf16_t* hp = HS + (size_t)(tok0 + c0 + t) * 512 + oc0 + sj;
                float hv = h; if (dir == 1) hv += bf2f(*hp);
                *hp = (bf16_t)(pk2(hv, 0.f) & 0xffffu); }
            __syncthreads();
            if (sseg == (dir == 0 ? 31 : 0)) {
                ((float*)(L + RN_CAR))[sj] = h;
                if (!dec && cc == nck - 1) F.out[O_ST + ((size_t)(seq * 2 + l) * 2 + dir) * 512 + oc0 + sj] = h;
            }
        }
    }
    __syncthreads();
}
__device__ __forceinline__ void phase_rnn_prep(Frame& F, int l) {
#pragma unroll 1
    for (int k = 0; k < 5; ++k) {
        int seq, n, qt;
        if (k == 0) { const int v = F.vcu; seq = 32 + (v >> 5); n = (v & 31) >> 2; qt = v & 3; }
        else { const int p = F.vcu * 4 + k - 1; seq = p >> 5; n = (p & 31) >> 2; qt = p & 3; }
        rnn_item(F, l, seq, n, qt);
    }
    const int gw = F.vcu * 8 + F.wave, NGW = F.G * 8, lane = F.lane;
    bf16_t* CQ = (bf16_t*)(F.ws + WS_Y + Y_SLOT); bf16_t* CKV = (bf16_t*)(F.ws + WS_A + A_CKV); bf16_t* KR = (bf16_t*)(F.ws + WS_A + A_KR);
    const float* qn = IN_(21) + l * 384; const float* kn = IN_(23) + l * 256;
    for (int r = gw; r < NTOK; r += NGW) {
        float q[8], c[8]; float sq = 0.f, sc = 0.f;
        bf16_t* qp = CQ + (size_t)r * 384 + lane * 8; bf16_t* cp = CKV + (size_t)kvrow_of(r) * 256 + lane * 8;
        if (lane < 48) { unpack8(*(const u32x4*)qp, q);
#pragma unroll
            for (int i = 0; i < 8; ++i) sq += q[i] * q[i]; }
        if (lane < 32) { unpack8(*(const u32x4*)cp, c);
#pragma unroll
            for (int i = 0; i < 8; ++i) sc += c[i] * c[i]; }
        const float rq = 1.0f / sqrtf(wave_sum(sq) * (1.0f / 384.0f) + EPS), rc = 1.0f / sqrtf(wave_sum(sc) * (1.0f / 256.0f) + EPS);
        if (lane < 48) {
#pragma unroll
            for (int i = 0; i < 8; ++i) q[i] = q[i] * rq * qn[lane * 8 + i];
            *(u32x4*)qp = pack8(q); }
        if (lane < 32) {
#pragma unroll
            for (int i = 0; i < 8; ++i) c[i] = c[i] * rc * kn[lane * 8 + i];
            *(u32x4*)cp = pack8(c);
            if (r < NP) st_f32x8(F.out + O_CKV + (size_t)cache_row(r, l) * 256 + lane * 8, c); }
    }
    for (int i = gw; i < 4096; i += NGW) { const int b = i >> 9, j = i & 511; const int kvr = NP + b * 2560 + j;
        const float* s1 = IN_(2) + ((size_t)(b * 2 + l) * 512 + j) * 256;
        if (lane < 32) { const f32x4 a = *(const f32x4*)(s1 + lane * 8), bq = *(const f32x4*)(s1 + lane * 8 + 4); const float v[8] = {a.x, a.y, a.z, a.w, bq.x, bq.y, bq.z, bq.w};
            *(u32x4*)(CKV + (size_t)kvr * 256 + lane * 8) = pack8(v); }
        const float* s2 = IN_(3) + ((size_t)(b * 2 + l) * 512 + j) * 32;
        if (lane < 4) { const f32x4 a = *(const f32x4*)(s2 + lane * 8), bq = *(const f32x4*)(s2 + lane * 8 + 4); const float v[8] = {a.x, a.y, a.z, a.w, bq.x, bq.y, bq.z, bq.w};
            *(u32x4*)(KR + (size_t)kvr * 32 + lane * 8) = pack8(v); }
    }
}
__device__ __forceinline__ void convert_diff_ctx(Frame& F, int l) {
    const int gw = F.vcu * 8 + F.wave, NGW = F.G * 8, lane = F.lane;
    bf16_t* DK = (bf16_t*)(F.ws + WS_A + A_DK); bf16_t* DV = (bf16_t*)(F.ws + WS_A + A_DV);
    for (int i = gw; i < 8192; i += NGW) { const int which = i >> 12, b = (i >> 9) & 7, j = i & 511; const int kvr = NP + b * 2560 + j;
        const float* s = (which ? IN_(5) : IN_(4)) + ((size_t)(b * 2 + l) * 512 + j) * 512 + lane * 8;
        const f32x4 a = *(const f32x4*)s, bq = *(const f32x4*)(s + 4); const float v[8] = {a.x, a.y, a.z, a.w, bq.x, bq.y, bq.z, bq.w};
        *(u32x4*)((which ? DV : DK) + (size_t)kvr * 512 + lane * 8) = pack8(v); }
}
constexpr int ATT_STASH = 65536;
#ifndef ATT_SDEPTH_M
#define ATT_SDEPTH_M 1
#endif
#ifndef ATT_SDEPTH_D
#define ATT_SDEPTH_D 0
#endif
__device__ __forceinline__ void mla_unit(Frame& F, int tok0, int kv0, int nkeys, int h) {
    const bf16_t* Q = (const bf16_t*)(F.ws + WS_A + A_Q); const bf16_t* KV = (const bf16_t*)(F.ws + WS_A + A_KV); const bf16_t* KR = (const bf16_t*)(F.ws + WS_A + A_KR);
    bf16_t* OM = (bf16_t*)(F.ws + WS_Y + Y_SLOT);
    f32x16 o[2]; float l;
    att::attn_core<96, 64, ATT_SDEPTH_M>(Q + (size_t)tok0 * 768 + h * 96, 768, KV + (size_t)kv0 * 1024 + h * 128, 1024, KR + (size_t)kv0 * 32, 32,
                           KV + (size_t)kv0 * 1024 + h * 128 + 64, 1024, nkeys, (char*)F.lds, o, l);
    const int lane = F.lane, r32 = lane & 31, hi = lane >> 5;
    float* li = (float*)(F.lds + 2 * 8192 + 2 * 16384) + F.wave * 64 + 32;
    if (hi == 0) li[r32] = l;
    asm volatile("s_waitcnt lgkmcnt(0)" ::: "memory");
#pragma unroll
    for (int r = 0; r < 16; ++r) { const int q = att::crow(r, hi); const float rl = __builtin_amdgcn_rcpf(li[q]);
        bf16_t* op = OM + (size_t)(tok0 + F.wave * 32 + q) * 512 + h * 64 + r32;
#pragma unroll
        for (int d = 0; d < 2; ++d) op[d * 32] = (bf16_t)(pk2(o[d][r] * rl, 0.f) & 0xffffu); }
}
__device__ __forceinline__ void phase_mla(Frame& F) {
    const int x = F.vcu >> 5, j = F.vcu & 31;
#pragma unroll 1
    for (int u = 0; u < 3; ++u) {
        int tok0, kv0, nkeys, h;
        if (u < 2) { const int idx = j * 2 + u, pair = x * 8 + (idx >> 3), qb = idx & 7, b = pair >> 3; h = pair & 7; tok0 = NP + b * 2048 + qb * 256; kv0 = NP + b * 2560; nkeys = 2560; }
        else { const int b = F.vcu >> 3; h = F.vcu & 7; tok0 = b * 256; kv0 = b * 256; nkeys = 256; }
        mla_unit(F, tok0, kv0, nkeys, h);
    }
}
__device__ __forceinline__ void diff_pass(Frame& F, int l, int tok0, int kv0, int nkeys, int h, int pass, float lam, float lam_init) {
    const bf16_t* DQ = (const bf16_t*)(F.ws + WS_A + A_DQ); const bf16_t* DK = (const bf16_t*)(F.ws + WS_A + A_DK); const bf16_t* DV = (const bf16_t*)(F.ws + WS_A + A_DV);
    bf16_t* OD = (bf16_t*)(F.ws + WS_Y + 2 * Y_SLOT);
    const int lane = F.lane, r32 = lane & 31, hi = lane >> 5;
    float* li = (float*)(F.lds + 2 * 16384 + 2 * 8192) + F.wave * 64 + 32;
    unsigned* stash = (unsigned*)(F.lds + ATT_STASH + F.wave * 8192);
    f32x16 o[4]; float lsum;
    const int coff = h * 128 + (pass == 0 ? 64 : 0);
    att::attn_core<64, 128, ATT_SDEPTH_D>(DQ + (size_t)tok0 * 512 + coff, 512, DK + (size_t)kv0 * 512 + coff, 512, nullptr, 0,
                            DV + (size_t)kv0 * 512 + h * 128, 512, nkeys, (char*)F.lds, o, lsum);
    if (hi == 0) li[r32] = lsum;
    asm volatile("s_waitcnt lgkmcnt(0)" ::: "memory");
    if (pass == 0) {
#pragma unroll
        for (int r = 0; r < 16; r += 2) { const float rl0 = lam * __builtin_amdgcn_rcpf(li[att::crow(r, hi)]), rl1 = lam * __builtin_amdgcn_rcpf(li[att::crow(r + 1, hi)]);
#pragma unroll
            for (int d = 0; d < 4; ++d) stash[(d * 8 + (r >> 1)) * 64 + lane] = pk2(o[d][r] * rl0, o[d][r + 1] * rl1); }
        asm volatile("s_waitcnt lgkmcnt(0)" ::: "memory");
    } else {
        const float* dn = IN_(29) + l * 128;
        const float g0 = dn[r32], g1 = dn[32 + r32], g2 = dn[64 + r32], g3 = dn[96 + r32];
#pragma unroll
        for (int r = 0; r < 16; r += 2) {
            const float rl0 = __builtin_amdgcn_rcpf(li[att::crow(r, hi)]), rl1 = __builtin_amdgcn_rcpf(li[att::crow(r + 1, hi)]);
            float e0[4], e1[4]; float s0 = 0.f, s1 = 0.f;
#pragma unroll
            for (int d = 0; d < 4; ++d) { const unsigned w = stash[(d * 8 + (r >> 1)) * 64 + lane];
                e0[d] = o[d][r] * rl0 - bflo(w); e1[d] = o[d][r + 1] * rl1 - bfhi(w); s0 += e0[d] * e0[d]; s1 += e1[d] * e1[d]; }
#pragma unroll
            for (int m = 1; m < 32; m <<= 1) { s0 += __shfl_xor(s0, m); s1 += __shfl_xor(s1, m); }
            const float k0 = (1.0f - lam_init) / sqrtf(s0 * (1.0f / 128.0f) + EPS), k1 = (1.0f - lam_init) / sqrtf(s1 * (1.0f / 128.0f) + EPS);
            bf16_t* p0 = OD + (size_t)(tok0 + F.wave * 32 + att::crow(r, hi)) * 512 + h * 128 + r32;
            bf16_t* p1 = OD + (size_t)(tok0 + F.wave * 32 + att::crow(r + 1, hi)) * 512 + h * 128 + r32;
            p0[0] = (bf16_t)(pk2(e0[0] * k0 * g0, 0.f) & 0xffffu); p0[32] = (bf16_t)(pk2(e0[1] * k0 * g1, 0.f) & 0xffffu);
            p0[64] = (bf16_t)(pk2(e0[2] * k0 * g2, 0.f) & 0xffffu); p0[96] = (bf16_t)(pk2(e0[3] * k0 * g3, 0.f) & 0xffffu);
            p1[0] = (bf16_t)(pk2(e1[0] * k1 * g0, 0.f) & 0xffffu); p1[32] = (bf16_t)(pk2(e1[1] * k1 * g1, 0.f) & 0xffffu);
            p1[64] = (bf16_t)(pk2(e1[2] * k1 * g2, 0.f) & 0xffffu); p1[96] = (bf16_t)(pk2(e1[3] * k1 * g3, 0.f) & 0xffffu);
        }
    }
}
__device__ __forceinline__ void phase_diff(Frame& F, int l) {
    const float lam_init = 0.8f - 0.6f * expf(-0.3f * (float)l);
    const float d1 = wave_sum(IN_(25)[l * 64 + F.lane] * IN_(26)[l * 64 + F.lane]), d2 = wave_sum(IN_(27)[l * 64 + F.lane] * IN_(28)[l * 64 + F.lane]);
    const float lam = expf(d1) - expf(d2) + lam_init;
    const int x = F.vcu >> 5, j = F.vcu & 31;
    const int nsteps = (F.vcu & 1) == 0 ? 4 : 2;
#pragma unroll 1
    for (int st = 0; st < nsteps; ++st) {
        int tok0, kv0, nkeys, h;
        if (st < 2) { const int pair = x * 4 + (j >> 3), qb = j & 7, b = pair >> 2; h = pair & 3; tok0 = NP + b * 2048 + qb * 256; kv0 = NP + b * 2560; nkeys = 2560; }
        else { const int p = F.vcu >> 1, b = p >> 2; h = p & 3; tok0 = b * 256; kv0 = b * 256; nkeys = 256; }
        diff_pass(F, l, tok0, kv0, nkeys, h, st & 1, lam, lam_init);
    }
}
#define GEMM_CALL(EPI, SCHED, g, S, E) pg8::gemm_phase<EPI, SCHED, true, true>((PG8_LAS unsigned char*)F.lds, g, S, E)
struct BrOrder {
    int c, half;
    __device__ __forceinline__ bool next(int i, pg8::Unit& u) const { if (c >= 192 || i >= 3) return false; u.pm = i * 96 + half * 48 + (c >> 2); u.pn = i * 4 + (c & 3); return true; }
    __device__ __forceinline__ void a_ready(const pg8::Unit&) const {}
    __device__ __forceinline__ void done(const pg8::Unit&) const {}
};
__device__ __forceinline__ void phase_g1(Frame& F, int l) {
    pg8::Gemm g{(const bf16_t*)(F.ws + WS_H), (const bf16_t*)(F.ws + WS_W + W_IN), NTOK, 1280, 1024};
    pg8::StaticOrder S; S.init(NTOK, 1280, F.G, F.bid);
    EpiG1 E{(bf16_t*)(F.ws + WS_Y + 2 * Y_SLOT), (bf16_t*)(F.ws + WS_Y + Y_SLOT), (bf16_t*)(F.ws + WS_A + A_CKV), (bf16_t*)(F.ws + WS_A + A_KR),
            F.out + O_KR, (const float*)(F.ws + CTL_ROPE), l};
    GEMM_CALL(EpiG1, pg8::StaticOrder, g, S, E);
}
__device__ __forceinline__ void phase_g2(Frame& F) {
    { pg8::Gemm g{(const bf16_t*)(F.ws + WS_Y + Y_SLOT), (const bf16_t*)(F.ws + WS_W + W_UQ), NTOK, 768, 384};
      pg8::StaticOrder S; S.init(NTOK, 768, F.G, F.bid);
      EpiQ E{(bf16_t*)(F.ws + WS_A + A_Q), (const float*)(F.ws + CTL_ROPE)};
      GEMM_CALL(EpiQ, pg8::StaticOrder, g, S, E); }
    { pg8::Gemm g{(const bf16_t*)(F.ws + WS_A + A_CKV), (const bf16_t*)(F.ws + WS_W + W_UKV), NKV, 1024, 256};
      pg8::StaticOrder S; S.init(NKV, 1024, F.G, (F.bid + F.G - (288 % F.G)) % F.G);
      EpiPlain E{(bf16_t*)(F.ws + WS_A + A_KV), 1024};
      GEMM_CALL(EpiPlain, pg8::StaticOrder, g, S, E); }
}
__device__ __forceinline__ void phase_g3(Frame& F, int l) {
    convert_diff_ctx(F, l);
    pg8::Gemm g{(const bf16_t*)(F.ws + WS_H), (const bf16_t*)(F.ws + WS_W + W_IN) + (size_t)1280 * 1024, NTOK, 1536, 1024};
    pg8::StaticOrder S; S.init(NTOK, 1536, F.G, F.bid);
    EpiG3 E{(bf16_t*)(F.ws + WS_A + A_DQ), (bf16_t*)(F.ws + WS_A + A_DK), (bf16_t*)(F.ws + WS_A + A_DV), F.out + O_DK, F.out + O_DV, (const float*)(F.ws + CTL_ROPE) + 1024, l};
    GEMM_CALL(EpiG3, pg8::StaticOrder, g, S, E);
}
__device__ __forceinline__ void phase_g4(Frame& F, int half) {
    pg8::Gemm g{(const bf16_t*)(F.ws + WS_H) + (size_t)half * HALF_TOK * 1024, (const bf16_t*)(F.ws + WS_W + W_IN) + (size_t)2816 * 1024, HALF_TOK, 4608, 1024};
    pg8::StaticOrder S; S.init(HALF_TOK, 4608, F.G, F.bid);
    EpiG4 E{(bf16_t*)(F.ws + WS_Y), (bf16_t*)(F.ws + WS_A + A_G), half * HALF_TOK};
    GEMM_CALL(EpiG4, pg8::StaticOrder, g, S, E);
}
__device__ __forceinline__ void phase_g5(Frame& F, int half) {
    pg8::Gemm g{(const bf16_t*)(F.ws + WS_Y), (const bf16_t*)(F.ws + WS_W + W_BR), 3 * NTOK, 3072, 512};
    BrOrder S{F.bid, half};
    EpiG5 E{(const bf16_t*)(F.ws + WS_A + A_G), (bf16_t*)(F.ws + WS_H), half};
    GEMM_CALL(EpiG5, BrOrder, g, S, E);
}
__device__ __forceinline__ void phase_g6(Frame& F) {
    pg8::Gemm g{(const bf16_t*)(F.ws + WS_H), (const bf16_t*)(F.ws + WS_W + W_OUT), NTOK, 1024, 1024};
    pg8::StaticOrder S; S.init(NTOK, 1024, F.G, F.bid);
    EpiG6 E{(bf16_t*)(F.ws + WS_A + A_O), (float*)(F.ws + CTL_SSQ)};
    GEMM_CALL(EpiG6, pg8::StaticOrder, g, S, E);
}

#define XB_TMO      128
#define XB_XCNT(j)  (256  + 64 * (j))
#define XB_XSUB(j)  (1280 + 64 * (j))
#define XB_XGEN(j)  (2304 + 64 * (j))
#define XB_TOP      3328
#define XB_TOPGEN   3392
#define XCD_BAR_WORDS 3456
#define XB_SPIN_CAP (1u << 18)

__device__ __forceinline__ unsigned xb_ld(unsigned* p)              { return __hip_atomic_load(p, __ATOMIC_RELAXED, __HIP_MEMORY_SCOPE_AGENT); }
__device__ __forceinline__ unsigned xb_add(unsigned* p, unsigned v) { return __hip_atomic_fetch_add(p, v, __ATOMIC_RELAXED, __HIP_MEMORY_SCOPE_AGENT); }
__device__ __forceinline__ unsigned xb_xcc_id() { return (unsigned)__builtin_amdgcn_s_getreg((3 << 11) | 20) & 0xFu; }
#define XB_SPIN(cond, bar) do { unsigned _sp = 0; while (cond) { __builtin_amdgcn_s_sleep(1); \
    if ((++_sp & 255u) == 0u) { if (xb_ld(&(bar)[XB_TMO])) break; if (_sp > XB_SPIN_CAP) { atomicAdd(&(bar)[XB_TMO], 1u); break; } } } } while (0)

struct XcdBarrier {
    unsigned* bar; unsigned x;
    volatile LAS unsigned* st;
};

__device__ __forceinline__ XcdBarrier xcd_barrier_post(unsigned* bar, volatile LAS unsigned* st) {
    XcdBarrier b; b.bar = bar; b.x = xb_xcc_id(); b.st = st;
    if (threadIdx.x == 0) (void)xb_add(&bar[XB_XCNT(b.x)], 1u);
    return b;
}
__device__ __forceinline__ void xcd_barrier_complete(unsigned* bar, unsigned x, unsigned& nloc, unsigned& nx) {
    const unsigned G = gridDim.x * gridDim.y * gridDim.z;
    unsigned sum, cnt, mine, sp = 0u;
    for (;;) {
        sum = 0u; cnt = 0u; mine = 0u;
#pragma unroll
        for (unsigned j = 0; j < 16; ++j) { const unsigned c = xb_ld(&bar[XB_XCNT(j)]); sum += c; cnt += (c > 0u) ? 1u : 0u; mine = (j == x) ? c : mine; }
        if (sum == G) break;
        __builtin_amdgcn_s_sleep(1);
        if ((++sp & 255u) == 0u) { if (xb_ld(&bar[XB_TMO])) break; if (sp > XB_SPIN_CAP) { atomicAdd(&bar[XB_TMO], 1u); break; } }
    }
    nloc = mine > 0u ? mine : 1u; nx = cnt > 0u ? cnt : 1u;
}

__device__ __forceinline__ void xcd_barrier(const XcdBarrier& b) {
    asm volatile("s_waitcnt vmcnt(0)" ::: "memory");
    __syncthreads();
    if (threadIdx.x == 0) {
        unsigned* bar = b.bar;
        __builtin_amdgcn_s_waitcnt(0);
        unsigned nloc = b.st[0], nx = b.st[1];
        if (nloc == 0u) { xcd_barrier_complete(bar, b.x, nloc, nx); b.st[0] = nloc; b.st[1] = nx; }
        const unsigned old = xb_add(&bar[XB_XSUB(b.x)], 1u);
        const unsigned gen = old / nloc;
        if (old + 1u == (gen + 1u) * nloc) {
            __builtin_amdgcn_fence(__ATOMIC_RELEASE, "agent");
            asm volatile("s_waitcnt vmcnt(0)" ::: "memory");
            const unsigned og = xb_add(&bar[XB_TOP], 1u);
            const unsigned tg = og / nx;
            if (og + 1u == (tg + 1u) * nx) xb_add(&bar[XB_TOPGEN], 1u);
            else XB_SPIN(xb_ld(&bar[XB_TOPGEN]) == tg, bar);
            __builtin_amdgcn_fence(__ATOMIC_ACQUIRE, "agent");
            xb_add(&bar[XB_XGEN(b.x)], 1u);
            asm volatile("s_waitcnt vmcnt(0)" ::: "memory");
        } else {
            XB_SPIN(xb_ld(&bar[XB_XGEN(b.x)]) == gen, bar);
            __builtin_amdgcn_fence(__ATOMIC_ACQUIRE, "agent");
            asm volatile("s_waitcnt vmcnt(0)" ::: "memory");
        }
    }
    __syncthreads();
}

constexpr int NPHASES = 2 + 2 * 12;
__global__ void __launch_bounds__(NTHREADS, 2) hybrid_step_megakernel(Params p) {
    extern __shared__ __attribute__((aligned(16))) unsigned char lds[];
    cg::grid_group grid = cg::this_grid();
    if (threadIdx.x < 34) ((LAS cfp_t*)(lds + LDS_TAB))[threadIdx.x] = (cfp_t)p.in[threadIdx.x];
    __syncthreads();
    volatile LAS unsigned* bst = (volatile LAS unsigned*)(lds + LDS_TAB + 512);
    XcdBarrier xbar; xbar.bar = nullptr; xbar.x = 0; xbar.st = bst;
#pragma unroll 1
    for (int ph = 0; ph < NPHASES; ++ph) {
        const int l = ph < 2 ? 0 : (ph - 2) / 12, k = ph < 2 ? ph : 2 + (ph - 2) % 12;
#define FRAME() int zv, zs; asm volatile("v_mov_b32 %0, 0" : "=v"(zv)); asm volatile("s_mov_b32 %0, 0" : "=s"(zs)); Frame F; \
        F.lds = lds; F.ws = p.ws + zs; F.out = p.out + zs; F.in = (const LAS cfp_t*)(lds + LDS_TAB); \
        F.tid = threadIdx.x + zv; F.lane = F.tid & 63; F.wave = __builtin_amdgcn_readfirstlane(F.tid >> 6); \
        F.G = gridDim.x; F.bid = blockIdx.x + zs; F.vcu = (F.bid % 8) * (F.G / 8) + F.bid / 8;
        switch (k) {
            case 0: { FRAME(); if (F.bid == 0) { for (int i = F.tid; i < XCD_BAR_WORDS; i += NTHREADS) ((unsigned*)(F.ws + WS_CTL))[i] = 0u; } phase0_mod_rope(F); convert_weights(F, 0); } break;
            case 1: { FRAME(); phase0_h(F); } break;
            case 2: { FRAME(); phase_g1(F, l); } break;
            case 3: { FRAME(); phase_rnn_prep(F, l); } break;
            case 4: { FRAME(); phase_g2(F); } break;
            case 5: { FRAME(); phase_mla(F); } break;
            case 6: { FRAME(); phase_g3(F, l); } break;
            case 7: { FRAME(); phase_diff(F, l); } break;
            case 8: { FRAME(); phase_g4(F, 0); } break;
            case 9: { FRAME(); phase_g5(F, 0); } break;
            case 10: { FRAME(); phase_g4(F, 1); } break;
            case 11: { FRAME(); phase_g5(F, 1); } break;
            case 12: { FRAME(); phase_g6(F); } break;
            default: { FRAME(); phase_post(F, l); if (l == 0) convert_weights(F, 1); } break;
        }
#undef FRAME
        if (ph == 0) {
            grid.sync();
            if (threadIdx.x == 0) { bst[0] = 0u; bst[1] = 0u; }
            __syncthreads();
            xbar = xcd_barrier_post((unsigned*)(p.ws + WS_CTL), bst);
        } else if (ph + 1 < NPHASES) xcd_barrier(xbar);
    }
}

extern "C" void kernel_launch(void* const* d_in, const int* in_sizes, int n_in, void* d_out, int out_size, void* d_ws, size_t ws_size, hipStream_t stream) {
    static int grid = 0;
    if (grid == 0) {
        if (n_in != 34 || out_size != (int)O_TOTAL || ws_size < WS_END) { fprintf(stderr, "kernel_launch: unexpected shapes: n_in %d out %d ws %zu (need >= %zu)\n", n_in, out_size, ws_size, (size_t)WS_END); grid = -1; return; }
        int dev = 0, cus = 0, per_cu = 0;
        if (hipGetDevice(&dev) != hipSuccess || hipDeviceGetAttribute(&cus, hipDeviceAttributeMultiprocessorCount, dev) != hipSuccess) { grid = -1; return; }
        if (hipFuncSetAttribute((const void*)hybrid_step_megakernel, hipFuncAttributeMaxDynamicSharedMemorySize, LDS_BYTES) != hipSuccess) { fprintf(stderr, "kernel_launch: hipFuncSetAttribute failed\n"); grid = -1; return; }
        if (hipOccupancyMaxActiveBlocksPerMultiprocessor(&per_cu, (const void*)hybrid_step_megakernel, NTHREADS, LDS_BYTES) != hipSuccess || per_cu < 1) { fprintf(stderr, "kernel_launch: occupancy query says %d blocks/CU\n", per_cu); per_cu = 1; }
        (void)hipGetLastError();
        grid = cus;
        if (grid != 256) fprintf(stderr, "kernel_launch: %d CUs (expected 256)\n", grid);
    }
    if (grid < 0) return;
    Params p{};
    for (int i = 0; i < 34; ++i) p.in[i] = (const float*)d_in[i];
    p.out = (float*)d_out; p.ws = (unsigned char*)d_ws;
    void* args[] = {&p};
    hipError_t e = hipLaunchCooperativeKernel((const void*)hybrid_step_megakernel, dim3(grid), dim3(NTHREADS), args, LDS_BYTES, stream);
    if (e != hipSuccess) fprintf(stderr, "kernel_launch: cooperative launch failed: %s (grid %d)\n", hipGetErrorString(e), grid);
}
```

```cpp
#include <hip/hip_runtime.h>
#include <hip/hip_cooperative_groups.h>
#include <cstdio>
#include <cstdint>
namespace cg = cooperative_groups;

#define LAS __attribute__((address_space(3)))
typedef unsigned short bf16_t;
typedef short bf16x8 __attribute__((ext_vector_type(8)));
typedef short s16x4 __attribute__((ext_vector_type(4)));
typedef float f32x2 __attribute__((ext_vector_type(2)));
typedef float f32x4 __attribute__((ext_vector_type(4)));
typedef float f32x16 __attribute__((ext_vector_type(16)));
typedef unsigned u32x2 __attribute__((ext_vector_type(2)));
typedef unsigned u32x4 __attribute__((ext_vector_type(4)));
typedef __bf16 bf16x2_t __attribute__((ext_vector_type(2)));

constexpr int DM = 1024, NP = 8192, ND = 16384, NTOK = 24576, NKV = 28672, HALF_TOK = 12288;
constexpr int IN_COLS = 7328;
constexpr float EPS = 1e-6f;
constexpr float LOG2E = 1.4426950408889634f;
constexpr float SCALE_M = 0.10206207261596577f * LOG2E;
constexpr float SCALE_D = 0.125f * LOG2E;
constexpr size_t O_Y = 0, O_CKV = 25165824, O_KR = 29360128, O_DK = 29884416, O_DV = 38273024, O_ST = 46661632, O_TOTAL = 46727168;

constexpr size_t MiB = 1u << 20;
constexpr size_t WS_CTL = 0;
constexpr size_t CTL_MOD = 64 * 1024;
constexpr size_t CTL_ROPE = 320 * 1024;
constexpr size_t CTL_SSQ = 1 * MiB;
constexpr size_t WS_W = 3 * MiB;
constexpr size_t W_IN = 0;
constexpr size_t W_UQ = W_IN + (size_t)7424 * 1024 * 2;
constexpr size_t W_UKV = W_UQ + (size_t)768 * 384 * 2;
constexpr size_t W_BR = W_UKV + (size_t)1024 * 256 * 2;
constexpr size_t W_OUT = W_BR + (size_t)3072 * 512 * 2;
constexpr size_t W_RG = W_OUT + (size_t)1024 * 1024 * 2;
constexpr size_t W_END = W_RG + (size_t)32 * 4096 * 2;
static_assert(W_END <= 21 * MiB, "weight region");
constexpr size_t WS_H = 24 * MiB;
constexpr size_t WS_Y = 72 * MiB;
constexpr size_t Y_SLOT = (size_t)NTOK * 512 * 2;
constexpr size_t WS_A = 144 * MiB;
constexpr size_t A_CKV = 0;
constexpr size_t A_KR = 14 * MiB;
constexpr size_t A_Q = 16 * MiB;
constexpr size_t A_KV = 52 * MiB;
constexpr size_t A_DQ = 0;
constexpr size_t A_DK = 24 * MiB;
constexpr size_t A_DV = 52 * MiB;
constexpr size_t A_G = 0;
constexpr size_t A_O = 0;
constexpr size_t WS_END = 256 * MiB;
static_assert(A_KV + (size_t)NKV * 1024 * 2 <= 112 * MiB, "A region");

constexpr int LDS_BYTES = 147456;
constexpr int NTHREADS = 512;

struct Params { const float* in[34]; float* out; unsigned char* ws; };

__device__ __forceinline__ unsigned pk2(float lo, float hi) { f32x2 v = {lo, hi}; bf16x2_t b = __builtin_convertvector(v, bf16x2_t); return __builtin_bit_cast(unsigned, b); }
__device__ __forceinline__ float bflo(unsigned w) { return __uint_as_float(w << 16); }
__device__ __forceinline__ float bfhi(unsigned w) { return __uint_as_float(w & 0xffff0000u); }
__device__ __forceinline__ float bf2f(bf16_t x) { return __uint_as_float(((unsigned)x) << 16); }
__device__ __forceinline__ u32x4 pack8(const float* v) { u32x4 w; w.x = pk2(v[0], v[1]); w.y = pk2(v[2], v[3]); w.z = pk2(v[4], v[5]); w.w = pk2(v[6], v[7]); return w; }
__device__ __forceinline__ void unpack8(u32x4 w, float* v) { v[0] = bflo(w.x); v[1] = bfhi(w.x); v[2] = bflo(w.y); v[3] = bfhi(w.y); v[4] = bflo(w.z); v[5] = bfhi(w.z); v[6] = bflo(w.w); v[7] = bfhi(w.w); }
__device__ __forceinline__ float wave_sum(float v) {
#pragma unroll
    for (int o = 1; o < 64; o <<= 1) v += __shfl_xor(v, o);
    return v;
}
__device__ __forceinline__ float sigmoidf_(float x) { return 1.0f / (1.0f + __expf(-x)); }
__device__ __forceinline__ float siluf_(float x) { return x / (1.0f + __expf(-x)); }
__device__ __forceinline__ int kvrow_of(int r) { return r < NP ? r : NP + ((r - NP) >> 11) * 2560 + 512 + ((r - NP) & 2047); }
__device__ __forceinline__ int grp_of(int r) { return r < NP ? 0 : 1 + ((r - NP) >> 11); }
__device__ __forceinline__ int cache_row(int r, int l) { return r + 256 * ((r >> 8) + l); }
__device__ __forceinline__ int tid_now() { int t = threadIdx.x; asm volatile("; tid" : "+v"(t)); return t; }
namespace pg8 {
#define PG8_LAS __attribute__((address_space(3)))
constexpr int BM = 256, BK = 64, HALF = 128, HTB = HALF * BK * 2  , STAGE_BYTES = 8 * HTB, NXCD = 8, WGM = 8;
__host__ __device__ __forceinline__ int lds_byte(int r, int c) { const int st = (r >> 4) * 2 + (c >> 5), rr = r & 15, cc = c & 31, ob = rr * 64 + cc * 2; return st * 1024 + (ob ^ (((ob >> 9) & 1) << 5)); }
__host__ __device__ __forceinline__ void stage_rc(int b, int& R, int& C) { const int st = b / 1024, sb = b % 1024, swz = sb ^ (((sb >> 9) & 1) << 5); R = (st >> 1) * 16 + swz / 64; C = (st & 1) * 32 + (swz % 64) / 2; }
__host__ __device__ __forceinline__ int perm32(int rho) { const int n = rho >> 4, i = rho & 15; return 8 * (i >> 2) + 4 * n + (i & 3); }
struct Unit { int pm, pn; };
struct Gemm { const bf16_t* A; const bf16_t* Bt; int M, N, K; };
struct StaticOrder {
    int nM, nN, nwg, G, c;
    __host__ __device__ void init(int M, int N, int G_, int c_) { nM = M / BM; nN = N / BM; nwg = nM * nN; G = G_; c = c_; }
    __host__ __device__ bool next(int i, Unit& u) const {
        const long L = (long)i * G + c; if (L >= nwg) return false;
        int wgid = (int)L; { const int q = nwg / NXCD, r = nwg % NXCD, xcd = wgid % NXCD, off = wgid / NXCD; wgid = (xcd < r ? xcd * (q + 1) : r * (q + 1) + (xcd - r) * q) + off; }
        const int nig = WGM * nN, gid = wgid / nig, fm = gid * WGM, gsz = (nM - fm) < WGM ? (nM - fm) : WGM;
        u.pm = fm + ((wgid % nig) % gsz); u.pn = (wgid % nig) / gsz; return true;
    }
    __device__ __forceinline__ void a_ready(const Unit&) const {}
    __device__ __forceinline__ void done(const Unit&) const {}
};
template <class Epi, class Sched, bool ALIGN_EPI = false, bool SP2 = false>
__device__ __forceinline__ void gemm_phase(PG8_LAS unsigned char* lds, const Gemm g, const Sched& S, const Epi& E) {
    const int tid = tid_now(), wid = __builtin_amdgcn_readfirstlane(tid >> 6), lane = tid & 63, wr = wid >> 2, wc = wid & 3, fr = lane & 15, fq = lane >> 4;
    const int K = g.K, nt = K / BK;
    unsigned voffA[2], voffB[2];
#pragma unroll
    for (int i = 0; i < 2; ++i) { int R, C; stage_rc(tid * 16 + i * 8192, R, C); const int Rb = Epi::PERM ? ((R & ~31) + perm32(R & 31)) : R;
        voffA[i] = (unsigned)(R * K + C) * 2u; voffB[i] = (unsigned)(Rb * K + C) * 2u; }
    const size_t kstep = (size_t)(BK * 2);
    const size_t hstep = (size_t)HALF * K * 2;
    const size_t tstep = 2 * hstep;
    const unsigned ldsw = (unsigned)wid * 1024u;
    const int aoff = lds_byte(wr * 64 + fr, fq * 8), boff = lds_byte(wc * 32 + fr, fq * 8);
#define PG8_SA(b, h) (((b) * 2 + (h)) * HTB)
#define PG8_SB(b, h) ((4 + (b) * 2 + (h)) * HTB)
#define PG8_STAGE(bufoff, gbase, voff) do { _Pragma("unroll") for (int _i = 0; _i < 2; ++_i) \
        __builtin_amdgcn_global_load_lds((const unsigned*)((const char*)(gbase) + (voff)[_i]), (PG8_LAS unsigned*)(lds + (bufoff) + ldsw + _i * 8192), 16, 0, 0); } while (0)
#define PG8_LDA(dst, b, h) do { _Pragma("unroll") for (int m = 0; m < 4; ++m) _Pragma("unroll") for (int k = 0; k < 2; ++k) dst[m][k] = *(const PG8_LAS bf16x8*)(lds + PG8_SA(b, h) + aoff + m * 2048 + k * 1024); } while (0)
#define PG8_LDB(dst, b, h) do { _Pragma("unroll") for (int n = 0; n < 2; ++n) _Pragma("unroll") for (int k = 0; k < 2; ++k) dst[n][k] = *(const PG8_LAS bf16x8*)(lds + PG8_SB(b, h) + boff + n * 2048 + k * 1024); } while (0)
#define PG8_MMA(ai, bj, At, Bt) do { __builtin_amdgcn_s_setprio(1); _Pragma("unroll") for (int m = 0; m < 4; ++m) _Pragma("unroll") for (int n = 0; n < 2; ++n) _Pragma("unroll") for (int k = 0; k < 2; ++k) \
        acc[ai][bj][m][n] = __builtin_amdgcn_mfma_f32_16x16x32_bf16(Bt[n][k], At[m][k], acc[ai][bj][m][n], 0, 0, 0); __builtin_amdgcn_s_setprio(0); } while (0)
#define PG8_WAIT_V(n) asm volatile("s_waitcnt vmcnt(" #n ")" ::: "memory")
#define PG8_WAIT_L(n) asm volatile("s_waitcnt lgkmcnt(" #n ")" ::: "memory")
#define PG8_BAR __builtin_amdgcn_s_barrier()
#define PG8_SCHED __builtin_amdgcn_sched_barrier(0)
    Unit cur, nxt; int ui = 0;
    if (!S.next(0, cur)) return;
    f32x4 acc[2][2][4][2];
#pragma unroll
    for (int a = 0; a < 2; ++a)
#pragma unroll
        for (int b = 0; b < 2; ++b)
#pragma unroll
            for (int m = 0; m < 4; ++m)
#pragma unroll
                for (int n = 0; n < 2; ++n) acc[a][b][m][n] = (f32x4){0.f, 0.f, 0.f, 0.f};
    bf16x8 At[4][2], B0[2][2], B1[2][2];
    const char* cA = (const char*)g.A + (size_t)cur.pm * tstep; const char* cB = (const char*)g.Bt + (size_t)cur.pn * tstep;
    S.a_ready(cur);
    if constexpr (SP2) {
        PG8_STAGE(PG8_SB(0, 0), cB, voffB); PG8_STAGE(PG8_SB(0, 1), cB + hstep, voffB); PG8_STAGE(PG8_SA(0, 0), cA, voffA); PG8_STAGE(PG8_SA(0, 1), cA + hstep, voffA);
        if (wr == 1) PG8_BAR;
        PG8_WAIT_V(2); PG8_BAR;
        PG8_STAGE(PG8_SB(1, 0), cB + kstep, voffB); PG8_STAGE(PG8_SA(1, 0), cA + kstep, voffA); PG8_STAGE(PG8_SB(1, 1), cB + hstep + kstep, voffB);
        PG8_WAIT_V(6); PG8_BAR;
    } else {
        PG8_STAGE(PG8_SB(0, 0), cB, voffB); PG8_STAGE(PG8_SA(0, 0), cA, voffA); PG8_STAGE(PG8_SB(0, 1), cB + hstep, voffB); PG8_STAGE(PG8_SA(0, 1), cA + hstep, voffA);
        if (wr == 1) PG8_BAR;
        PG8_WAIT_V(4); PG8_BAR;
        PG8_STAGE(PG8_SB(1, 0), cB + kstep, voffB); PG8_STAGE(PG8_SA(1, 0), cA + kstep, voffA); PG8_STAGE(PG8_SB(1, 1), cB + hstep + kstep, voffB);
        PG8_WAIT_V(6); PG8_BAR;
    }
    for (;;) {
        const bool has_next = S.next(ui + 1, nxt);
        const char* nA = has_next ? (const char*)g.A + (size_t)nxt.pm * tstep : cA; const char* nB = has_next ? (const char*)g.Bt + (size_t)nxt.pn * tstep : cB;
#pragma unroll 1
        for (int t = 0; t < nt; t += 2) {
            const bool last = (t == nt - 2);
            const char* a1 = cA + (size_t)(t + 1) * kstep;
            const char* a2 = last ? nA : cA + (size_t)(t + 2) * kstep; const char* b2 = last ? nB : cB + (size_t)(t + 2) * kstep;
            const char* a3 = a2 + kstep; const char* b3 = b2 + kstep;
            if (last && has_next) S.a_ready(nxt);
            if constexpr (SP2) {
            PG8_LDB(B0, 0, 0); PG8_LDB(B1, 0, 1); PG8_SCHED; PG8_LDA(At, 0, 0); PG8_STAGE(PG8_SA(1, 1), a1 + hstep, voffA);
            PG8_WAIT_V(8); PG8_WAIT_L(0); PG8_BAR; PG8_MMA(0, 0, At, B0); PG8_MMA(0, 1, At, B1); PG8_BAR; PG8_SCHED;
            PG8_LDA(At, 0, 1); PG8_STAGE(PG8_SB(0, 0), b2, voffB); PG8_STAGE(PG8_SB(0, 1), b2 + hstep, voffB); PG8_STAGE(PG8_SA(0, 0), a2, voffA);
            PG8_WAIT_V(8); PG8_WAIT_L(0); PG8_BAR; PG8_MMA(1, 0, At, B0); PG8_MMA(1, 1, At, B1); PG8_BAR; PG8_SCHED;
            PG8_LDB(B0, 1, 0); PG8_LDB(B1, 1, 1); PG8_SCHED; PG8_LDA(At, 1, 0); PG8_STAGE(PG8_SA(0, 1), a2 + hstep, voffA);
            PG8_WAIT_V(8); PG8_WAIT_L(0); PG8_BAR; PG8_MMA(0, 0, At, B0); PG8_MMA(0, 1, At, B1); PG8_BAR; PG8_SCHED;
            PG8_LDA(At, 1, 1); PG8_STAGE(PG8_SB(1, 0), b3, voffB); PG8_STAGE(PG8_SB(1, 1), b3 + hstep, voffB); PG8_STAGE(PG8_SA(1, 0), a3, voffA);
            PG8_WAIT_V(8); PG8_WAIT_L(0); PG8_BAR; PG8_MMA(1, 0, At, B0); PG8_MMA(1, 1, At, B1); PG8_BAR; PG8_SCHED;
            } else {
            PG8_LDB(B0, 0, 0); PG8_SCHED; PG8_LDA(At, 0, 0); PG8_STAGE(PG8_SA(1, 1), a1 + hstep, voffA);
            PG8_WAIT_L(8); PG8_BAR; PG8_WAIT_L(0); PG8_MMA(0, 0, At, B0); PG8_BAR; PG8_SCHED;
            PG8_LDB(B1, 0, 1); PG8_STAGE(PG8_SB(0, 0), b2, voffB);
            PG8_BAR; PG8_WAIT_L(0); PG8_MMA(0, 1, At, B1); PG8_BAR;
            PG8_LDA(At, 0, 1); PG8_STAGE(PG8_SA(0, 0), a2, voffA);
            PG8_BAR; PG8_WAIT_L(0); PG8_MMA(1, 0, At, B0); PG8_BAR; PG8_SCHED;
            PG8_STAGE(PG8_SB(0, 1), b2 + hstep, voffB);
            PG8_WAIT_V(6); PG8_BAR; PG8_MMA(1, 1, At, B1); PG8_BAR;
            PG8_LDB(B0, 1, 0); PG8_SCHED; PG8_LDA(At, 1, 0); PG8_STAGE(PG8_SA(0, 1), a2 + hstep, voffA);
            PG8_WAIT_L(8); PG8_BAR; PG8_WAIT_L(0); PG8_MMA(0, 0, At, B0); PG8_BAR; PG8_SCHED;
            PG8_LDB(B1, 1, 1); PG8_STAGE(PG8_SB(1, 0), b3, voffB);
            PG8_BAR; PG8_WAIT_L(0); PG8_MMA(0, 1, At, B1); PG8_BAR;
            PG8_LDA(At, 1, 1); PG8_STAGE(PG8_SA(1, 0), a3, voffA);
            PG8_BAR; PG8_WAIT_L(0); PG8_MMA(1, 0, At, B0); PG8_BAR; PG8_SCHED;
            PG8_STAGE(PG8_SB(1, 1), b3 + hstep, voffB);
            PG8_WAIT_V(6); PG8_BAR; PG8_MMA(1, 1, At, B1); PG8_BAR;
            }
        }
        if constexpr (ALIGN_EPI) { if (wr == 0) PG8_BAR; }
        bool rst_ = true; if constexpr (!Epi::AFTER_DRAIN) { rst_ = E(acc, cur, wr, wc, fr, fq); S.done(cur); }
        if (!has_next) break;
        if (rst_) {
#pragma unroll
        for (int a = 0; a < 2; ++a)
#pragma unroll
            for (int b = 0; b < 2; ++b)
#pragma unroll
                for (int m = 0; m < 4; ++m)
#pragma unroll
                    for (int n = 0; n < 2; ++n) acc[a][b][m][n] = (f32x4){0.f, 0.f, 0.f, 0.f};
        }
        cur = nxt; cA = nA; cB = nB; ++ui;
        if constexpr (ALIGN_EPI) { if (wr == 1) PG8_BAR; }
    }
    PG8_WAIT_V(0);
    if constexpr (!ALIGN_EPI) { if (wr == 0) PG8_BAR; }
    PG8_BAR;
    if constexpr (Epi::AFTER_DRAIN) { E.fused(acc, cur, wr, wc, fr, fq, lds, wid, lane); S.done(cur); }
#undef PG8_SA
#undef PG8_SB
#undef PG8_STAGE
#undef PG8_LDA
#undef PG8_LDB
#undef PG8_MMA
#undef PG8_WAIT_V
#undef PG8_WAIT_L
#undef PG8_BAR
#undef PG8_SCHED
}
}
using pg8::Unit;
#define EPI_ROWS_BEGIN _Pragma("unroll") for (int ai = 0; ai < 2; ++ai) _Pragma("unroll") for (int m = 0; m < 4; ++m) { const int row = u.pm * 256 + ai * 128 + wr * 64 + m * 16 + fr;
#define EPI_COLS_BEGIN _Pragma("unroll") for (int bj = 0; bj < 2; ++bj) { const int col = u.pn * 256 + bj * 128 + wc * 32 + 8 * fq; \
    float v[8]; { const f32x4 a0 = acc[ai][bj][m][0], a1 = acc[ai][bj][m][1]; v[0] = a0[0]; v[1] = a0[1]; v[2] = a0[2]; v[3] = a0[3]; v[4] = a1[0]; v[5] = a1[1]; v[6] = a1[2]; v[7] = a1[3]; }
#define EPI_END } asm volatile("" ::: "memory"); }
__device__ __forceinline__ void st_bf16x8(bf16_t* p, const float* v) { *(u32x4*)p = pack8(v); }
__device__ __forceinline__ void st_f32x8(float* p, const float* v) { *(f32x4*)p = (f32x4){v[0], v[1], v[2], v[3]}; *(f32x4*)(p + 4) = (f32x4){v[4], v[5], v[6], v[7]}; }

template <int XL> __device__ __forceinline__ void rope8(float* v, bool second, const float* cs, const float* sn) {
    const f32x4 c0 = *(const f32x4*)cs, c1 = *(const f32x4*)(cs + 4), s0 = *(const f32x4*)sn, s1 = *(const f32x4*)(sn + 4);
    const float c[8] = {c0[0], c0[1], c0[2], c0[3], c1[0], c1[1], c1[2], c1[3]}, s[8] = {s0[0], s0[1], s0[2], s0[3], s1[0], s1[1], s1[2], s1[3]};
#pragma unroll
    for (int i = 0; i < 8; ++i) { const float p = __shfl_xor(v[i], XL); v[i] = v[i] * c[i] + (second ? p : -p) * s[i]; }
}

struct EpiG1 {
    static constexpr bool PERM = true, AFTER_DRAIN = false;
    bf16_t *RX, *CQ, *CKV, *KR; float* okr; const float* rope; int l;
    __device__ __forceinline__ bool operator()(f32x4 (&acc)[2][2][4][2], const Unit& u, int wr, int wc, int fr, int fq) const {
        const bool dec = u.pm >= 32;
        EPI_ROWS_BEGIN
            const int kvr = kvrow_of(row);
            EPI_COLS_BEGIN
                if (col < 512) st_bf16x8(RX + (size_t)row * 512 + col, v);
                else if (col < 896) st_bf16x8(CQ + (size_t)row * 384 + (col - 512), v);
                else if (col < 1152) st_bf16x8(CKV + (size_t)kvr * 256 + (col - 896), v);
                else if (col < 1184) {
                    const int e = col - 1152;
                    if (dec) { const int t = (row - NP) & 2047, pos = (fq & 2) ? (t & 63) : (t >> 6);
                        rope8<16>(v, (fq & 1) != 0, rope + pos * 8, rope + 512 + pos * 8); }
                    else st_f32x8(okr + (size_t)cache_row(row, l) * 32 + e, v);
                    st_bf16x8(KR + (size_t)kvr * 32 + e, v);
                }
            EPI_END
        return true;
    }
};
struct EpiQ {
    static constexpr bool PERM = true, AFTER_DRAIN = false;
    bf16_t* Q; const float* rope;
    __device__ __forceinline__ bool operator()(f32x4 (&acc)[2][2][4][2], const Unit& u, int wr, int wc, int fr, int fq) const {
        const bool dec = u.pm >= 32;
        EPI_ROWS_BEGIN
            EPI_COLS_BEGIN
                const int g32 = col >> 5;
                if (dec && (g32 % 3) == 2) { const int t = (row - NP) & 2047, pos = (fq & 2) ? (t & 63) : (t >> 6);
                    rope8<16>(v, (fq & 1) != 0, rope + pos * 8, rope + 512 + pos * 8); }
#pragma unroll
                for (int i = 0; i < 8; ++i) v[i] *= SCALE_M;
                st_bf16x8(Q + (size_t)row * 768 + col, v);
            EPI_END
        return true;
    }
};
struct EpiPlain {
    static constexpr bool PERM = true, AFTER_DRAIN = false;
    bf16_t* O; int ldc;
    __device__ __forceinline__ bool operator()(f32x4 (&acc)[2][2][4][2], const Unit& u, int wr, int wc, int fr, int fq) const {
        EPI_ROWS_BEGIN
            EPI_COLS_BEGIN
                st_bf16x8(O + (size_t)row * ldc + col, v);
            EPI_END
        return true;
    }
};
struct EpiG3 {
    static constexpr bool PERM = true, AFTER_DRAIN = false;
    bf16_t *DQ, *DK, *DV; float *odk, *odv; const float* rope; int l;
    __device__ __forceinline__ bool operator()(f32x4 (&acc)[2][2][4][2], const Unit& u, int wr, int wc, int fr, int fq) const {
        const bool dec = u.pm >= 32;
        EPI_ROWS_BEGIN
            const int kvr = kvrow_of(row);
            EPI_COLS_BEGIN
                if (col < 1024) {
                    if (dec) { const int t = (row - NP) & 2047, pos = ((col >> 5) & 1) ? (t & 63) : (t >> 6);
                        rope8<32>(v, (fq & 2) != 0, rope + pos * 16 + (fq & 1) * 8, rope + 1024 + pos * 16 + (fq & 1) * 8); }
                    if (col < 512) {
#pragma unroll
                        for (int i = 0; i < 8; ++i) v[i] *= SCALE_D;
                        st_bf16x8(DQ + (size_t)row * 512 + col, v);
                    } else {
                        if (!dec) st_f32x8(odk + (size_t)cache_row(row, l) * 512 + (col - 512), v);
                        st_bf16x8(DK + (size_t)kvr * 512 + (col - 512), v);
                    }
                } else {
                    if (!dec) st_f32x8(odv + (size_t)cache_row(row, l) * 512 + (col - 1024), v);
                    st_bf16x8(DV + (size_t)kvr * 512 + (col - 1024), v);
                }
            EPI_END
        return true;
    }
};
struct EpiG4 {
    static constexpr bool PERM = true, AFTER_DRAIN = false;
    bf16_t* Y; bf16_t* G; int row_off;
    __device__ __forceinline__ bool operator()(f32x4 (&acc)[2][2][4][2], const Unit& u, int wr, int wc, int fr, int fq) const {
        EPI_ROWS_BEGIN
            EPI_COLS_BEGIN
                if (col < 1536) {
                    const int slot = col >> 9, cc = col & 511;
                    bf16_t* p = Y + (size_t)slot * ((size_t)NTOK * 512) + (size_t)(row + row_off) * 512 + cc;
                    float pre[8]; unpack8(*(const u32x4*)p, pre);
#pragma unroll
                    for (int i = 0; i < 8; ++i) v[i] = pre[i] * siluf_(v[i]);
                    st_bf16x8(p, v);
                } else {
#pragma unroll
                    for (int i = 0; i < 8; ++i) v[i] = sigmoidf_(v[i]);
                    st_bf16x8(G + (size_t)row * 3072 + (col - 1536), v);
                }
            EPI_END
        return true;
    }
};
struct EpiG5 {
    static constexpr bool PERM = true, AFTER_DRAIN = false;
    const bf16_t* G; bf16_t* MG; int half;
    __device__ __forceinline__ bool operator()(f32x4 (&acc)[2][2][4][2], const Unit& u, int wr, int wc, int fr, int fq) const {
        const int br = u.pn >> 2, pn = u.pn & 3, pml = u.pm - br * 96 - half * 48;
#pragma unroll
        for (int ai = 0; ai < 2; ++ai)
#pragma unroll
            for (int m = 0; m < 4; ++m) { const int rl = pml * 256 + ai * 128 + wr * 64 + m * 16 + fr;
#pragma unroll
                for (int bj = 0; bj < 2; ++bj) { const int col = pn * 256 + bj * 128 + wc * 32 + 8 * fq;
                    float g0[8], f[8]; unpack8(*(const u32x4*)(G + (size_t)rl * 3072 + br * 1024 + col), g0);
                    if (br < 2) { float g1[8]; unpack8(*(const u32x4*)(G + (size_t)rl * 3072 + (br + 1) * 1024 + col), g1);
#pragma unroll
                        for (int i = 0; i < 8; ++i) f[i] = fmaxf(g0[i], 1e-30f) / fmaxf(g1[i], 1e-30f);
                        if (br == 0) {
#pragma unroll
                            for (int i = 0; i < 8; ++i) f[i] = g0[i] / fmaxf(g1[i], 1e-30f);
                        }
                    } else {
#pragma unroll
                        for (int i = 0; i < 8; ++i) f[i] = fmaxf(g0[i], 1e-30f);
                    }
                    f32x4& a0 = acc[ai][bj][m][0]; f32x4& a1 = acc[ai][bj][m][1];
                    a0[0] *= f[0]; a0[1] *= f[1]; a0[2] *= f[2]; a0[3] *= f[3]; a1[0] *= f[4]; a1[1] *= f[5]; a1[2] *= f[6]; a1[3] *= f[7];
                    if (br == 2) { const float v[8] = {a0[0], a0[1], a0[2], a0[3], a1[0], a1[1], a1[2], a1[3]};
                        st_bf16x8(MG + (size_t)(half * HALF_TOK + rl) * 1024 + col, v); }
                } }
        return br == 2;
    }
};
struct EpiG6 {
    static constexpr bool PERM = true, AFTER_DRAIN = false;
    bf16_t* O; float* ssq;
    __device__ __forceinline__ bool operator()(f32x4 (&acc)[2][2][4][2], const Unit& u, int wr, int wc, int fr, int fq) const {
        EPI_ROWS_BEGIN
            float s = 0.f;
            EPI_COLS_BEGIN
#pragma unroll
                for (int i = 0; i < 8; ++i) s += v[i] * v[i];
                st_bf16x8(O + (size_t)row * 1024 + col, v);
            }
            s += __shfl_xor(s, 16); s += __shfl_xor(s, 32);
            if (fq == 0) ssq[(size_t)row * 16 + u.pn * 4 + wc] = s;
        }
        return true;
    }
};
namespace att {
#define SBAR() __builtin_amdgcn_sched_barrier(0)
__device__ __forceinline__ int crow(int r, int hi) { return (r & 3) + 8 * (r >> 2) + 4 * hi; }
template <int DQK> __device__ __forceinline__ int kswz(int row, int chunk) {
    if constexpr (DQK == 64) return row * 128 + ((chunk ^ ((row >> 1) & 7)) << 4);
    else return row * 256 + ((chunk ^ (row & 15)) << 4);
}
template <int DQK> struct KTile { static constexpr int BYTES = DQK == 64 ? 8192 : 16384; };
template <int DV> __device__ __forceinline__ int v_st(int k, int c) { return ((k >> 3) * (DV / 32) + (c >> 5)) * 512 + ((k & 7) * 32 + (c & 31)) * 2; }
__device__ __forceinline__ int v_rd_base(int lane) { return ((lane & 3) << 3) | (((lane >> 2) & 3) << 6) | (((lane >> 4) & 1) << 5) | (((lane >> 5) & 1) << 8); }
template <int OFF> __device__ __forceinline__ s16x4 tr_read(int vb) {
    s16x4 r; asm volatile("ds_read_b64_tr_b16 %0, %1 offset:%2" : "=&v"(r) : "v"(vb), "i"(OFF) : "memory"); return r;
}
template <int DV, int D0> __device__ __forceinline__ void pv_one(f32x16& od, int vb, bf16x8 pa0, bf16x8 pa1, bf16x8 pa2, bf16x8 pa3) {
    constexpr int NB = DV / 32;
#define VOFF(ks, half) (((2 * (ks) + (half)) * NB + D0) * 512)
    const s16x4 l0 = tr_read<VOFF(0, 0)>(vb), h0 = tr_read<VOFF(0, 1)>(vb), l1 = tr_read<VOFF(1, 0)>(vb), h1 = tr_read<VOFF(1, 1)>(vb);
    const s16x4 l2 = tr_read<VOFF(2, 0)>(vb), h2 = tr_read<VOFF(2, 1)>(vb), l3 = tr_read<VOFF(3, 0)>(vb), h3 = tr_read<VOFF(3, 1)>(vb);
#undef VOFF
    asm volatile("s_waitcnt lgkmcnt(0)" ::: "memory"); SBAR();
#define PK(L, H) (bf16x8){L[0], L[1], L[2], L[3], H[0], H[1], H[2], H[3]}
    od = __builtin_amdgcn_mfma_f32_32x32x16_bf16(pa0, PK(l0, h0), od, 0, 0, 0);
    od = __builtin_amdgcn_mfma_f32_32x32x16_bf16(pa1, PK(l1, h1), od, 0, 0, 0);
    od = __builtin_amdgcn_mfma_f32_32x32x16_bf16(pa2, PK(l2, h2), od, 0, 0, 0);
    od = __builtin_amdgcn_mfma_f32_32x32x16_bf16(pa3, PK(l3, h3), od, 0, 0, 0);
#undef PK
}
template <int DV> __device__ __forceinline__ void pv_all(f32x16* o, int vb, bf16x8 pa0, bf16x8 pa1, bf16x8 pa2, bf16x8 pa3) {
    pv_one<DV, 0>(o[0], vb, pa0, pa1, pa2, pa3); pv_one<DV, 1>(o[1], vb, pa0, pa1, pa2, pa3);
    if constexpr (DV == 128) { pv_one<DV, 2>(o[2], vb, pa0, pa1, pa2, pa3); pv_one<DV, 3>(o[3], vb, pa0, pa1, pa2, pa3); }
}
constexpr float THRL = 6.0f;
__device__ __forceinline__ void partialSM(f32x16& p0, f32x16& p1, float& m_reg, float& alpha) {
    float pmax = p0[0];
#pragma unroll
    for (int r = 1; r < 16; ++r) pmax = fmaxf(pmax, p0[r]);
#pragma unroll
    for (int r = 0; r < 16; ++r) pmax = fmaxf(pmax, p1[r]);
    { auto rr = __builtin_amdgcn_permlane32_swap(__float_as_uint(pmax), __float_as_uint(pmax), false, false);
      pmax = fmaxf(__uint_as_float(rr[0]), __uint_as_float(rr[1])); }
    float mn;
    if (__builtin_expect(__all(pmax - m_reg <= THRL), 1)) { mn = m_reg; alpha = 1.f; }
    else { mn = fmaxf(m_reg, pmax); alpha = __builtin_amdgcn_exp2f(m_reg - mn); m_reg = mn; }
#pragma unroll
    for (int r = 0; r < 16; ++r) p0[r] = __builtin_amdgcn_exp2f(p0[r] - mn);
#pragma unroll
    for (int r = 0; r < 16; ++r) p1[r] -= mn;
}
__device__ __forceinline__ void finishSM(f32x16& p0, f32x16& p1, float alpha, float& l_reg, bf16x8& pa0, bf16x8& pa1, bf16x8& pa2, bf16x8& pa3) {
#pragma unroll
    for (int r = 0; r < 16; ++r) p1[r] = __builtin_amdgcn_exp2f(p1[r]);
    float ps = 0.f;
#pragma unroll
    for (int r = 0; r < 16; ++r) ps += p0[r];
#pragma unroll
    for (int r = 0; r < 16; ++r) ps += p1[r];
    l_reg = l_reg * alpha + ps;
#define PK4(P, B, OUT) do { u32x4 w = {pk2(P[B + 0], P[B + 1]), pk2(P[B + 2], P[B + 3]), pk2(P[B + 4], P[B + 5]), pk2(P[B + 6], P[B + 7])}; OUT = __builtin_bit_cast(bf16x8, w); } while (0)
    PK4(p0, 0, pa0); PK4(p0, 8, pa1); PK4(p1, 0, pa2); PK4(p1, 8, pa3);
#undef PK4
}
template <int DQK> __device__ __forceinline__ void qkt(f32x16& p0, f32x16& p1, const char* Ks, const bf16x8* qr, int r32, int hi) {
    p0 = f32x16{}; p1 = f32x16{};
#pragma unroll
    for (int d0 = 0; d0 < DQK / 16; ++d0) {
        const bf16x8 b0 = *reinterpret_cast<const bf16x8*>(Ks + kswz<DQK>(r32, 2 * d0 + hi));
        const bf16x8 b1 = *reinterpret_cast<const bf16x8*>(Ks + kswz<DQK>(32 + r32, 2 * d0 + hi));
        p0 = __builtin_amdgcn_mfma_f32_32x32x16_bf16(b0, qr[d0], p0, 0, 0, 0);
        p1 = __builtin_amdgcn_mfma_f32_32x32x16_bf16(b1, qr[d0], p1, 0, 0, 0);
    }
}
template <int DQK, int DV, int SDEPTH>
__device__ __forceinline__ void attn_core(const bf16_t* __restrict__ Qw, int ldq, const bf16_t* __restrict__ K1, int ldk1, const bf16_t* __restrict__ K2, int ldk2,
                                          const bf16_t* __restrict__ Vp, int ldv, int nkeys, char* lds, f32x16 (&o)[DV / 32], float& l_out) {
    constexpr int SHM_V = 64 * DV * 2, SHM_K = KTile<DQK>::BYTES;
    const int tid = tid_now(), wid = tid >> 6, lane = tid & 63, r32 = lane & 31, hi = lane >> 5;
    char* V_lds = lds; char* K_lds = lds + 2 * SHM_V;
    float* al_l = (float*)(lds + 2 * SHM_V + 2 * SHM_K) + wid * 64;
    float m_reg = -1e30f, l_reg = 0.f;
#pragma unroll
    for (int d = 0; d < DV / 32; ++d) o[d] = f32x16{};
    bf16x8 qr[DQK / 16];
    { const bf16_t* q = Qw + (size_t)(wid * 32 + r32) * ldq + hi * 8;
#pragma unroll
      for (int d0 = 0; d0 < DQK / 16; ++d0) qr[d0] = *reinterpret_cast<const bf16x8*>(q + d0 * 16); }
    const int kr_ = tid >> 3, kc_ = tid & 7;
    const int vr_ = DV == 64 ? (tid >> 3) : (tid >> 4), vc_ = DV == 64 ? (tid & 7) * 8 : (tid & 15) * 8;
    const int kst = kswz<DQK>(kr_, kc_);
    const int k2st = DQK == 96 ? kswz<DQK>(kr_, 8 + (kc_ >> 1)) + (kc_ & 1) * 8 : 0;
    const int vst0 = v_st<DV>(vr_, vc_), vst1 = v_st<DV>(32 + vr_, vc_);
    const int vb0 = (int)(uintptr_t)V_lds + v_rd_base(lane);
    struct Slot { bf16x8 k1; u32x2 k2; bf16x8 v0; bf16x8 v1; };
    Slot sE, sO;
#define SLOAD(S, k0) do { (S).k1 = *reinterpret_cast<const bf16x8*>(K1 + (size_t)((k0) + kr_) * ldk1 + kc_ * 8); \
        if constexpr (DQK == 96) (S).k2 = *reinterpret_cast<const u32x2*>(K2 + (size_t)((k0) + kr_) * ldk2 + kc_ * 4); \
        (S).v0 = *reinterpret_cast<const bf16x8*>(Vp + (size_t)((k0) + vr_) * ldv + vc_); \
        if constexpr (DV == 128) (S).v1 = *reinterpret_cast<const bf16x8*>(Vp + (size_t)((k0) + 32 + vr_) * ldv + vc_); } while (0)
#define SWRITE(b, S) do { *reinterpret_cast<bf16x8*>(K_lds + (b) * SHM_K + kst) = (S).k1; \
        if constexpr (DQK == 96) *reinterpret_cast<u32x2*>(K_lds + (b) * SHM_K + k2st) = (S).k2; \
        *reinterpret_cast<bf16x8*>(V_lds + (b) * SHM_V + vst0) = (S).v0; \
        if constexpr (DV == 128) *reinterpret_cast<bf16x8*>(V_lds + (b) * SHM_V + vst1) = (S).v1; } while (0)
#define RESC(a) do { if (__any((a) < 1.f)) { if (hi == 0) al_l[r32] = (a); asm volatile("s_waitcnt lgkmcnt(0)" ::: "memory"); \
        _Pragma("unroll") for (int d = 0; d < DV / 32; ++d) _Pragma("unroll") for (int r = 0; r < 16; ++r) o[d][r] *= al_l[crow(r, hi)]; } } while (0)
    if constexpr (SDEPTH == 0) {
        f32x16 p0, p1; float al; bf16x8 pa0, pa1, pa2, pa3; const int NT = nkeys / 64;
        __syncthreads();
        SLOAD(sE, 0); SWRITE(0, sE); SLOAD(sE, 64); __syncthreads();
#pragma unroll 1
        for (int j = 0; j < NT; ++j) {
            const int b = j & 1;
            SBAR(); qkt<DQK>(p0, p1, K_lds + b * SHM_K, qr, r32, hi);
            partialSM(p0, p1, m_reg, al); RESC(al);
            finishSM(p0, p1, al, l_reg, pa0, pa1, pa2, pa3); SBAR();
            pv_all<DV>(o, vb0 + b * SHM_V, pa0, pa1, pa2, pa3);
            if (j + 1 < NT) { SWRITE(b ^ 1, sE); if (j + 2 < NT) SLOAD(sE, (j + 2) * 64); }
            __syncthreads();
        }
    } else {
    f32x16 pA0, pA1, pB0, pB1; float alA, alB; bf16x8 pa0, pa1, pa2, pa3; const int NT = nkeys / 64;
    __syncthreads();
    SLOAD(sE, 0); SWRITE(0, sE); __syncthreads();
    qkt<DQK>(pA0, pA1, K_lds, qr, r32, hi); partialSM(pA0, pA1, m_reg, alA);
    if constexpr (SDEPTH == 2) { SLOAD(sO, 64); if (2 < NT) SLOAD(sE, 128); SWRITE(1, sO); } else { SLOAD(sE, 64); SWRITE(1, sE); }
    __syncthreads();
#pragma unroll 1
    for (int j = 1; j + 1 < NT; j += 2) {
        SBAR(); qkt<DQK>(pB0, pB1, K_lds + SHM_K, qr, r32, hi);
        finishSM(pA0, pA1, alA, l_reg, pa0, pa1, pa2, pa3); SBAR();
        if constexpr (SDEPTH == 2) SLOAD(sO, (j + 2) * 64); else SLOAD(sE, (j + 1) * 64);
        SBAR();
        pv_all<DV>(o, vb0, pa0, pa1, pa2, pa3); partialSM(pB0, pB1, m_reg, alB);
        __syncthreads(); SWRITE(0, sE);
        RESC(alB); __syncthreads();
        SBAR(); qkt<DQK>(pA0, pA1, K_lds, qr, r32, hi);
        finishSM(pB0, pB1, alB, l_reg, pa0, pa1, pa2, pa3); SBAR();
        if constexpr (SDEPTH == 2) { if (j + 3 < NT) SLOAD(sE, (j + 3) * 64); } else SLOAD(sE, (j + 2) * 64);
        SBAR();
        pv_all<DV>(o, vb0 + SHM_V, pa0, pa1, pa2, pa3); partialSM(pA0, pA1, m_reg, alA);
        __syncthreads(); if constexpr (SDEPTH == 2) SWRITE(1, sO); else SWRITE(1, sE);
        RESC(alA); __syncthreads();
    }
    SBAR(); qkt<DQK>(pB0, pB1, K_lds + SHM_K, qr, r32, hi);
    finishSM(pA0, pA1, alA, l_reg, pa0, pa1, pa2, pa3); SBAR();
    pv_all<DV>(o, vb0, pa0, pa1, pa2, pa3); partialSM(pB0, pB1, m_reg, alB);
    __syncthreads(); RESC(alB);
    finishSM(pB0, pB1, alB, l_reg, pa0, pa1, pa2, pa3); SBAR();
    pv_all<DV>(o, vb0 + SHM_V, pa0, pa1, pa2, pa3);
    }
    { auto rr = __builtin_amdgcn_permlane32_swap(__float_as_uint(l_reg), __float_as_uint(l_reg), false, false);
      l_out = __uint_as_float(rr[0]) + __uint_as_float(rr[1]); }
#undef SLOAD
#undef SWRITE
#undef RESC
}
}
typedef const float __attribute__((address_space(1)))* cfp_t;
constexpr int LDS_TAB = 146432;
struct Frame {
    unsigned char* lds; unsigned char* ws; float* out; const LAS cfp_t* in;
    int tid, lane, wave, vcu, G, bid;
};
#define IN_(k) ((const float*)F.in[k])

__device__ __forceinline__ void tr_item(const float* W, int ldw, int col0, int K, bf16_t* WT, int drow0, int kb, int nb, LAS float* scr, int lane, bool zero) {
    const int k0 = 64 * kb, n0 = 32 * nb;
    if (!zero) {
#pragma unroll 8
        for (int i = 0; i < 32; ++i) { const int kk = 2 * i + (lane >> 5); scr[kk * 33 + (lane & 31)] = W[(size_t)(k0 + kk) * ldw + col0 + n0 + (lane & 31)]; }
    }
    asm volatile("s_waitcnt lgkmcnt(0)" ::: "memory");
    const int c = lane & 7;
#pragma unroll
    for (int j = 0; j < 4; ++j) { const int n = (lane >> 3) + 8 * j; const LAS float* s = scr + (8 * c) * 33 + n;
        u32x4 o; o.x = pk2(s[0 * 33], s[1 * 33]); o.y = pk2(s[2 * 33], s[3 * 33]); o.z = pk2(s[4 * 33], s[5 * 33]); o.w = pk2(s[6 * 33], s[7 * 33]);
        if (zero) o = (u32x4){0u, 0u, 0u, 0u};
        *(u32x4*)(WT + (size_t)(drow0 + n0 + n) * K + k0 + 8 * c) = o; }
    asm volatile("s_waitcnt lgkmcnt(0)" ::: "memory");
}
__device__ __forceinline__ int win_src_col(int r) {
    if (r < 512) return r;
    if (r < 896) return 1024 + (r - 512);
    if (r < 1152) return 1408 + (r - 896);
    if (r < 1184) return 1664;
    if (r < 1280) return -1;
    if (r < 1792) return 2208 + (r - 1280);
    if (r < 2304) return 2720 + (r - 1792);
    if (r < 2816) return 3232 + (r - 2304);
    if (r < 3328) return 512 + (r - 2816);
    if (r < 3840) return 1696 + (r - 3328);
    if (r < 4352) return 3744 + (r - 3840);
    return 4256 + (r - 4352);
}
__device__ __forceinline__ void convert_weights(Frame& F, int l) {
    LAS float* scr = (LAS float*)(F.lds) + F.wave * 2176;
    unsigned char* Wb = F.ws + WS_W;
    const int gw = F.vcu * 8 + F.wave, NGW = F.G * 8;
    constexpr int I_IN = 16 * 232, I_UQ = 6 * 24, I_UKV = 4 * 32, I_BR = 8 * 32, I_OUT = 16 * 32, I_RG = 64;
    constexpr int NITEMS = I_IN + I_UQ + I_UKV + 3 * I_BR + I_OUT + I_RG;
    for (int it = gw; it < NITEMS; it += NGW) {
        int r = it;
        if (r < I_IN) { const int db = r % 232, kb = r / 232; const int sc = win_src_col(db * 32);
            tr_item(IN_(13) + (size_t)l * 1024 * IN_COLS, IN_COLS, sc < 0 ? 0 : sc, 1024, (bf16_t*)(Wb + W_IN), db * 32, kb, 0, scr, F.lane, sc < 0); continue; } r -= I_IN;
        if (r < I_UQ) { tr_item(IN_(22) + (size_t)l * 384 * 768, 768, 0, 384, (bf16_t*)(Wb + W_UQ), 0, r / 24, r % 24, scr, F.lane, false); continue; } r -= I_UQ;
        if (r < I_UKV) { tr_item(IN_(24) + (size_t)l * 256 * 1024, 1024, 0, 256, (bf16_t*)(Wb + W_UKV), 0, r / 32, r % 32, scr, F.lane, false); continue; } r -= I_UKV;
        if (r < 3 * I_BR) { const int b = r / I_BR, q = r % I_BR;
            tr_item((b == 0 ? IN_(30) : b == 1 ? IN_(31) : IN_(32)) + (size_t)l * 512 * 1024, 1024, 0, 512, (bf16_t*)(Wb + W_BR), b * 1024, q / 32, q % 32, scr, F.lane, false); continue; } r -= 3 * I_BR;
        if (r < I_OUT) { tr_item(IN_(33) + (size_t)l * 1024 * 1024, 1024, 0, 1024, (bf16_t*)(Wb + W_OUT), 0, r / 32, r % 32, scr, F.lane, false); continue; } r -= I_OUT;
        { const int mat = r >> 1, nb = r & 1, gate = mat >> 4, dn = mat & 15;
          const float* src = (gate ? IN_(18) : IN_(16)) + ((size_t)l * 16 + dn) * 4096;
          const int d = dn >> 3, n = dn & 7;
          tr_item(src, 64, 0, 64, (bf16_t*)(Wb + W_RG) + (size_t)((d * 2 + gate) * 8 + n) * 4096, 0, 0, nb, scr, F.lane, false); }
    }
}
__device__ __forceinline__ void phase0_mod_rope(Frame& F) {
    float* mod = (float*)(F.ws + CTL_MOD);
    if (F.bid < 96) {
        const int l = F.bid / 48, c0 = (F.bid % 48) * 64;
        LAS float* sc = (LAS float*)F.lds + 8 * 2176;
        LAS float* red = sc + 9 * 1024;
        for (int i = F.tid; i < 9 * 1024; i += NTHREADS) { const int g = i >> 10, k = i & 1023; const float x = g == 0 ? IN_(8)[k] : IN_(7)[(g - 1) * 1024 + k]; sc[i] = siluf_(x); }
        __syncthreads();
        float a[9];
#pragma unroll
        for (int g = 0; g < 9; ++g) a[g] = 0.f;
        const float* w = IN_(9) + (size_t)l * 1024 * 3072 + c0 + F.lane;
        for (int k = F.wave * 128; k < F.wave * 128 + 128; ++k) { const float wv = w[(size_t)k * 3072];
#pragma unroll
            for (int g = 0; g < 9; ++g) a[g] += sc[g * 1024 + k] * wv; }
#pragma unroll
        for (int g = 0; g < 9; ++g) red[(F.wave * 9 + g) * 64 + F.lane] = a[g];
        __syncthreads();
        for (int i = F.tid; i < 9 * 64; i += NTHREADS) { const int g = i >> 6, c = i & 63; float s = IN_(10)[l * 3072 + c0 + c];
#pragma unroll
            for (int wv = 0; wv < 8; ++wv) s += red[(wv * 9 + g) * 64 + c];
            mod[((size_t)l * 9 + g) * 3072 + c0 + c] = s; }
        __syncthreads();
    } else if (F.bid == 96) {
        float* rp = (float*)(F.ws + CTL_ROPE);
        for (int i = F.tid; i < 64 * 8; i += NTHREADS) { const int pos = i >> 3, j = i & 7; const float ang = (float)pos * powf(10000.0f, -(float)j / 8.0f); rp[i] = cosf(ang); rp[512 + i] = sinf(ang); }
        for (int i = F.tid; i < 64 * 16; i += NTHREADS) { const int pos = i >> 4, j = i & 15; const float ang = (float)pos * powf(10000.0f, -(float)j / 16.0f); rp[1024 + i] = cosf(ang); rp[2048 + i] = sinf(ang); }
    }
}
__device__ __forceinline__ const float* x_row_l0(Frame& F, int r) { return r < NP ? IN_(0) + (size_t)r * DM : IN_(1) + (size_t)(r - NP) * DM; }
__device__ __forceinline__ void prenorm_store(Frame& F, const f32x4* v, int r, int l) {
    float s = 0.f;
#pragma unroll
    for (int j = 0; j < 4; ++j) s += (v[j].x * v[j].x + v[j].y * v[j].y) + (v[j].z * v[j].z + v[j].w * v[j].w);
    const float rstd = 1.0f / sqrtf(wave_sum(s) * (1.0f / DM) + EPS);
    const float* mod = (const float*)(F.ws + CTL_MOD) + ((size_t)l * 9 + grp_of(r)) * 3072;
    const float* gp = IN_(11) + l * DM;
    bf16_t* h = (bf16_t*)(F.ws + WS_H) + (size_t)r * DM;
#pragma unroll
    for (int j = 0; j < 4; ++j) { const int c = 4 * F.lane + 256 * j;
        const f32x4 g = *(const f32x4*)(gp + c), sh = *(const f32x4*)(mod + c), sc = *(const f32x4*)(mod + 1024 + c);
        const f32x4 y = (v[j] * rstd * g) * (sc + 1.0f) + sh;
        u32x2 w; w.x = pk2(y.x, y.y); w.y = pk2(y.z, y.w); *(u32x2*)(h + c) = w; }
}
__device__ __forceinline__ void phase0_h(Frame& F) {
    const int gw = F.vcu * 8 + F.wave, NGW = F.G * 8;
    for (int r = gw; r < NTOK; r += NGW) { const f32x4* xr = (const f32x4*)x_row_l0(F, r) + F.lane; f32x4 v[4];
#pragma unroll
        for (int j = 0; j < 4; ++j) v[j] = xr[64 * j];
        prenorm_store(F, v, r, 0); }
}
__device__ __forceinline__ void phase_post(Frame& F, int l) {
    const int gw = F.vcu * 8 + F.wave, NGW = F.G * 8;
    const bf16_t* O = (const bf16_t*)(F.ws + WS_A + A_O);
    const float* ssq = (const float*)(F.ws + CTL_SSQ);
    const float* gpost = IN_(12) + l * DM;
    for (int r = gw; r < NTOK; r += NGW) {
        float sq = F.lane < 16 ? ssq[(size_t)r * 16 + F.lane] : 0.f;
        const float rstd = 1.0f / sqrtf(wave_sum(sq) * (1.0f / DM) + EPS);
        const float* xin = l == 0 ? x_row_l0(F, r) : F.out + O_Y + (size_t)r * DM;
        float* xo = F.out + O_Y + (size_t)r * DM;
        const float* gate = (const float*)(F.ws + CTL_MOD) + ((size_t)l * 9 + grp_of(r)) * 3072 + 2048;
        f32x4 v[4];
#pragma unroll
        for (int j = 0; j < 4; ++j) { const int c = 4 * F.lane + 256 * j;
            const u32x2 ow = *(const u32x2*)(O + (size_t)r * DM + c);
            const f32x4 o = {bflo(ow.x), bfhi(ow.x), bflo(ow.y), bfhi(ow.y)};
            const f32x4 x = *(const f32x4*)(xin + c), g = *(const f32x4*)(gpost + c), gt = *(const f32x4*)(gate + c);
            v[j] = x + gt * (o * rstd * g);
            *(f32x4*)(xo + c) = v[j]; }
        if (l == 0) prenorm_store(F, v, r, 1);
    }
}
constexpr int RN_RAW = 0;
constexpr int RN_XB = 38016;
constexpr int RN_XF = RN_XB + 36864;
constexpr int RN_WC = RN_XF + 16384;
static_assert(RN_WC + 1024 <= 131072, "rnn LDS map");
#define LDS_BARRIER() asm volatile("s_waitcnt lgkmcnt(0)\n\ts_barrier" ::: "memory")
__device__ __forceinline__ float neg_expm1(float x, float ex) {
    const float s = -x * (1.0f + x * (0.5f + x * (0.16666667f + x * (0.041666668f + x * 0.008333334f))));
    return x > -0.125f ? s : 1.0f - ex;
}
__device__ __forceinline__ void rnn_item(Frame& F, int l, int seq, int n, int qt) {
    const bool dec = seq >= 32;
    const int S = dec ? 2048 : 256, tok0 = dec ? NP + (seq - 32) * 2048 : seq * 256, nck = S / 256;
    const int tid = F.tid, lane = F.lane, wave = F.wave;
    const bf16_t* RX = (const bf16_t*)(F.ws + WS_Y + 2 * Y_SLOT) + (size_t)tok0 * 512 + n * 64;
    bf16_t* HS = (bf16_t*)(F.ws + WS_Y) + (size_t)tok0 * 512 + n * 64 + qt * 16;
    unsigned char* L = F.lds;
    const int oc0 = n * 64 + qt * 16;
    const int jc = lane & 15, g = lane >> 4;
    const int c8 = tid & 7, tb = tid >> 3;
    float cw[4][8], cbv[8];
#pragma unroll
    for (int k = 0; k < 4; ++k) { const f32x4 w0 = *(const f32x4*)(IN_(14) + ((size_t)l * 4 + k) * 512 + n * 64 + c8 * 8), w1 = *(const f32x4*)(IN_(14) + ((size_t)l * 4 + k) * 512 + n * 64 + c8 * 8 + 4);
        cw[k][0] = w0.x; cw[k][1] = w0.y; cw[k][2] = w0.z; cw[k][3] = w0.w; cw[k][4] = w1.x; cw[k][5] = w1.y; cw[k][6] = w1.z; cw[k][7] = w1.w; }
    { const f32x4 b0 = *(const f32x4*)(IN_(15) + l * 512 + n * 64 + c8 * 8), b1 = *(const f32x4*)(IN_(15) + l * 512 + n * 64 + c8 * 8 + 4);
      cbv[0] = b0.x; cbv[1] = b0.y; cbv[2] = b0.z; cbv[3] = b0.w; cbv[4] = b1.x; cbv[5] = b1.y; cbv[6] = b1.z; cbv[7] = b1.w; }
    u32x4 raw[5];
#define RN_LOAD(c0_) do { _Pragma("unroll") for (int i = 0; i < 5; ++i) { const int pc = tid + i * 512, rr = pc >> 3, pc8 = pc & 7, t = (c0_) - 2 + rr; \
        const bool ok = t >= 0 && t < S && pc < 2072; const int tc = ok ? t : 0; \
        if (i < 4 || tid < 24) { raw[i] = *(const u32x4*)(RX + (size_t)tc * 512 + pc8 * 8); if (!ok) raw[i] = (u32x4){0u, 0u, 0u, 0u}; } } } while (0)
#define RN_STORE() do { _Pragma("unroll") for (int i = 0; i < 5; ++i) { const int pc = tid + i * 512, rr = pc >> 3, pc8 = pc & 7; \
        if (i < 4 || tid < 24) *(u32x4*)(L + RN_RAW + rr * 144 + pc8 * 16) = raw[i]; } } while (0)
    for (int dir = 0; dir < 2; ++dir) {
        const float ba = IN_(17)[(l * 2 + dir) * 512 + oc0 + jc], bx = IN_(19)[(l * 2 + dir) * 512 + oc0 + jc];
        const float lam = IN_(20)[(l * 2 + dir) * 512 + oc0 + jc];
        const float sp8 = -8.0f * log1pf(__expf(-lam));
        const bf16_t* wt = (const bf16_t*)(F.ws + WS_W + W_RG);
        bf16x8 wa[2], wx[2];
#pragma unroll
        for (int ks = 0; ks < 2; ++ks) {
            wa[ks] = *(const bf16x8*)(wt + (size_t)((dir * 2 + 0) * 8 + n) * 4096 + (qt * 16 + jc) * 64 + ks * 32 + g * 8);
            wx[ks] = *(const bf16x8*)(wt + (size_t)((dir * 2 + 1) * 8 + n) * 4096 + (qt * 16 + jc) * 64 + ks * 32 + g * 8); }
        float carry = dec ? IN_(6)[(((seq - 32) * 2 + l) * 2 + dir) * 512 + oc0 + jc] : 0.f;
        asm volatile("s_waitcnt vmcnt(0)" ::: "memory");
        RN_LOAD(dir == 0 ? 0 : (nck - 1) * 256);
        for (int cc = 0; cc < nck; ++cc) {
            const int ci = dir == 0 ? cc : nck - 1 - cc, c0 = ci * 256;
            RN_STORE();
            if (cc + 1 < nck) RN_LOAD(dir == 0 ? c0 + 256 : c0 - 256);
            float hfv[2][4];
#pragma unroll
            for (int rb = 0; rb < 2; ++rb)
#pragma unroll
                for (int i = 0; i < 4; ++i) hfv[rb][i] = dir == 1 ? bf2f(HS[(size_t)(c0 + wave * 32 + rb * 16 + 4 * g + i) * 512 + jc]) : 0.f;
            LDS_BARRIER();
            {
                float xr[7][8];
#pragma unroll
                for (int r = 0; r < 7; ++r) unpack8(*(const u32x4*)(L + RN_RAW + (tb * 4 + r) * 144 + c8 * 16), xr[r]);
#pragma unroll
                for (int tt = 0; tt < 4; ++tt) { float acc8[8];
#pragma unroll
                    for (int e = 0; e < 8; ++e) acc8[e] = cbv[e] + xr[tt][e] * cw[0][e] + xr[tt + 1][e] * cw[1][e] + xr[tt + 2][e] * cw[2][e] + xr[tt + 3][e] * cw[3][e];
                    *(u32x4*)(L + RN_XB + (tb * 4 + tt) * 144 + c8 * 16) = pack8(acc8);
                    if ((c8 >> 1) == qt) { float* xf = (float*)(L + RN_XF) + (tb * 4 + tt) * 16 + (c8 & 1) * 8;
                        *(f32x4*)xf = (f32x4){acc8[0], acc8[1], acc8[2], acc8[3]}; *(f32x4*)(xf + 4) = (f32x4){acc8[4], acc8[5], acc8[6], acc8[7]}; } }
            }
            LDS_BARRIER();
            float av[2][4], bv[2][4];
#pragma unroll
            for (int rb = 0; rb < 2; ++rb) {
                f32x4 ga = {0.f, 0.f, 0.f, 0.f}, gx = {0.f, 0.f, 0.f, 0.f};
#pragma unroll
                for (int ks = 0; ks < 2; ++ks) {
                    const bf16x8 af = *(const bf16x8*)(L + RN_XB + (wave * 32 + rb * 16 + jc) * 144 + (ks * 32 + g * 8) * 2);
                    ga = __builtin_amdgcn_mfma_f32_16x16x32_bf16(af, wa[ks], ga, 0, 0, 0);
                    gx = __builtin_amdgcn_mfma_f32_16x16x32_bf16(af, wx[ks], gx, 0, 0, 0);
                }
#pragma unroll
                for (int i = 0; i < 4; ++i) { const int t = wave * 32 + rb * 16 + 4 * g + i;
                    const float r = __builtin_amdgcn_rcpf(1.0f + __expf(-(ga[i] + ba))), ig = __builtin_amdgcn_rcpf(1.0f + __expf(-(gx[i] + bx)));
                    const float la = sp8 * r, a = __expf(la), a2 = a * a;
                    const float xc = ((const float*)(L + RN_XF))[t * 16 + jc];
                    av[rb][i] = a; bv[rb][i] = __builtin_amdgcn_sqrtf(neg_expm1(2.0f * la, a2)) * (ig * xc); }
            }
            float sA[2], sB[2];
#pragma unroll
            for (int rb = 0; rb < 2; ++rb) { float A = 1.f, B = 0.f;
#pragma unroll
                for (int i = 0; i < 4; ++i) { const int ii = dir == 0 ? i : 3 - i; A *= av[rb][ii]; B = av[rb][ii] * B + bv[rb][ii]; }
                sA[rb] = A; sB[rb] = B; }
            float iA[2], iB[2];
#pragma unroll
            for (int rb = 0; rb < 2; ++rb) { float A = sA[rb], B = sB[rb];
#pragma unroll
                for (int st = 1; st < 4; st <<= 1) {
                    const int src = dir == 0 ? lane - 16 * st : lane + 16 * st;
                    const float pA = __shfl(A, src & 63), pB = __shfl(B, src & 63);
                    const bool has = dir == 0 ? (g >= st) : (g + st <= 3);
                    if (has) { B = A * pB + B; A = A * pA; } }
                iA[rb] = A; iB[rb] = B; }
            const int lastl = dir == 0 ? 48 + jc : jc;
            float tA[2], tB[2];
#pragma unroll
            for (int rb = 0; rb < 2; ++rb) { tA[rb] = __shfl(iA[rb], lastl); tB[rb] = __shfl(iB[rb], lastl); }
            const int f0 = dir == 0 ? 0 : 1, f1 = 1 - f0;
            const float wA = tA[f0] * tA[f1], wB = tA[f1] * tB[f0] + tB[f1];
            float* WC = (float*)(L + RN_WC);
            if (g == 0) { WC[(wave * 2 + 0) * 16 + jc] = wA; WC[(wave * 2 + 1) * 16 + jc] = wB; }
            LDS_BARRIER();
            float hin = carry, hout = carry;
#pragma unroll
            for (int w = 0; w < 8; ++w) { const int ws_ = dir == 0 ? w : 7 - w; const float A = WC[(ws_ * 2 + 0) * 16 + jc], B = WC[(ws_ * 2 + 1) * 16 + jc];
                hout = A * hout + B; const bool before = dir == 0 ? (ws_ < wave) : (ws_ > wave); if (before) hin = hout; }
            carry = hout;
#pragma unroll
            for (int rbi = 0; rbi < 2; ++rbi) { const int rb = rbi == 0 ? f0 : f1;
                float h = hin; if (rbi == 1) h = tA[f0] * h + tB[f0];
                const int src = dir == 0 ? lane - 16 : lane + 16; const float pA = __shfl(iA[rb], src & 63), pB = __shfl(iB[rb], src & 63);
                const bool has = dir == 0 ? (g >= 1) : (g <= 2);
                if (has) h = pA * h + pB;
#pragma unroll
                for (int i = 0; i < 4; ++i) { const int ii = dir == 0 ? i : 3 - i;
                    h = av[rb][ii] * h + bv[rb][ii];
                    HS[(size_t)(c0 + wave * 32 + rb * 16 + 4 * g + ii) * 512 + jc] = (bf16_t)(pk2(h + hfv[rb][ii], 0.f) & 0xffffu); } }
        }
        if (!dec && wave == 0 && g == 0) F.out[O_ST + ((size_t)(seq * 2 + l) * 2 + dir) * 512 + oc0 + jc] = carry;
    }
#undef RN_LOAD
#undef RN_STORE
    LDS_BARRIER();
}
__device__ __forceinline__ void phase_rnn_prep(Frame& F, int l, bool do_prep) {
#pragma unroll 1
    for (int k = 0; k < 5; ++k) {
        int seq, n, qt;
        if (k == 0) { const int v = F.vcu; seq = 32 + (v >> 5); n = (v & 31) >> 2; qt = v & 3; }
        else { const int p = F.vcu * 4 + k - 1; seq = p >> 5; n = (p & 31) >> 2; qt = p & 3; }
        rnn_item(F, l, seq, n, qt);
    }
    if (!do_prep) return;
    const int gw = F.vcu * 8 + F.wave, NGW = F.G * 8, lane = F.lane;
    bf16_t* CQ = (bf16_t*)(F.ws + WS_Y + Y_SLOT); bf16_t* CKV = (bf16_t*)(F.ws + WS_A + A_CKV); bf16_t* KR = (bf16_t*)(F.ws + WS_A + A_KR);
    const float* qn = IN_(21) + l * 384; const float* kn = IN_(23) + l * 256;
    for (int r = gw; r < NTOK; r += NGW) {
        float q[8], c[8]; float sq = 0.f, sc = 0.f;
        bf16_t* qp = CQ + (size_t)r * 384 + lane * 8; bf16_t* cp = CKV + (size_t)kvrow_of(r) * 256 + lane * 8;
        if (lane < 48) { unpack8(*(const u32x4*)qp, q);
#pragma unroll
            for (int i = 0; i < 8; ++i) sq += q[i] * q[i]; }
        if (lane < 32) { unpack8(*(const u32x4*)cp, c);
#pragma unroll
            for (int i = 0; i < 8; ++i) sc += c[i] * c[i]; }
        const float rq = 1.0f / sqrtf(wave_sum(sq) * (1.0f / 384.0f) + EPS), rc = 1.0f / sqrtf(wave_sum(sc) * (1.0f / 256.0f) + EPS);
        if (lane < 48) {
#pragma unroll
            for (int i = 0; i < 8; ++i) q[i] = q[i] * rq * qn[lane * 8 + i];
            *(u32x4*)qp = pack8(q); }
        if (lane < 32) {
#pragma unroll
            for (int i = 0; i < 8; ++i) c[i] = c[i] * rc * kn[lane * 8 + i];
            *(u32x4*)cp = pack8(c);
            if (r < NP) st_f32x8(F.out + O_CKV + (size_t)cache_row(r, l) * 256 + lane * 8, c); }
    }
    for (int i = gw; i < 4096; i += NGW) { const int b = i >> 9, j = i & 511; const int kvr = NP + b * 2560 + j;
        const float* s1 = IN_(2) + ((size_t)(b * 2 + l) * 512 + j) * 256;
        if (lane < 32) { const f32x4 a = *(const f32x4*)(s1 + lane * 8), bq = *(const f32x4*)(s1 + lane * 8 + 4); const float v[8] = {a.x, a.y, a.z, a.w, bq.x, bq.y, bq.z, bq.w};
            *(u32x4*)(CKV + (size_t)kvr * 256 + lane * 8) = pack8(v); }
        const float* s2 = IN_(3) + ((size_t)(b * 2 + l) * 512 + j) * 32;
        if (lane < 4) { const f32x4 a = *(const f32x4*)(s2 + lane * 8), bq = *(const f32x4*)(s2 + lane * 8 + 4); const float v[8] = {a.x, a.y, a.z, a.w, bq.x, bq.y, bq.z, bq.w};
            *(u32x4*)(KR + (size_t)kvr * 32 + lane * 8) = pack8(v); }
    }
}
__device__ __forceinline__ void convert_diff_ctx(Frame& F, int l) {
    const int gw = F.vcu * 8 + F.wave, NGW = F.G * 8, lane = F.lane;
    bf16_t* DK = (bf16_t*)(F.ws + WS_A + A_DK); bf16_t* DV = (bf16_t*)(F.ws + WS_A + A_DV);
    for (int i = gw; i < 8192; i += NGW) { const int which = i >> 12, b = (i >> 9) & 7, j = i & 511; const int kvr = NP + b * 2560 + j;
        const float* s = (which ? IN_(5) : IN_(4)) + ((size_t)(b * 2 + l) * 512 + j) * 512 + lane * 8;
        const f32x4 a = *(const f32x4*)s, bq = *(const f32x4*)(s + 4); const float v[8] = {a.x, a.y, a.z, a.w, bq.x, bq.y, bq.z, bq.w};
        *(u32x4*)((which ? DV : DK) + (size_t)kvr * 512 + lane * 8) = pack8(v); }
}
constexpr int ATT_STASH = 65536;
#ifndef ATT_SDEPTH_M
#define ATT_SDEPTH_M 1
#endif
#ifndef ATT_SDEPTH_D
#define ATT_SDEPTH_D 0
#endif
__device__ __forceinline__ void mla_unit(Frame& F, int tok0, int kv0, int nkeys, int h) {
    const bf16_t* Q = (const bf16_t*)(F.ws + WS_A + A_Q); const bf16_t* KV = (const bf16_t*)(F.ws + WS_A + A_KV); const bf16_t* KR = (const bf16_t*)(F.ws + WS_A + A_KR);
    bf16_t* OM = (bf16_t*)(F.ws + WS_Y + Y_SLOT);
    f32x16 o[2]; float l;
    att::attn_core<96, 64, ATT_SDEPTH_M>(Q + (size_t)tok0 * 768 + h * 96, 768, KV + (size_t)kv0 * 1024 + h * 128, 1024, KR + (size_t)kv0 * 32, 32,
                           KV + (size_t)kv0 * 1024 + h * 128 + 64, 1024, nkeys, (char*)F.lds, o, l);
    const int lane = F.lane, r32 = lane & 31, hi = lane >> 5;
    float* li = (float*)(F.lds + 2 * 8192 + 2 * 16384) + F.wave * 64 + 32;
    if (hi == 0) li[r32] = l;
    asm volatile("s_waitcnt lgkmcnt(0)" ::: "memory");
#pragma unroll
    for (int r = 0; r < 16; ++r) { const int q = att::crow(r, hi); const float rl = __builtin_amdgcn_rcpf(li[q]);
        bf16_t* op = OM + (size_t)(tok0 + F.wave * 32 + q) * 512 + h * 64 + r32;
#pragma unroll
        for (int d = 0; d < 2; ++d) op[d * 32] = (bf16_t)(pk2(o[d][r] * rl, 0.f) & 0xffffu); }
}
__device__ __forceinline__ void phase_mla(Frame& F) {
    const int x = F.vcu >> 5, j = F.vcu & 31;
#pragma unroll 1
    for (int u = 0; u < 3; ++u) {
        int tok0, kv0, nkeys, h;
        if (u < 2) { const int idx = j * 2 + u, pair = x * 8 + (idx >> 3), qb = idx & 7, b = pair >> 3; h = pair & 7; tok0 = NP + b * 2048 + qb * 256; kv0 = NP + b * 2560; nkeys = 2560; }
        else { const int b = F.vcu >> 3; h = F.vcu & 7; tok0 = b * 256; kv0 = b * 256; nkeys = 256; }
        mla_unit(F, tok0, kv0, nkeys, h);
    }
}
__device__ __forceinline__ void diff_pass(Frame& F, int l, int tok0, int kv0, int nkeys, int h, int pass, float lam, float lam_init) {
    const bf16_t* DQ = (const bf16_t*)(F.ws + WS_A + A_DQ); const bf16_t* DK = (const bf16_t*)(F.ws + WS_A + A_DK); const bf16_t* DV = (const bf16_t*)(F.ws + WS_A + A_DV);
    bf16_t* OD = (bf16_t*)(F.ws + WS_Y + 2 * Y_SLOT);
    const int lane = F.lane, r32 = lane & 31, hi = lane >> 5;
    float* li = (float*)(F.lds + 2 * 16384 + 2 * 8192) + F.wave * 64 + 32;
    unsigned* stash = (unsigned*)(F.lds + ATT_STASH + F.wave * 8192);
    f32x16 o[4]; float lsum;
    const int coff = h * 128 + (pass == 0 ? 64 : 0);
    att::attn_core<64, 128, ATT_SDEPTH_D>(DQ + (size_t)tok0 * 512 + coff, 512, DK + (size_t)kv0 * 512 + coff, 512, nullptr, 0,
                            DV + (size_t)kv0 * 512 + h * 128, 512, nkeys, (char*)F.lds, o, lsum);
    if (hi == 0) li[r32] = lsum;
    asm volatile("s_waitcnt lgkmcnt(0)" ::: "memory");
    if (pass == 0) {
#pragma unroll
        for (int r = 0; r < 16; r += 2) { const float rl0 = lam * __builtin_amdgcn_rcpf(li[att::crow(r, hi)]), rl1 = lam * __builtin_amdgcn_rcpf(li[att::crow(r + 1, hi)]);
#pragma unroll
            for (int d = 0; d < 4; ++d) stash[(d * 8 + (r >> 1)) * 64 + lane] = pk2(o[d][r] * rl0, o[d][r + 1] * rl1); }
        asm volatile("s_waitcnt lgkmcnt(0)" ::: "memory");
    } else {
        const float* dn = IN_(29) + l * 128;
        const float g0 = dn[r32], g1 = dn[32 + r32], g2 = dn[64 + r32], g3 = dn[96 + r32];
#pragma unroll
        for (int r = 0; r < 16; r += 2) {
            const float rl0 = __builtin_amdgcn_rcpf(li[att::crow(r, hi)]), rl1 = __builtin_amdgcn_rcpf(li[att::crow(r + 1, hi)]);
            float e0[4], e1[4]; float s0 = 0.f, s1 = 0.f;
#pragma unroll
            for (int d = 0; d < 4; ++d) { const unsigned w = stash[(d * 8 + (r >> 1)) * 64 + lane];
                e0[d] = o[d][r] * rl0 - bflo(w); e1[d] = o[d][r + 1] * rl1 - bfhi(w); s0 += e0[d] * e0[d]; s1 += e1[d] * e1[d]; }
#pragma unroll
            for (int m = 1; m < 32; m <<= 1) { s0 += __shfl_xor(s0, m); s1 += __shfl_xor(s1, m); }
            const float k0 = (1.0f - lam_init) / sqrtf(s0 * (1.0f / 128.0f) + EPS), k1 = (1.0f - lam_init) / sqrtf(s1 * (1.0f / 128.0f) + EPS);
            bf16_t* p0 = OD + (size_t)(tok0 + F.wave * 32 + att::crow(r, hi)) * 512 + h * 128 + r32;
            bf16_t* p1 = OD + (size_t)(tok0 + F.wave * 32 + att::crow(r + 1, hi)) * 512 + h * 128 + r32;
            p0[0] = (bf16_t)(pk2(e0[0] * k0 * g0, 0.f) & 0xffffu); p0[32] = (bf16_t)(pk2(e0[1] * k0 * g1, 0.f) & 0xffffu);
            p0[64] = (bf16_t)(pk2(e0[2] * k0 * g2, 0.f) & 0xffffu); p0[96] = (bf16_t)(pk2(e0[3] * k0 * g3, 0.f) & 0xffffu);
            p1[0] = (bf16_t)(pk2(e1[0] * k1 * g0, 0.f) & 0xffffu); p1[32] = (bf16_t)(pk2(e1[1] * k1 * g1, 0.f) & 0xffffu);
            p1[64] = (bf16_t)(pk2(e1[2] * k1 * g2, 0.f) & 0xffffu); p1[96] = (bf16_t)(pk2(e1[3] * k1 * g3, 0.f) & 0xffffu);
        }
    }
}
__device__ __forceinline__ void phase_diff(Frame& F, int l) {
    const float lam_init = 0.8f - 0.6f * expf(-0.3f * (float)l);
    const float d1 = wave_sum(IN_(25)[l * 64 + F.lane] * IN_(26)[l * 64 + F.lane]), d2 = wave_sum(IN_(27)[l * 64 + F.lane] * IN_(28)[l * 64 + F.lane]);
    const float lam = expf(d1) - expf(d2) + lam_init;
    const int x = F.vcu >> 5, j = F.vcu & 31;
    const int nsteps = (F.vcu & 1) == 0 ? 4 : 2;
#pragma unroll 1
    for (int st = 0; st < nsteps; ++st) {
        int tok0, kv0, nkeys, h;
        if (st < 2) { const int pair = x * 4 + (j >> 3), qb = j & 7, b = pair >> 2; h = pair & 3; tok0 = NP + b * 2048 + qb * 256; kv0 = NP + b * 2560; nkeys = 2560; }
        else { const int p = F.vcu >> 1, b = p >> 2; h = p & 3; tok0 = b * 256; kv0 = b * 256; nkeys = 256; }
        diff_pass(F, l, tok0, kv0, nkeys, h, st & 1, lam, lam_init);
    }
}
#define GEMM_CALL(EPI, SCHED, g, S, E) pg8::gemm_phase<EPI, SCHED, true, true>((PG8_LAS unsigned char*)F.lds, g, S, E)
struct BrOrder {
    int c, half;
    __device__ __forceinline__ bool next(int i, pg8::Unit& u) const { if (c >= 192 || i >= 3) return false; u.pm = i * 96 + half * 48 + (c >> 2); u.pn = i * 4 + (c & 3); return true; }
    __device__ __forceinline__ void a_ready(const pg8::Unit&) const {}
    __device__ __forceinline__ void done(const pg8::Unit&) const {}
};
__device__ __forceinline__ void phase_g1(Frame& F, int l) {
    pg8::Gemm g{(const bf16_t*)(F.ws + WS_H), (const bf16_t*)(F.ws + WS_W + W_IN), NTOK, 1280, 1024};
    pg8::StaticOrder S; S.init(NTOK, 1280, F.G, F.bid);
    EpiG1 E{(bf16_t*)(F.ws + WS_Y + 2 * Y_SLOT), (bf16_t*)(F.ws + WS_Y + Y_SLOT), (bf16_t*)(F.ws + WS_A + A_CKV), (bf16_t*)(F.ws + WS_A + A_KR),
            F.out + O_KR, (const float*)(F.ws + CTL_ROPE), l};
    GEMM_CALL(EpiG1, pg8::StaticOrder, g, S, E);
}
__device__ __forceinline__ void phase_g2(Frame& F) {
    { pg8::Gemm g{(const bf16_t*)(F.ws + WS_Y + Y_SLOT), (const bf16_t*)(F.ws + WS_W + W_UQ), NTOK, 768, 384};
      pg8::StaticOrder S; S.init(NTOK, 768, F.G, F.bid);
      EpiQ E{(bf16_t*)(F.ws + WS_A + A_Q), (const float*)(F.ws + CTL_ROPE)};
      GEMM_CALL(EpiQ, pg8::StaticOrder, g, S, E); }
    { pg8::Gemm g{(const bf16_t*)(F.ws + WS_A + A_CKV), (const bf16_t*)(F.ws + WS_W + W_UKV), NKV, 1024, 256};
      pg8::StaticOrder S; S.init(NKV, 1024, F.G, (F.bid + F.G - (288 % F.G)) % F.G);
      EpiPlain E{(bf16_t*)(F.ws + WS_A + A_KV), 1024};
      GEMM_CALL(EpiPlain, pg8::StaticOrder, g, S, E); }
}
__device__ __forceinline__ void phase_g3(Frame& F, int l) {
    convert_diff_ctx(F, l);
    pg8::Gemm g{(const bf16_t*)(F.ws + WS_H), (const bf16_t*)(F.ws + WS_W + W_IN) + (size_t)1280 * 1024, NTOK, 1536, 1024};
    pg8::StaticOrder S; S.init(NTOK, 1536, F.G, F.bid);
    EpiG3 E{(bf16_t*)(F.ws + WS_A + A_DQ), (bf16_t*)(F.ws + WS_A + A_DK), (bf16_t*)(F.ws + WS_A + A_DV), F.out + O_DK, F.out + O_DV, (const float*)(F.ws + CTL_ROPE) + 1024, l};
    GEMM_CALL(EpiG3, pg8::StaticOrder, g, S, E);
}
__device__ __forceinline__ void phase_g4(Frame& F, int half) {
    pg8::Gemm g{(const bf16_t*)(F.ws + WS_H) + (size_t)half * HALF_TOK * 1024, (const bf16_t*)(F.ws + WS_W + W_IN) + (size_t)2816 * 1024, HALF_TOK, 4608, 1024};
    pg8::StaticOrder S; S.init(HALF_TOK, 4608, F.G, F.bid);
    EpiG4 E{(bf16_t*)(F.ws + WS_Y), (bf16_t*)(F.ws + WS_A + A_G), half * HALF_TOK};
    GEMM_CALL(EpiG4, pg8::StaticOrder, g, S, E);
}
__device__ __forceinline__ void phase_g5(Frame& F, int half) {
    pg8::Gemm g{(const bf16_t*)(F.ws + WS_Y), (const bf16_t*)(F.ws + WS_W + W_BR), 3 * NTOK, 3072, 512};
    BrOrder S{F.bid, half};
    EpiG5 E{(const bf16_t*)(F.ws + WS_A + A_G), (bf16_t*)(F.ws + WS_H), half};
    GEMM_CALL(EpiG5, BrOrder, g, S, E);
}
__device__ __forceinline__ void phase_g6(Frame& F) {
    pg8::Gemm g{(const bf16_t*)(F.ws + WS_H), (const bf16_t*)(F.ws + WS_W + W_OUT), NTOK, 1024, 1024};
    pg8::StaticOrder S; S.init(NTOK, 1024, F.G, F.bid);
    EpiG6 E{(bf16_t*)(F.ws + WS_A + A_O), (float*)(F.ws + CTL_SSQ)};
    GEMM_CALL(EpiG6, pg8::StaticOrder, g, S, E);
}

#define XB_TMO      128
#define XB_XCNT(j)  (256  + 64 * (j))
#define XB_XSUB(j)  (1280 + 64 * (j))
#define XB_XGEN(j)  (2304 + 64 * (j))
#define XB_TOP      3328
#define XB_TOPGEN   3392
#define XCD_BAR_WORDS 3456
#define XB_SPIN_CAP (1u << 18)

__device__ __forceinline__ unsigned xb_ld(unsigned* p)              { return __hip_atomic_load(p, __ATOMIC_RELAXED, __HIP_MEMORY_SCOPE_AGENT); }
__device__ __forceinline__ unsigned xb_add(unsigned* p, unsigned v) { return __hip_atomic_fetch_add(p, v, __ATOMIC_RELAXED, __HIP_MEMORY_SCOPE_AGENT); }
__device__ __forceinline__ unsigned xb_xcc_id() { return (unsigned)__builtin_amdgcn_s_getreg((3 << 11) | 20) & 0xFu; }
#define XB_SPIN(cond, bar) do { unsigned _sp = 0; while (cond) { __builtin_amdgcn_s_sleep(1); \
    if ((++_sp & 255u) == 0u) { if (xb_ld(&(bar)[XB_TMO])) break; if (_sp > XB_SPIN_CAP) { atomicAdd(&(bar)[XB_TMO], 1u); break; } } } } while (0)

struct XcdBarrier {
    unsigned* bar; unsigned x;
    volatile LAS unsigned* st;
};

__device__ __forceinline__ XcdBarrier xcd_barrier_post(unsigned* bar, volatile LAS unsigned* st) {
    XcdBarrier b; b.bar = bar; b.x = xb_xcc_id(); b.st = st;
    if (threadIdx.x == 0) (void)xb_add(&bar[XB_XCNT(b.x)], 1u);
    return b;
}
__device__ __forceinline__ void xcd_barrier_complete(unsigned* bar, unsigned x, unsigned& nloc, unsigned& nx) {
    const unsigned G = gridDim.x * gridDim.y * gridDim.z;
    unsigned sum, cnt, mine, sp = 0u;
    for (;;) {
        sum = 0u; cnt = 0u; mine = 0u;
#pragma unroll
        for (unsigned j = 0; j < 16; ++j) { const unsigned c = xb_ld(&bar[XB_XCNT(j)]); sum += c; cnt += (c > 0u) ? 1u : 0u; mine = (j == x) ? c : mine; }
        if (sum == G) break;
        __builtin_amdgcn_s_sleep(1);
        if ((++sp & 255u) == 0u) { if (xb_ld(&bar[XB_TMO])) break; if (sp > XB_SPIN_CAP) { atomicAdd(&bar[XB_TMO], 1u); break; } }
    }
    nloc = mine > 0u ? mine : 1u; nx = cnt > 0u ? cnt : 1u;
}

__device__ __forceinline__ void xcd_barrier(const XcdBarrier& b) {
    asm volatile("s_waitcnt vmcnt(0)" ::: "memory");
    __syncthreads();
    if (threadIdx.x == 0) {
        unsigned* bar = b.bar;
        __builtin_amdgcn_s_waitcnt(0);
        unsigned nloc = b.st[0], nx = b.st[1];
        if (nloc == 0u) { xcd_barrier_complete(bar, b.x, nloc, nx); b.st[0] = nloc; b.st[1] = nx; }
        const unsigned old = xb_add(&bar[XB_XSUB(b.x)], 1u);
        const unsigned gen = old / nloc;
        if (old + 1u == (gen + 1u) * nloc) {
            __builtin_amdgcn_fence(__ATOMIC_RELEASE, "agent");
            asm volatile("s_waitcnt vmcnt(0)" ::: "memory");
            const unsigned og = xb_add(&bar[XB_TOP], 1u);
            const unsigned tg = og / nx;
            if (og + 1u == (tg + 1u) * nx) xb_add(&bar[XB_TOPGEN], 1u);
            else XB_SPIN(xb_ld(&bar[XB_TOPGEN]) == tg, bar);
            __builtin_amdgcn_fence(__ATOMIC_ACQUIRE, "agent");
            xb_add(&bar[XB_XGEN(b.x)], 1u);
            asm volatile("s_waitcnt vmcnt(0)" ::: "memory");
        } else {
            XB_SPIN(xb_ld(&bar[XB_XGEN(b.x)]) == gen, bar);
            __builtin_amdgcn_fence(__ATOMIC_ACQUIRE, "agent");
            asm volatile("s_waitcnt vmcnt(0)" ::: "memory");
        }
    }
    __syncthreads();
}

constexpr int NPHASES = 2 + 2 * 12;
#ifndef PROBE_DUP
#define PROBE_DUP (-1)
#endif
__global__ void __launch_bounds__(NTHREADS, 2) hybrid_step_megakernel(Params p) {
    extern __shared__ __attribute__((aligned(16))) unsigned char lds[];
    cg::grid_group grid = cg::this_grid();
    if (threadIdx.x < 34) ((LAS cfp_t*)(lds + LDS_TAB))[threadIdx.x] = (cfp_t)p.in[threadIdx.x];
    __syncthreads();
    volatile LAS unsigned* bst = (volatile LAS unsigned*)(lds + LDS_TAB + 512);
    XcdBarrier xbar; xbar.bar = nullptr; xbar.x = 0; xbar.st = bst;
#pragma unroll 1
    for (int pi = 0; pi < NPHASES + (PROBE_DUP >= 0 ? 1 : 0); ++pi) {
        const int ph = (PROBE_DUP >= 0 && pi > PROBE_DUP) ? pi - 1 : pi; const bool rep = PROBE_DUP >= 0 && pi == PROBE_DUP + 1;
        const int l = ph < 2 ? 0 : (ph - 2) / 12, k = ph < 2 ? ph : 2 + (ph - 2) % 12;
#define FRAME() int zv, zs; asm volatile("v_mov_b32 %0, 0" : "=v"(zv)); asm volatile("s_mov_b32 %0, 0" : "=s"(zs)); Frame F; \
        F.lds = lds; F.ws = p.ws + zs; F.out = p.out + zs; F.in = (const LAS cfp_t*)(lds + LDS_TAB); \
        F.tid = threadIdx.x + zv; F.lane = F.tid & 63; F.wave = __builtin_amdgcn_readfirstlane(F.tid >> 6); \
        F.G = gridDim.x; F.bid = blockIdx.x + zs; F.vcu = (F.bid % 8) * (F.G / 8) + F.bid / 8;
        switch (k) {
            case 0: { FRAME(); if (F.bid == 0) { for (int i = F.tid; i < XCD_BAR_WORDS; i += NTHREADS) ((unsigned*)(F.ws + WS_CTL))[i] = 0u; } phase0_mod_rope(F); convert_weights(F, 0); } break;
            case 1: { FRAME(); phase0_h(F); } break;
            case 2: { FRAME(); phase_g1(F, l); } break;
            case 3: { FRAME(); phase_rnn_prep(F, l, !rep); } break;
            case 4: { FRAME(); phase_g2(F); } break;
            case 5: { FRAME(); phase_mla(F); } break;
            case 6: { FRAME(); phase_g3(F, l); } break;
            case 7: { FRAME(); phase_diff(F, l); } break;
            case 8: { FRAME(); phase_g4(F, 0); } break;
            case 9: { FRAME(); phase_g5(F, 0); } break;
            case 10: { FRAME(); phase_g4(F, 1); } break;
            case 11: { FRAME(); phase_g5(F, 1); } break;
            case 12: { FRAME(); phase_g6(F); } break;
            default: { FRAME(); phase_post(F, l); if (l == 0) convert_weights(F, 1); } break;
        }
#undef FRAME
        if (pi == 0) {
            grid.sync();
            if (threadIdx.x == 0) { bst[0] = 0u; bst[1] = 0u; }
            __syncthreads();
            xbar = xcd_barrier_post((unsigned*)(p.ws + WS_CTL), bst);
        } else if (pi + 1 < NPHASES + (PROBE_DUP >= 0 ? 1 : 0)) xcd_barrier(xbar);
    }
}

extern "C" void kernel_launch(void* const* d_in, const int* in_sizes, int n_in, void* d_out, int out_size, void* d_ws, size_t ws_size, hipStream_t stream) {
    static int grid = 0;
    if (grid == 0) {
        if (n_in != 34 || out_size != (int)O_TOTAL || ws_size < WS_END) { fprintf(stderr, "kernel_launch: unexpected shapes: n_in %d out %d ws %zu (need >= %zu)\n", n_in, out_size, ws_size, (size_t)WS_END); grid = -1; return; }
        int dev = 0, cus = 0, per_cu = 0;
        if (hipGetDevice(&dev) != hipSuccess || hipDeviceGetAttribute(&cus, hipDeviceAttributeMultiprocessorCount, dev) != hipSuccess) { grid = -1; return; }
        if (hipFuncSetAttribute((const void*)hybrid_step_megakernel, hipFuncAttributeMaxDynamicSharedMemorySize, LDS_BYTES) != hipSuccess) { fprintf(stderr, "kernel_launch: hipFuncSetAttribute failed\n"); grid = -1; return; }
        if (hipOccupancyMaxActiveBlocksPerMultiprocessor(&per_cu, (const void*)hybrid_step_megakernel, NTHREADS, LDS_BYTES) != hipSuccess || per_cu < 1) { fprintf(stderr, "kernel_launch: occupancy query says %d blocks/CU\n", per_cu); per_cu = 1; }
        (void)hipGetLastError();
        grid = cus;
        if (grid != 256) fprintf(stderr, "kernel_launch: %d CUs (expected 256)\n", grid);
    }
    if (grid < 0) return;
    Params p{};
    for (int i = 0; i < 34; ++i) p.in[i] = (const float*)d_in[i];
    p.out = (float*)d_out; p.ws = (unsigned char*)d_ws;
    void* args[] = {&p};
    hipError_t e = hipLaunchCooperativeKernel((const void*)hybrid_step_megakernel, dim3(grid), dim3(NTHREADS), args, LDS_BYTES, stream);
    if (e != hipSuccess) fprintf(stderr, "kernel_launch: cooperative launch failed: %s (grid %d)\n", hipGetErrorString(e), grid);
}
```

```cpp
#include <hip/hip_runtime.h>
#include <hip/hip_cooperative_groups.h>
#include <cstdio>
#include <cstdint>
namespace cg = cooperative_groups;

#define LAS __attribute__((address_space(3)))
typedef unsigned short bf16_t;
typedef short bf16x8 __attribute__((ext_vector_type(8)));
typedef short s16x4 __attribute__((ext_vector_type(4)));
typedef float f32x2 __attribute__((ext_vector_type(2)));
typedef float f32x4 __attribute__((ext_vector_type(4)));
typedef float f32x16 __attribute__((ext_vector_type(16)));
typedef unsigned u32x2 __attribute__((ext_vector_type(2)));
typedef unsigned u32x4 __attribute__((ext_vector_type(4)));
typedef __bf16 bf16x2_t __attribute__((ext_vector_type(2)));

constexpr int DM = 1024, NP = 8192, ND = 16384, NTOK = 24576, NKV = 28672, HALF_TOK = 12288;
constexpr int IN_COLS = 7328;
constexpr float EPS = 1e-6f;
constexpr float LOG2E = 1.4426950408889634f;
constexpr float SCALE_M = 0.10206207261596577f * LOG2E;
constexpr float SCALE_D = 0.125f * LOG2E;
constexpr size_t O_Y = 0, O_CKV = 25165824, O_KR = 29360128, O_DK = 29884416, O_DV = 38273024, O_ST = 46661632, O_TOTAL = 46727168;

constexpr size_t MiB = 1u << 20;
constexpr size_t WS_CTL = 0;
constexpr size_t CTL_MOD = 64 * 1024;
constexpr size_t CTL_ROPE = 320 * 1024;
constexpr size_t CTL_SSQ = 1 * MiB;
constexpr size_t WS_W = 3 * MiB;
constexpr size_t W_IN = 0;
constexpr size_t W_UQ = W_IN + (size_t)7424 * 1024 * 2;
constexpr size_t W_UKV = W_UQ + (size_t)768 * 384 * 2;
constexpr size_t W_BR = W_UKV + (size_t)1024 * 256 * 2;
constexpr size_t W_OUT = W_BR + (size_t)3072 * 512 * 2;
constexpr size_t W_RG = W_OUT + (size_t)1024 * 1024 * 2;
constexpr size_t W_END = W_RG + (size_t)32 * 4096 * 2;
static_assert(W_END <= 21 * MiB, "weight region");
constexpr size_t WS_H = 24 * MiB;
constexpr size_t WS_Y = 72 * MiB;
constexpr size_t Y_SLOT = (size_t)NTOK * 512 * 2;
constexpr size_t WS_A = 144 * MiB;
constexpr size_t A_CKV = 0;
constexpr size_t A_KR = 14 * MiB;
constexpr size_t A_Q = 16 * MiB;
constexpr size_t A_KV = 52 * MiB;
constexpr size_t A_DQ = 0;
constexpr size_t A_DK = 24 * MiB;
constexpr size_t A_DV = 52 * MiB;
constexpr size_t A_G = 0;
constexpr size_t A_O = 0;
constexpr size_t WS_END = 256 * MiB;
static_assert(A_KV + (size_t)NKV * 1024 * 2 <= 112 * MiB, "A region");

constexpr int LDS_BYTES = 147456;
constexpr int NTHREADS = 512;

struct Params { const float* in[34]; float* out; unsigned char* ws; };

__device__ __forceinline__ unsigned pk2(float lo, float hi) { f32x2 v = {lo, hi}; bf16x2_t b = __builtin_convertvector(v, bf16x2_t); return __builtin_bit_cast(unsigned, b); }
__device__ __forceinline__ float bflo(unsigned w) { return __uint_as_float(w << 16); }
__device__ __forceinline__ float bfhi(unsigned w) { return __uint_as_float(w & 0xffff0000u); }
__device__ __forceinline__ float bf2f(bf16_t x) { return __uint_as_float(((unsigned)x) << 16); }
__device__ __forceinline__ u32x4 pack8(const float* v) { u32x4 w; w.x = pk2(v[0], v[1]); w.y = pk2(v[2], v[3]); w.z = pk2(v[4], v[5]); w.w = pk2(v[6], v[7]); return w; }
__device__ __forceinline__ void unpack8(u32x4 w, float* v) { v[0] = bflo(w.x); v[1] = bfhi(w.x); v[2] = bflo(w.y); v[3] = bfhi(w.y); v[4] = bflo(w.z); v[5] = bfhi(w.z); v[6] = bflo(w.w); v[7] = bfhi(w.w); }
__device__ __forceinline__ float wave_sum(float v) {
#pragma unroll
    for (int o = 1; o < 64; o <<= 1) v += __shfl_xor(v, o);
    return v;
}
__device__ __forceinline__ float sigmoidf_(float x) { return 1.0f / (1.0f + __expf(-x)); }
__device__ __forceinline__ float siluf_(float x) { return x / (1.0f + __expf(-x)); }
__device__ __forceinline__ int kvrow_of(int r) { return r < NP ? r : NP + ((r - NP) >> 11) * 2560 + 512 + ((r - NP) & 2047); }
__device__ __forceinline__ int grp_of(int r) { return r < NP ? 0 : 1 + ((r - NP) >> 11); }
__device__ __forceinline__ int cache_row(int r, int l) { return r + 256 * ((r >> 8) + l); }
__device__ __forceinline__ int tid_now() { int t = threadIdx.x; asm volatile("; tid" : "+v"(t)); return t; }
namespace pg8 {
#define PG8_LAS __attribute__((address_space(3)))
constexpr int BM = 256, BK = 64, HALF = 128, HTB = HALF * BK * 2  , STAGE_BYTES = 8 * HTB, NXCD = 8, WGM = 8;
__host__ __device__ __forceinline__ int lds_byte(int r, int c) { const int st = (r >> 4) * 2 + (c >> 5), rr = r & 15, cc = c & 31, ob = rr * 64 + cc * 2; return st * 1024 + (ob ^ (((ob >> 9) & 1) << 5)); }
__host__ __device__ __forceinline__ void stage_rc(int b, int& R, int& C) { const int st = b / 1024, sb = b % 1024, swz = sb ^ (((sb >> 9) & 1) << 5); R = (st >> 1) * 16 + swz / 64; C = (st & 1) * 32 + (swz % 64) / 2; }
__host__ __device__ __forceinline__ int perm32(int rho) { const int n = rho >> 4, i = rho & 15; return 8 * (i >> 2) + 4 * n + (i & 3); }
struct Unit { int pm, pn; };
struct Gemm { const bf16_t* A; const bf16_t* Bt; int M, N, K; };
struct StaticOrder {
    int nM, nN, nwg, G, c;
    __host__ __device__ void init(int M, int N, int G_, int c_) { nM = M / BM; nN = N / BM; nwg = nM * nN; G = G_; c = c_; }
    __host__ __device__ bool next(int i, Unit& u) const {
        const long L = (long)i * G + c; if (L >= nwg) return false;
        int wgid = (int)L; { const int q = nwg / NXCD, r = nwg % NXCD, xcd = wgid % NXCD, off = wgid / NXCD; wgid = (xcd < r ? xcd * (q + 1) : r * (q + 1) + (xcd - r) * q) + off; }
        const int nig = WGM * nN, gid = wgid / nig, fm = gid * WGM, gsz = (nM - fm) < WGM ? (nM - fm) : WGM;
        u.pm = fm + ((wgid % nig) % gsz); u.pn = (wgid % nig) / gsz; return true;
    }
    __device__ __forceinline__ void a_ready(const Unit&) const {}
    __device__ __forceinline__ void done(const Unit&) const {}
};
template <class Epi, class Sched, bool ALIGN_EPI = false, bool SP2 = false>
__device__ __forceinline__ void gemm_phase(PG8_LAS unsigned char* lds, const Gemm g, const Sched& S, const Epi& E) {
    const int tid = tid_now(), wid = __builtin_amdgcn_readfirstlane(tid >> 6), lane = tid & 63, wr = wid >> 2, wc = wid & 3, fr = lane & 15, fq = lane >> 4;
    const int K = g.K, nt = K / BK;
    unsigned voffA[2], voffB[2];
#pragma unroll
    for (int i = 0; i < 2; ++i) { int R, C; stage_rc(tid * 16 + i * 8192, R, C); const int Rb = Epi::PERM ? ((R & ~31) + perm32(R & 31)) : R;
        voffA[i] = (unsigned)(R * K + C) * 2u; voffB[i] = (unsigned)(Rb * K + C) * 2u; }
    const size_t kstep = (size_t)(BK * 2);
    const size_t hstep = (size_t)HALF * K * 2;
    const size_t tstep = 2 * hstep;
    const unsigned ldsw = (unsigned)wid * 1024u;
    const int aoff = lds_byte(wr * 64 + fr, fq * 8), boff = lds_byte(wc * 32 + fr, fq * 8);
#define PG8_SA(b, h) (((b) * 2 + (h)) * HTB)
#define PG8_SB(b, h) ((4 + (b) * 2 + (h)) * HTB)
#define PG8_STAGE(bufoff, gbase, voff) do { _Pragma("unroll") for (int _i = 0; _i < 2; ++_i) \
        __builtin_amdgcn_global_load_lds((const unsigned*)((const char*)(gbase) + (voff)[_i]), (PG8_LAS unsigned*)(lds + (bufoff) + ldsw + _i * 8192), 16, 0, 0); } while (0)
#define PG8_LDA(dst, b, h) do { _Pragma("unroll") for (int m = 0; m < 4; ++m) _Pragma("unroll") for (int k = 0; k < 2; ++k) dst[m][k] = *(const PG8_LAS bf16x8*)(lds + PG8_SA(b, h) + aoff + m * 2048 + k * 1024); } while (0)
#define PG8_LDB(dst, b, h) do { _Pragma("unroll") for (int n = 0; n < 2; ++n) _Pragma("unroll") for (int k = 0; k < 2; ++k) dst[n][k] = *(const PG8_LAS bf16x8*)(lds + PG8_SB(b, h) + boff + n * 2048 + k * 1024); } while (0)
#define PG8_MMA(ai, bj, At, Bt) do { __builtin_amdgcn_s_setprio(1); _Pragma("unroll") for (int m = 0; m < 4; ++m) _Pragma("unroll") for (int n = 0; n < 2; ++n) _Pragma("unroll") for (int k = 0; k < 2; ++k) \
        acc[ai][bj][m][n] = __builtin_amdgcn_mfma_f32_16x16x32_bf16(Bt[n][k], At[m][k], acc[ai][bj][m][n], 0, 0, 0); __builtin_amdgcn_s_setprio(0); } while (0)
#define PG8_WAIT_V(n) asm volatile("s_waitcnt vmcnt(" #n ")" ::: "memory")
#define PG8_WAIT_L(n) asm volatile("s_waitcnt lgkmcnt(" #n ")" ::: "memory")
#define PG8_BAR __builtin_amdgcn_s_barrier()
#define PG8_SCHED __builtin_amdgcn_sched_barrier(0)
    Unit cur, nxt; int ui = 0;
    if (!S.next(0, cur)) return;
    f32x4 acc[2][2][4][2];
#pragma unroll
    for (int a = 0; a < 2; ++a)
#pragma unroll
        for (int b = 0; b < 2; ++b)
#pragma unroll
            for (int m = 0; m < 4; ++m)
#pragma unroll
                for (int n = 0; n < 2; ++n) acc[a][b][m][n] = (f32x4){0.f, 0.f, 0.f, 0.f};
    bf16x8 At[4][2], B0[2][2], B1[2][2];
    const char* cA = (const char*)g.A + (size_t)cur.pm * tstep; const char* cB = (const char*)g.Bt + (size_t)cur.pn * tstep;
    S.a_ready(cur);
    if constexpr (SP2) {
        PG8_STAGE(PG8_SB(0, 0), cB, voffB); PG8_STAGE(PG8_SB(0, 1), cB + hstep, voffB); PG8_STAGE(PG8_SA(0, 0), cA, voffA); PG8_STAGE(PG8_SA(0, 1), cA + hstep, voffA);
        if (wr == 1) PG8_BAR;
        PG8_WAIT_V(2); PG8_BAR;
        PG8_STAGE(PG8_SB(1, 0), cB + kstep, voffB); PG8_STAGE(PG8_SA(1, 0), cA + kstep, voffA); PG8_STAGE(PG8_SB(1, 1), cB + hstep + kstep, voffB);
        PG8_WAIT_V(6); PG8_BAR;
    } else {
        PG8_STAGE(PG8_SB(0, 0), cB, voffB); PG8_STAGE(PG8_SA(0, 0), cA, voffA); PG8_STAGE(PG8_SB(0, 1), cB + hstep, voffB); PG8_STAGE(PG8_SA(0, 1), cA + hstep, voffA);
        if (wr == 1) PG8_BAR;
        PG8_WAIT_V(4); PG8_BAR;
        PG8_STAGE(PG8_SB(1, 0), cB + kstep, voffB); PG8_STAGE(PG8_SA(1, 0), cA + kstep, voffA); PG8_STAGE(PG8_SB(1, 1), cB + hstep + kstep, voffB);
        PG8_WAIT_V(6); PG8_BAR;
    }
    for (;;) {
        const bool has_next = S.next(ui + 1, nxt);
        const char* nA = has_next ? (const char*)g.A + (size_t)nxt.pm * tstep : cA; const char* nB = has_next ? (const char*)g.Bt + (size_t)nxt.pn * tstep : cB;
#pragma unroll 1
        for (int t = 0; t < nt; t += 2) {
            const bool last = (t == nt - 2);
            const char* a1 = cA + (size_t)(t + 1) * kstep;
            const char* a2 = last ? nA : cA + (size_t)(t + 2) * kstep; const char* b2 = last ? nB : cB + (size_t)(t + 2) * kstep;
            const char* a3 = a2 + kstep; const char* b3 = b2 + kstep;
            if (last && has_next) S.a_ready(nxt);
            if constexpr (SP2) {
            PG8_LDB(B0, 0, 0); PG8_LDB(B1, 0, 1); PG8_SCHED; PG8_LDA(At, 0, 0); PG8_STAGE(PG8_SA(1, 1), a1 + hstep, voffA);
            PG8_WAIT_V(8); PG8_WAIT_L(0); PG8_BAR; PG8_MMA(0, 0, At, B0); PG8_MMA(0, 1, At, B1); PG8_BAR; PG8_SCHED;
            PG8_LDA(At, 0, 1); PG8_STAGE(PG8_SB(0, 0), b2, voffB); PG8_STAGE(PG8_SB(0, 1), b2 + hstep, voffB); PG8_STAGE(PG8_SA(0, 0), a2, voffA);
            PG8_WAIT_V(8); PG8_WAIT_L(0); PG8_BAR; PG8_MMA(1, 0, At, B0); PG8_MMA(1, 1, At, B1); PG8_BAR; PG8_SCHED;
            PG8_LDB(B0, 1, 0); PG8_LDB(B1, 1, 1); PG8_SCHED; PG8_LDA(At, 1, 0); PG8_STAGE(PG8_SA(0, 1), a2 + hstep, voffA);
            PG8_WAIT_V(8); PG8_WAIT_L(0); PG8_BAR; PG8_MMA(0, 0, At, B0); PG8_MMA(0, 1, At, B1); PG8_BAR; PG8_SCHED;
            PG8_LDA(At, 1, 1); PG8_STAGE(PG8_SB(1, 0), b3, voffB); PG8_STAGE(PG8_SB(1, 1), b3 + hstep, voffB); PG8_STAGE(PG8_SA(1, 0), a3, voffA);
            PG8_WAIT_V(8); PG8_WAIT_L(0); PG8_BAR; PG8_MMA(1, 0, At, B0); PG8_MMA(1, 1, At, B1); PG8_BAR; PG8_SCHED;
            } else {
            PG8_LDB(B0, 0, 0); PG8_SCHED; PG8_LDA(At, 0, 0); PG8_STAGE(PG8_SA(1, 1), a1 + hstep, voffA);
            PG8_WAIT_L(8); PG8_BAR; PG8_WAIT_L(0); PG8_MMA(0, 0, At, B0); PG8_BAR; PG8_SCHED;
            PG8_LDB(B1, 0, 1); PG8_STAGE(PG8_SB(0, 0), b2, voffB);
            PG8_BAR; PG8_WAIT_L(0); PG8_MMA(0, 1, At, B1); PG8_BAR;
            PG8_LDA(At, 0, 1); PG8_STAGE(PG8_SA(0, 0), a2, voffA);
            PG8_BAR; PG8_WAIT_L(0); PG8_MMA(1, 0, At, B0); PG8_BAR; PG8_SCHED;
            PG8_STAGE(PG8_SB(0, 1), b2 + hstep, voffB);
            PG8_WAIT_V(6); PG8_BAR; PG8_MMA(1, 1, At, B1); PG8_BAR;
            PG8_LDB(B0, 1, 0); PG8_SCHED; PG8_LDA(At, 1, 0); PG8_STAGE(PG8_SA(0, 1), a2 + hstep, voffA);
            PG8_WAIT_L(8); PG8_BAR; PG8_WAIT_L(0); PG8_MMA(0, 0, At, B0); PG8_BAR; PG8_SCHED;
            PG8_LDB(B1, 1, 1); PG8_STAGE(PG8_SB(1, 0), b3, voffB);
            PG8_BAR; PG8_WAIT_L(0); PG8_MMA(0, 1, At, B1); PG8_BAR;
            PG8_LDA(At, 1, 1); PG8_STAGE(PG8_SA(1, 0), a3, voffA);
            PG8_BAR; PG8_WAIT_L(0); PG8_MMA(1, 0, At, B0); PG8_BAR; PG8_SCHED;
            PG8_STAGE(PG8_SB(1, 1), b3 + hstep, voffB);
            PG8_WAIT_V(6); PG8_BAR; PG8_MMA(1, 1, At, B1); PG8_BAR;
            }
        }
        if constexpr (ALIGN_EPI) { if (wr == 0) PG8_BAR; }
        bool rst_ = true; if constexpr (!Epi::AFTER_DRAIN) { rst_ = E(acc, cur, wr, wc, fr, fq); S.done(cur); }
        if (!has_next) break;
        if (rst_) {
#pragma unroll
        for (int a = 0; a < 2; ++a)
#pragma unroll
            for (int b = 0; b < 2; ++b)
#pragma unroll
                for (int m = 0; m < 4; ++m)
#pragma unroll
                    for (int n = 0; n < 2; ++n) acc[a][b][m][n] = (f32x4){0.f, 0.f, 0.f, 0.f};
        }
        cur = nxt; cA = nA; cB = nB; ++ui;
        if constexpr (ALIGN_EPI) { if (wr == 1) PG8_BAR; }
    }
    PG8_WAIT_V(0);
    if constexpr (!ALIGN_EPI) { if (wr == 0) PG8_BAR; }
    PG8_BAR;
    if constexpr (Epi::AFTER_DRAIN) { E.fused(acc, cur, wr, wc, fr, fq, lds, wid, lane); S.done(cur); }
#undef PG8_SA
#undef PG8_SB
#undef PG8_STAGE
#undef PG8_LDA
#undef PG8_LDB
#undef PG8_MMA
#undef PG8_WAIT_V
#undef PG8_WAIT_L
#undef PG8_BAR
#undef PG8_SCHED
}
}
using pg8::Unit;
#define EPI_ROWS_BEGIN _Pragma("unroll") for (int ai = 0; ai < 2; ++ai) _Pragma("unroll") for (int m = 0; m < 4; ++m) { const int row = u.pm * 256 + ai * 128 + wr * 64 + m * 16 + fr;
#define EPI_COLS_BEGIN _Pragma("unroll") for (int bj = 0; bj < 2; ++bj) { const int col = u.pn * 256 + bj * 128 + wc * 32 + 8 * fq; \
    float v[8]; { const f32x4 a0 = acc[ai][bj][m][0], a1 = acc[ai][bj][m][1]; v[0] = a0[0]; v[1] = a0[1]; v[2] = a0[2]; v[3] = a0[3]; v[4] = a1[0]; v[5] = a1[1]; v[6] = a1[2]; v[7] = a1[3]; }
#define EPI_END } asm volatile("" ::: "memory"); }
__device__ __forceinline__ void st_bf16x8(bf16_t* p, const float* v) { *(u32x4*)p = pack8(v); }
__device__ __forceinline__ void st_f32x8(float* p, const float* v) { *(f32x4*)p = (f32x4){v[0], v[1], v[2], v[3]}; *(f32x4*)(p + 4) = (f32x4){v[4], v[5], v[6], v[7]}; }

template <int XL> __device__ __forceinline__ void rope8(float* v, bool second, const float* cs, const float* sn) {
    const f32x4 c0 = *(const f32x4*)cs, c1 = *(const f32x4*)(cs + 4), s0 = *(const f32x4*)sn, s1 = *(const f32x4*)(sn + 4);
    const float c[8] = {c0[0], c0[1], c0[2], c0[3], c1[0], c1[1], c1[2], c1[3]}, s[8] = {s0[0], s0[1], s0[2], s0[3], s1[0], s1[1], s1[2], s1[3]};
#pragma unroll
    for (int i = 0; i < 8; ++i) { const float p = __shfl_xor(v[i], XL); v[i] = v[i] * c[i] + (second ? p : -p) * s[i]; }
}

struct EpiG1 {
    static constexpr bool PERM = true, AFTER_DRAIN = false;
    bf16_t *RX, *CQ, *CKV, *KR; float* okr; const float* rope; int l;
    __device__ __forceinline__ bool operator()(f32x4 (&acc)[2][2][4][2], const Unit& u, int wr, int wc, int fr, int fq) const {
        const bool dec = u.pm >= 32;
        EPI_ROWS_BEGIN
            const int kvr = kvrow_of(row);
            EPI_COLS_BEGIN
                if (col < 512) st_bf16x8(RX + (size_t)row * 512 + col, v);
                else if (col < 896) st_bf16x8(CQ + (size_t)row * 384 + (col - 512), v);
                else if (col < 1152) st_bf16x8(CKV + (size_t)kvr * 256 + (col - 896), v);
                else if (col < 1184) {
                    const int e = col - 1152;
                    if (dec) { const int t = (row - NP) & 2047, pos = (fq & 2) ? (t & 63) : (t >> 6);
                        rope8<16>(v, (fq & 1) != 0, rope + pos * 8, rope + 512 + pos * 8); }
                    else st_f32x8(okr + (size_t)cache_row(row, l) * 32 + e, v);
                    st_bf16x8(KR + (size_t)kvr * 32 + e, v);
                }
            EPI_END
        return true;
    }
};
struct EpiQ {
    static constexpr bool PERM = true, AFTER_DRAIN = false;
    bf16_t* Q; const float* rope;
    __device__ __forceinline__ bool operator()(f32x4 (&acc)[2][2][4][2], const Unit& u, int wr, int wc, int fr, int fq) const {
        const bool dec = u.pm >= 32;
        EPI_ROWS_BEGIN
            EPI_COLS_BEGIN
                const int g32 = col >> 5;
                if (dec && (g32 % 3) == 2) { const int t = (row - NP) & 2047, pos = (fq & 2) ? (t & 63) : (t >> 6);
                    rope8<16>(v, (fq & 1) != 0, rope + pos * 8, rope + 512 + pos * 8); }
#pragma unroll
                for (int i = 0; i < 8; ++i) v[i] *= SCALE_M;
                st_bf16x8(Q + (size_t)row * 768 + col, v);
            EPI_END
        return true;
    }
};
struct EpiPlain {
    static constexpr bool PERM = true, AFTER_DRAIN = false;
    bf16_t* O; int ldc;
    __device__ __forceinline__ bool operator()(f32x4 (&acc)[2][2][4][2], const Unit& u, int wr, int wc, int fr, int fq) const {
        EPI_ROWS_BEGIN
            EPI_COLS_BEGIN
                st_bf16x8(O + (size_t)row * ldc + col, v);
            EPI_END
        return true;
    }
};
struct EpiG3 {
    static constexpr bool PERM = true, AFTER_DRAIN = false;
    bf16_t *DQ, *DK, *DV; float *odk, *odv; const float* rope; int l;
    __device__ __forceinline__ bool operator()(f32x4 (&acc)[2][2][4][2], const Unit& u, int wr, int wc, int fr, int fq) const {
        const bool dec = u.pm >= 32;
        EPI_ROWS_BEGIN
            const int kvr = kvrow_of(row);
            EPI_COLS_BEGIN
                if (col < 1024) {
                    if (dec) { const int t = (row - NP) & 2047, pos = ((col >> 5) & 1) ? (t & 63) : (t >> 6);
                        rope8<32>(v, (fq & 2) != 0, rope + pos * 16 + (fq & 1) * 8, rope + 1024 + pos * 16 + (fq & 1) * 8); }
                    if (col < 512) {
#pragma unroll
                        for (int i = 0; i < 8; ++i) v[i] *= SCALE_D;
                        st_bf16x8(DQ + (size_t)row * 512 + col, v);
                    } else {
                        if (!dec) st_f32x8(odk + (size_t)cache_row(row, l) * 512 + (col - 512), v);
                        st_bf16x8(DK + (size_t)kvr * 512 + (col - 512), v);
                    }
                } else {
                    if (!dec) st_f32x8(odv + (size_t)cache_row(row, l) * 512 + (col - 1024), v);
                    st_bf16x8(DV + (size_t)kvr * 512 + (col - 1024), v);
                }
            EPI_END
        return true;
    }
};
struct EpiG4 {
    static constexpr bool PERM = true, AFTER_DRAIN = false;
    bf16_t* Y; bf16_t* G; int row_off;
    __device__ __forceinline__ bool operator()(f32x4 (&acc)[2][2][4][2], const Unit& u, int wr, int wc, int fr, int fq) const {
        EPI_ROWS_BEGIN
            EPI_COLS_BEGIN
                if (col < 1536) {
                    const int slot = col >> 9, cc = col & 511;
                    bf16_t* p = Y + (size_t)slot * ((size_t)NTOK * 512) + (size_t)(row + row_off) * 512 + cc;
                    float pre[8]; unpack8(*(const u32x4*)p, pre);
#pragma unroll
                    for (int i = 0; i < 8; ++i) v[i] = pre[i] * siluf_(v[i]);
                    st_bf16x8(p, v);
                } else {
#pragma unroll
                    for (int i = 0; i < 8; ++i) v[i] = sigmoidf_(v[i]);
                    st_bf16x8(G + (size_t)row * 3072 + (col - 1536), v);
                }
            EPI_END
        return true;
    }
};
struct EpiG5 {
    static constexpr bool PERM = true, AFTER_DRAIN = false;
    const bf16_t* G; bf16_t* MG; int half;
    __device__ __forceinline__ bool operator()(f32x4 (&acc)[2][2][4][2], const Unit& u, int wr, int wc, int fr, int fq) const {
        const int br = u.pn >> 2, pn = u.pn & 3, pml = u.pm - br * 96 - half * 48;
#pragma unroll
        for (int ai = 0; ai < 2; ++ai)
#pragma unroll
            for (int m = 0; m < 4; ++m) { const int rl = pml * 256 + ai * 128 + wr * 64 + m * 16 + fr;
#pragma unroll
                for (int bj = 0; bj < 2; ++bj) { const int col = pn * 256 + bj * 128 + wc * 32 + 8 * fq;
                    float g0[8], f[8]; unpack8(*(const u32x4*)(G + (size_t)rl * 3072 + br * 1024 + col), g0);
                    if (br < 2) { float g1[8]; unpack8(*(const u32x4*)(G + (size_t)rl * 3072 + (br + 1) * 1024 + col), g1);
#pragma unroll
                        for (int i = 0; i < 8; ++i) f[i] = fmaxf(g0[i], 1e-30f) / fmaxf(g1[i], 1e-30f);
                        if (br == 0) {
#pragma unroll
                            for (int i = 0; i < 8; ++i) f[i] = g0[i] / fmaxf(g1[i], 1e-30f);
                        }
                    } else {
#pragma unroll
                        for (int i = 0; i < 8; ++i) f[i] = fmaxf(g0[i], 1e-30f);
                    }
                    f32x4& a0 = acc[ai][bj][m][0]; f32x4& a1 = acc[ai][bj][m][1];
                    a0[0] *= f[0]; a0[1] *= f[1]; a0[2] *= f[2]; a0[3] *= f[3]; a1[0] *= f[4]; a1[1] *= f[5]; a1[2] *= f[6]; a1[3] *= f[7];
                    if (br == 2) { const float v[8] = {a0[0], a0[1], a0[2], a0[3], a1[0], a1[1], a1[2], a1[3]};
                        st_bf16x8(MG + (size_t)(half * HALF_TOK + rl) * 1024 + col, v); }
                } }
        return br == 2;
    }
};
struct EpiG6 {
    static constexpr bool PERM = true, AFTER_DRAIN = false;
    bf16_t* O; float* ssq;
    __device__ __forceinline__ bool operator()(f32x4 (&acc)[2][2][4][2], const Unit& u, int wr, int wc, int fr, int fq) const {
        EPI_ROWS_BEGIN
            float s = 0.f;
            EPI_COLS_BEGIN
#pragma unroll
                for (int i = 0; i < 8; ++i) s += v[i] * v[i];
                st_bf16x8(O + (size_t)row * 1024 + col, v);
            }
            s += __shfl_xor(s, 16); s += __shfl_xor(s, 32);
            if (fq == 0) ssq[(size_t)row * 16 + u.pn * 4 + wc] = s;
        }
        return true;
    }
};
namespace att {
#define SBAR() __builtin_amdgcn_sched_barrier(0)
__device__ __forceinline__ int crow(int r, int hi) { return (r & 3) + 8 * (r >> 2) + 4 * hi; }
template <int DQK> __device__ __forceinline__ int kswz(int row, int chunk) {
    if constexpr (DQK == 64) return row * 128 + ((chunk ^ ((row >> 1) & 7)) << 4);
    else return row * 256 + ((chunk ^ (row & 15)) << 4);
}
template <int DQK> struct KTile { static constexpr int BYTES = DQK == 64 ? 8192 : 16384; };
template <int DV> __device__ __forceinline__ int v_st(int k, int c) { return ((k >> 3) * (DV / 32) + (c >> 5)) * 512 + ((k & 7) * 32 + (c & 31)) * 2; }
__device__ __forceinline__ int v_rd_base(int lane) { return ((lane >> 4) & 1) * 32 + (lane & 3) * 8 + (4 * (lane >> 5) + ((lane & 15) >> 2)) * 64; }
template <int OFF> __device__ __forceinline__ s16x4 tr_read(int vb) {
    s16x4 r; asm volatile("ds_read_b64_tr_b16 %0, %1 offset:%2" : "=&v"(r) : "v"(vb), "i"(OFF) : "memory"); return r;
}
template <int DV, int D0> __device__ __forceinline__ void pv_one(f32x16& od, int vb, bf16x8 pa0, bf16x8 pa1, bf16x8 pa2, bf16x8 pa3) {
    constexpr int NB = DV / 32;
#define VOFF(ks, half) (D0 * 4096 + (ks) * 1024 + (half) * 512)
    const s16x4 l0 = tr_read<VOFF(0, 0)>(vb), h0 = tr_read<VOFF(0, 1)>(vb), l1 = tr_read<VOFF(1, 0)>(vb), h1 = tr_read<VOFF(1, 1)>(vb);
    const s16x4 l2 = tr_read<VOFF(2, 0)>(vb), h2 = tr_read<VOFF(2, 1)>(vb), l3 = tr_read<VOFF(3, 0)>(vb), h3 = tr_read<VOFF(3, 1)>(vb);
#undef VOFF
    asm volatile("s_waitcnt lgkmcnt(0)" ::: "memory"); SBAR();
#define PK(L, H) (bf16x8){L[0], L[1], L[2], L[3], H[0], H[1], H[2], H[3]}
    od = __builtin_amdgcn_mfma_f32_32x32x16_bf16(pa0, PK(l0, h0), od, 0, 0, 0);
    od = __builtin_amdgcn_mfma_f32_32x32x16_bf16(pa1, PK(l1, h1), od, 0, 0, 0);
    od = __builtin_amdgcn_mfma_f32_32x32x16_bf16(pa2, PK(l2, h2), od, 0, 0, 0);
    od = __builtin_amdgcn_mfma_f32_32x32x16_bf16(pa3, PK(l3, h3), od, 0, 0, 0);
#undef PK
}
template <int DV> __device__ __forceinline__ void pv_all(f32x16* o, int vb, bf16x8 pa0, bf16x8 pa1, bf16x8 pa2, bf16x8 pa3) {
    pv_one<DV, 0>(o[0], vb, pa0, pa1, pa2, pa3); pv_one<DV, 1>(o[1], vb, pa0, pa1, pa2, pa3);
    if constexpr (DV == 128) { pv_one<DV, 2>(o[2], vb, pa0, pa1, pa2, pa3); pv_one<DV, 3>(o[3], vb, pa0, pa1, pa2, pa3); }
}
template <int DV> __device__ __forceinline__ void pv_vis(f32x16* o, const LAS char* vrd, bf16x8 pa0, bf16x8 pa1, bf16x8 pa2, bf16x8 pa3) {
    typedef short v4i16_t __attribute__((ext_vector_type(4)));
#define TRR(off) __builtin_bit_cast(s16x4, __builtin_amdgcn_ds_read_tr16_b64_v4i16((LAS v4i16_t*)(vrd + (off))))
#define PKV(L, H) (bf16x8){L[0], L[1], L[2], L[3], H[0], H[1], H[2], H[3]}
#pragma unroll
    for (int d0 = 0; d0 < DV / 32; ++d0) {
        const s16x4 l0 = TRR(d0 * 4096), h0 = TRR(d0 * 4096 + 512), l1 = TRR(d0 * 4096 + 1024), h1 = TRR(d0 * 4096 + 1536);
        const s16x4 l2 = TRR(d0 * 4096 + 2048), h2 = TRR(d0 * 4096 + 2560), l3 = TRR(d0 * 4096 + 3072), h3 = TRR(d0 * 4096 + 3584);
        o[d0] = __builtin_amdgcn_mfma_f32_32x32x16_bf16(pa0, PKV(l0, h0), o[d0], 0, 0, 0);
        o[d0] = __builtin_amdgcn_mfma_f32_32x32x16_bf16(pa1, PKV(l1, h1), o[d0], 0, 0, 0);
        o[d0] = __builtin_amdgcn_mfma_f32_32x32x16_bf16(pa2, PKV(l2, h2), o[d0], 0, 0, 0);
        o[d0] = __builtin_amdgcn_mfma_f32_32x32x16_bf16(pa3, PKV(l3, h3), o[d0], 0, 0, 0); }
#undef TRR
#undef PKV
}
constexpr float THRL = 6.0f;
__device__ __forceinline__ void partialSM(f32x16& p0, f32x16& p1, float& m_reg, float& alpha) {
    float pmax = p0[0];
#pragma unroll
    for (int r = 1; r < 16; ++r) pmax = fmaxf(pmax, p0[r]);
#pragma unroll
    for (int r = 0; r < 16; ++r) pmax = fmaxf(pmax, p1[r]);
    { auto rr = __builtin_amdgcn_permlane32_swap(__float_as_uint(pmax), __float_as_uint(pmax), false, false);
      pmax = fmaxf(__uint_as_float(rr[0]), __uint_as_float(rr[1])); }
    float mn;
    if (__builtin_expect(__all(pmax - m_reg <= THRL), 1)) { mn = m_reg; alpha = 1.f; }
    else { mn = fmaxf(m_reg, pmax); alpha = __builtin_amdgcn_exp2f(m_reg - mn); m_reg = mn; }
#pragma unroll
    for (int r = 0; r < 16; ++r) p0[r] = __builtin_amdgcn_exp2f(p0[r] - mn);
#pragma unroll
    for (int r = 0; r < 16; ++r) p1[r] -= mn;
}
__device__ __forceinline__ void finishSM(f32x16& p0, f32x16& p1, float alpha, float& l_reg, bf16x8& pa0, bf16x8& pa1, bf16x8& pa2, bf16x8& pa3) {
#pragma unroll
    for (int r = 0; r < 16; ++r) p1[r] = __builtin_amdgcn_exp2f(p1[r]);
    float ps = 0.f;
#pragma unroll
    for (int r = 0; r < 16; ++r) ps += p0[r];
#pragma unroll
    for (int r = 0; r < 16; ++r) ps += p1[r];
    l_reg = l_reg * alpha + ps;
#define PK4(P, B, OUT) do { u32x4 w = {pk2(P[B + 0], P[B + 1]), pk2(P[B + 2], P[B + 3]), pk2(P[B + 4], P[B + 5]), pk2(P[B + 6], P[B + 7])}; OUT = __builtin_bit_cast(bf16x8, w); } while (0)
    PK4(p0, 0, pa0); PK4(p0, 8, pa1); PK4(p1, 0, pa2); PK4(p1, 8, pa3);
#undef PK4
}
template <int DQK> __device__ __forceinline__ void qkt(f32x16& p0, f32x16& p1, const char* Ks, const bf16x8* qr, int r32, int hi) {
    p0 = f32x16{}; p1 = f32x16{};
#pragma unroll
    for (int d0 = 0; d0 < DQK / 16; ++d0) {
        const bf16x8 b0 = *reinterpret_cast<const bf16x8*>(Ks + d0 * 2048 + hi * 1024 + r32 * 16);
        const bf16x8 b1 = *reinterpret_cast<const bf16x8*>(Ks + d0 * 2048 + hi * 1024 + 512 + r32 * 16);
        p0 = __builtin_amdgcn_mfma_f32_32x32x16_bf16(b0, qr[d0], p0, 0, 0, 0);
        p1 = __builtin_amdgcn_mfma_f32_32x32x16_bf16(b1, qr[d0], p1, 0, 0, 0);
    }
}
template <int DQK, int DV, bool PIPE>
__device__ __forceinline__ void attn_core(const bf16_t* __restrict__ Qw, int ldq, const bf16_t* __restrict__ K1, int ldk1, const bf16_t* __restrict__ K2, int ldk2,
                                          const bf16_t* __restrict__ Vp, int ldv, int nkeys, char* lds, f32x16 (&o)[DV / 32], float& l_out) {
    constexpr int KB = DQK * 128, VB = DV * 128, SLOT = KB + VB, NS = PIPE ? 4 : 3, NPK = DQK / 8, NPV = DV / 8, NP_ = NPK + NPV;
    static_assert(NP_ <= 24, "3 pieces per wave");
    const int tid = tid_now(), lane = tid & 63, r32 = lane & 31, hi = lane >> 5; const int wid = __builtin_amdgcn_readfirstlane(tid >> 6);
    float* al_l = (float*)(lds + NS * SLOT) + wid * 64;
    float m_reg = -1e30f, l_reg = 0.f;
#pragma unroll
    for (int d = 0; d < DV / 32; ++d) o[d] = f32x16{};
    const bf16_t* psrc[3]; int pstep[3]; int pdst[3];
#pragma unroll
    for (int i = 0; i < 3; ++i) { int p = wid + 8 * i; if (p >= NP_) p -= 8;
        if (p < NPK) { if (DQK == 96 && p >= 8) { psrc[i] = K2 + (size_t)lane * ldk2 + (p - 8) * 8; pstep[i] = 64 * ldk2; } else { psrc[i] = K1 + (size_t)lane * ldk1 + p * 8; pstep[i] = 64 * ldk1; } pdst[i] = p * 1024; }
        else { const int q = p - NPK, d0 = q >> 2, kq = q & 3; psrc[i] = Vp + (size_t)(16 * kq + (lane >> 2)) * ldv + d0 * 32 + (lane & 3) * 8; pstep[i] = 64 * ldv; pdst[i] = KB + q * 1024; } }
#define DMA_TILE(t, slotoff) do { _Pragma("unroll") for (int i = 0; i < 3; ++i) \
        __builtin_amdgcn_global_load_lds((const unsigned*)(psrc[i] + (size_t)(t) * pstep[i]), (LAS unsigned*)(lds + (slotoff) + pdst[i]), 16, 0, 0); } while (0)
#define WAITV(n) asm volatile("s_waitcnt vmcnt(" #n ")" ::: "memory")
#define BAR() asm volatile("s_waitcnt lgkmcnt(0)\n\ts_barrier" ::: "memory")
#define RESC(a) do { if (__any((a) < 1.f)) { if (hi == 0) al_l[r32] = (a); asm volatile("s_waitcnt lgkmcnt(0)" ::: "memory"); \
        _Pragma("unroll") for (int d = 0; d < DV / 32; ++d) _Pragma("unroll") for (int r = 0; r < 16; ++r) o[d][r] *= al_l[crow(r, hi)]; } } while (0)
    const int NT = nkeys / 64;
    WAITV(0);
    bf16x8 qr[DQK / 16];
    { const bf16_t* q = Qw + (size_t)(wid * 32 + r32) * ldq + hi * 8;
#pragma unroll
      for (int d0 = 0; d0 < DQK / 16; ++d0) qr[d0] = *reinterpret_cast<const bf16x8*>(q + d0 * 16); }
    BAR();
    DMA_TILE(0, 0); DMA_TILE(1, SLOT);
    const int vb0 = (int)(uintptr_t)lds + KB + v_rd_base(lane);
    bf16x8 pa0, pa1, pa2, pa3;
    if constexpr (!PIPE) {
        typedef short v4i16_t __attribute__((ext_vector_type(4)));
        constexpr int NB = DV / 32;
        const LAS char* vrd = (const LAS char*)(LAS char*)(lds) + KB + v_rd_base(lane);
        const LAS char* krd = (const LAS char*)(LAS char*)(lds) + hi * 1024 + r32 * 16;
        f32x16 p0, p1; float al; int sl = 0, sl2 = 2 * SLOT;
#pragma unroll 1
        for (int t = 0; t < NT; ++t) {
            if (t + 1 < NT) WAITV(3); else WAITV(0);
            BAR();
            if (t + 2 < NT) DMA_TILE(t + 2, sl2);
            SBAR();
            bf16x8 kf[DQK / 16][2]; s16x4 vl[NB][4], vh[NB][4];
#pragma unroll
            for (int d0 = 0; d0 < DQK / 16; ++d0) { kf[d0][0] = *(const LAS bf16x8*)(krd + sl + d0 * 2048); kf[d0][1] = *(const LAS bf16x8*)(krd + sl + d0 * 2048 + 512); }
#pragma unroll
            for (int d0 = 0; d0 < NB; ++d0)
#pragma unroll
                for (int ks = 0; ks < 4; ++ks) {
                    vl[d0][ks] = __builtin_bit_cast(s16x4, __builtin_amdgcn_ds_read_tr16_b64_v4i16((LAS v4i16_t*)(vrd + sl + d0 * 4096 + ks * 1024)));
                    vh[d0][ks] = __builtin_bit_cast(s16x4, __builtin_amdgcn_ds_read_tr16_b64_v4i16((LAS v4i16_t*)(vrd + sl + d0 * 4096 + ks * 1024 + 512))); }
            SBAR();
            p0 = f32x16{}; p1 = f32x16{};
#pragma unroll
            for (int d0 = 0; d0 < DQK / 16; ++d0) {
                p0 = __builtin_amdgcn_mfma_f32_32x32x16_bf16(kf[d0][0], qr[d0], p0, 0, 0, 0);
                p1 = __builtin_amdgcn_mfma_f32_32x32x16_bf16(kf[d0][1], qr[d0], p1, 0, 0, 0); }
            partialSM(p0, p1, m_reg, al); RESC(al);
            finishSM(p0, p1, al, l_reg, pa0, pa1, pa2, pa3);
#define PKV(L, H) (bf16x8){L[0], L[1], L[2], L[3], H[0], H[1], H[2], H[3]}
#pragma unroll
            for (int d0 = 0; d0 < NB; ++d0) {
                o[d0] = __builtin_amdgcn_mfma_f32_32x32x16_bf16(pa0, PKV(vl[d0][0], vh[d0][0]), o[d0], 0, 0, 0);
                o[d0] = __builtin_amdgcn_mfma_f32_32x32x16_bf16(pa1, PKV(vl[d0][1], vh[d0][1]), o[d0], 0, 0, 0);
                o[d0] = __builtin_amdgcn_mfma_f32_32x32x16_bf16(pa2, PKV(vl[d0][2], vh[d0][2]), o[d0], 0, 0, 0);
                o[d0] = __builtin_amdgcn_mfma_f32_32x32x16_bf16(pa3, PKV(vl[d0][3], vh[d0][3]), o[d0], 0, 0, 0); }
#undef PKV
            sl = sl == (NS - 1) * SLOT ? 0 : sl + SLOT; sl2 = sl2 == (NS - 1) * SLOT ? 0 : sl2 + SLOT;
        }
    } else {
        f32x16 pA0, pA1, pB0, pB1; float alA, alB;
        const LAS char* vrd = (const LAS char*)(LAS char*)(lds) + KB + v_rd_base(lane);
        WAITV(3); BAR(); DMA_TILE(2, 2 * SLOT);
        qkt<DQK>(pA0, pA1, lds, qr, r32, hi); partialSM(pA0, pA1, m_reg, alA);
        int sp = 0, sc = SLOT, sn = 3 * SLOT;
#define ROT() do { sp = sc; sc = sc == 3 * SLOT ? 0 : sc + SLOT; sn = sn == 3 * SLOT ? 0 : sn + SLOT; } while (0)
#pragma unroll 1
        for (int j = 1; j + 1 < NT; j += 2) {
            WAITV(3); BAR(); if (j + 2 < NT) DMA_TILE(j + 2, sn);
            SBAR(); qkt<DQK>(pB0, pB1, lds + sc, qr, r32, hi);
            finishSM(pA0, pA1, alA, l_reg, pa0, pa1, pa2, pa3); SBAR();
            pv_all<DV>(o, vb0 + sp, pa0, pa1, pa2, pa3); partialSM(pB0, pB1, m_reg, alB);
            RESC(alB); ROT();
            if (j + 2 < NT) WAITV(3); else WAITV(0);
            BAR(); if (j + 3 < NT) DMA_TILE(j + 3, sn);
            SBAR(); qkt<DQK>(pA0, pA1, lds + sc, qr, r32, hi);
            finishSM(pB0, pB1, alB, l_reg, pa0, pa1, pa2, pa3); SBAR();
            pv_all<DV>(o, vb0 + sp, pa0, pa1, pa2, pa3); partialSM(pA0, pA1, m_reg, alA);
            RESC(alA); ROT();
        }
        WAITV(0); BAR();
        SBAR(); qkt<DQK>(pB0, pB1, lds + sc, qr, r32, hi);
        finishSM(pA0, pA1, alA, l_reg, pa0, pa1, pa2, pa3); SBAR();
        pv_all<DV>(o, vb0 + sp, pa0, pa1, pa2, pa3); partialSM(pB0, pB1, m_reg, alB);
        RESC(alB);
        finishSM(pB0, pB1, alB, l_reg, pa0, pa1, pa2, pa3); SBAR();
        pv_all<DV>(o, vb0 + sc, pa0, pa1, pa2, pa3);
#undef ROT
    }
    { auto rr = __builtin_amdgcn_permlane32_swap(__float_as_uint(l_reg), __float_as_uint(l_reg), false, false);
      l_out = __uint_as_float(rr[0]) + __uint_as_float(rr[1]); }
#undef DMA_TILE
#undef WAITV
#undef BAR
#undef RESC
}
}
typedef const float __attribute__((address_space(1)))* cfp_t;
constexpr int LDS_TAB = 146432;
struct Frame {
    unsigned char* lds; unsigned char* ws; float* out; const LAS cfp_t* in;
    int tid, lane, wave, vcu, G, bid;
};
#define IN_(k) ((const float*)F.in[k])

__device__ __forceinline__ void tr_item(const float* W, int ldw, int col0, int K, bf16_t* WT, int drow0, int kb, int nb, LAS float* scr, int lane, bool zero) {
    const int k0 = 64 * kb, n0 = 32 * nb;
    if (!zero) {
#pragma unroll 8
        for (int i = 0; i < 32; ++i) { const int kk = 2 * i + (lane >> 5); scr[kk * 33 + (lane & 31)] = W[(size_t)(k0 + kk) * ldw + col0 + n0 + (lane & 31)]; }
    }
    asm volatile("s_waitcnt lgkmcnt(0)" ::: "memory");
    const int c = lane & 7;
#pragma unroll
    for (int j = 0; j < 4; ++j) { const int n = (lane >> 3) + 8 * j; const LAS float* s = scr + (8 * c) * 33 + n;
        u32x4 o; o.x = pk2(s[0 * 33], s[1 * 33]); o.y = pk2(s[2 * 33], s[3 * 33]); o.z = pk2(s[4 * 33], s[5 * 33]); o.w = pk2(s[6 * 33], s[7 * 33]);
        if (zero) o = (u32x4){0u, 0u, 0u, 0u};
        *(u32x4*)(WT + (size_t)(drow0 + n0 + n) * K + k0 + 8 * c) = o; }
    asm volatile("s_waitcnt lgkmcnt(0)" ::: "memory");
}
__device__ __forceinline__ int win_src_col(int r) {
    if (r < 512) return r;
    if (r < 896) return 1024 + (r - 512);
    if (r < 1152) return 1408 + (r - 896);
    if (r < 1184) return 1664;
    if (r < 1280) return -1;
    if (r < 1792) return 2208 + (r - 1280);
    if (r < 2304) return 2720 + (r - 1792);
    if (r < 2816) return 3232 + (r - 2304);
    if (r < 3328) return 512 + (r - 2816);
    if (r < 3840) return 1696 + (r - 3328);
    if (r < 4352) return 3744 + (r - 3840);
    return 4256 + (r - 4352);
}
__device__ __forceinline__ void convert_weights(Frame& F, int l) {
    LAS float* scr = (LAS float*)(F.lds) + F.wave * 2176;
    unsigned char* Wb = F.ws + WS_W;
    const int gw = F.vcu * 8 + F.wave, NGW = F.G * 8;
    constexpr int I_IN = 16 * 232, I_UQ = 6 * 24, I_UKV = 4 * 32, I_BR = 8 * 32, I_OUT = 16 * 32, I_RG = 64;
    constexpr int NITEMS = I_IN + I_UQ + I_UKV + 3 * I_BR + I_OUT + I_RG;
    for (int it = gw; it < NITEMS; it += NGW) {
        int r = it;
        if (r < I_IN) { const int db = r % 232, kb = r / 232; const int sc = win_src_col(db * 32);
            tr_item(IN_(13) + (size_t)l * 1024 * IN_COLS, IN_COLS, sc < 0 ? 0 : sc, 1024, (bf16_t*)(Wb + W_IN), db * 32, kb, 0, scr, F.lane, sc < 0); continue; } r -= I_IN;
        if (r < I_UQ) { tr_item(IN_(22) + (size_t)l * 384 * 768, 768, 0, 384, (bf16_t*)(Wb + W_UQ), 0, r / 24, r % 24, scr, F.lane, false); continue; } r -= I_UQ;
        if (r < I_UKV) { tr_item(IN_(24) + (size_t)l * 256 * 1024, 1024, 0, 256, (bf16_t*)(Wb + W_UKV), 0, r / 32, r % 32, scr, F.lane, false); continue; } r -= I_UKV;
        if (r < 3 * I_BR) { const int b = r / I_BR, q = r % I_BR;
            tr_item((b == 0 ? IN_(30) : b == 1 ? IN_(31) : IN_(32)) + (size_t)l * 512 * 1024, 1024, 0, 512, (bf16_t*)(Wb + W_BR), b * 1024, q / 32, q % 32, scr, F.lane, false); continue; } r -= 3 * I_BR;
        if (r < I_OUT) { tr_item(IN_(33) + (size_t)l * 1024 * 1024, 1024, 0, 1024, (bf16_t*)(Wb + W_OUT), 0, r / 32, r % 32, scr, F.lane, false); continue; } r -= I_OUT;
        { const int mat = r >> 1, nb = r & 1, gate = mat >> 4, dn = mat & 15;
          const float* src = (gate ? IN_(18) : IN_(16)) + ((size_t)l * 16 + dn) * 4096;
          const int d = dn >> 3, n = dn & 7;
          tr_item(src, 64, 0, 64, (bf16_t*)(Wb + W_RG) + (size_t)((d * 2 + gate) * 8 + n) * 4096, 0, 0, nb, scr, F.lane, false); }
    }
}
__device__ __forceinline__ void phase0_mod_rope(Frame& F) {
    float* mod = (float*)(F.ws + CTL_MOD);
    if (F.bid < 96) {
        const int l = F.bid / 48, c0 = (F.bid % 48) * 64;
        LAS float* sc = (LAS float*)F.lds + 8 * 2176;
        LAS float* red = sc + 9 * 1024;
        for (int i = F.tid; i < 9 * 1024; i += NTHREADS) { const int g = i >> 10, k = i & 1023; const float x = g == 0 ? IN_(8)[k] : IN_(7)[(g - 1) * 1024 + k]; sc[i] = siluf_(x); }
        __syncthreads();
        float a[9];
#pragma unroll
        for (int g = 0; g < 9; ++g) a[g] = 0.f;
        const float* w = IN_(9) + (size_t)l * 1024 * 3072 + c0 + F.lane;
        for (int k = F.wave * 128; k < F.wave * 128 + 128; ++k) { const float wv = w[(size_t)k * 3072];
#pragma unroll
            for (int g = 0; g < 9; ++g) a[g] += sc[g * 1024 + k] * wv; }
#pragma unroll
        for (int g = 0; g < 9; ++g) red[(F.wave * 9 + g) * 64 + F.lane] = a[g];
        __syncthreads();
        for (int i = F.tid; i < 9 * 64; i += NTHREADS) { const int g = i >> 6, c = i & 63; float s = IN_(10)[l * 3072 + c0 + c];
#pragma unroll
            for (int wv = 0; wv < 8; ++wv) s += red[(wv * 9 + g) * 64 + c];
            mod[((size_t)l * 9 + g) * 3072 + c0 + c] = s; }
        __syncthreads();
    } else if (F.bid == 96) {
        float* rp = (float*)(F.ws + CTL_ROPE);
        for (int i = F.tid; i < 64 * 8; i += NTHREADS) { const int pos = i >> 3, j = i & 7; const float ang = (float)pos * powf(10000.0f, -(float)j / 8.0f); rp[i] = cosf(ang); rp[512 + i] = sinf(ang); }
        for (int i = F.tid; i < 64 * 16; i += NTHREADS) { const int pos = i >> 4, j = i & 15; const float ang = (float)pos * powf(10000.0f, -(float)j / 16.0f); rp[1024 + i] = cosf(ang); rp[2048 + i] = sinf(ang); }
    }
}
__device__ __forceinline__ const float* x_row_l0(Frame& F, int r) { return r < NP ? IN_(0) + (size_t)r * DM : IN_(1) + (size_t)(r - NP) * DM; }
__device__ __forceinline__ void prenorm_store(Frame& F, const f32x4* v, int r, int l) {
    float s = 0.f;
#pragma unroll
    for (int j = 0; j < 4; ++j) s += (v[j].x * v[j].x + v[j].y * v[j].y) + (v[j].z * v[j].z + v[j].w * v[j].w);
    const float rstd = 1.0f / sqrtf(wave_sum(s) * (1.0f / DM) + EPS);
    const float* mod = (const float*)(F.ws + CTL_MOD) + ((size_t)l * 9 + grp_of(r)) * 3072;
    const float* gp = IN_(11) + l * DM;
    bf16_t* h = (bf16_t*)(F.ws + WS_H) + (size_t)r * DM;
#pragma unroll
    for (int j = 0; j < 4; ++j) { const int c = 4 * F.lane + 256 * j;
        const f32x4 g = *(const f32x4*)(gp + c), sh = *(const f32x4*)(mod + c), sc = *(const f32x4*)(mod + 1024 + c);
        const f32x4 y = (v[j] * rstd * g) * (sc + 1.0f) + sh;
        u32x2 w; w.x = pk2(y.x, y.y); w.y = pk2(y.z, y.w); *(u32x2*)(h + c) = w; }
}
__device__ __forceinline__ void phase0_h(Frame& F) {
    const int gw = F.vcu * 8 + F.wave, NGW = F.G * 8;
    for (int r = gw; r < NTOK; r += NGW) { const f32x4* xr = (const f32x4*)x_row_l0(F, r) + F.lane; f32x4 v[4];
#pragma unroll
        for (int j = 0; j < 4; ++j) v[j] = xr[64 * j];
        prenorm_store(F, v, r, 0); }
}
__device__ __forceinline__ void phase_post(Frame& F, int l) {
    const int gw = F.vcu * 8 + F.wave, NGW = F.G * 8;
    const bf16_t* O = (const bf16_t*)(F.ws + WS_A + A_O);
    const float* ssq = (const float*)(F.ws + CTL_SSQ);
    const float* gpost = IN_(12) + l * DM;
    for (int r = gw; r < NTOK; r += NGW) {
        float sq = F.lane < 16 ? ssq[(size_t)r * 16 + F.lane] : 0.f;
        const float rstd = 1.0f / sqrtf(wave_sum(sq) * (1.0f / DM) + EPS);
        const float* xin = l == 0 ? x_row_l0(F, r) : F.out + O_Y + (size_t)r * DM;
        float* xo = F.out + O_Y + (size_t)r * DM;
        const float* gate = (const float*)(F.ws + CTL_MOD) + ((size_t)l * 9 + grp_of(r)) * 3072 + 2048;
        f32x4 v[4];
#pragma unroll
        for (int j = 0; j < 4; ++j) { const int c = 4 * F.lane + 256 * j;
            const u32x2 ow = *(const u32x2*)(O + (size_t)r * DM + c);
            const f32x4 o = {bflo(ow.x), bfhi(ow.x), bflo(ow.y), bfhi(ow.y)};
            const f32x4 x = *(const f32x4*)(xin + c), g = *(const f32x4*)(gpost + c), gt = *(const f32x4*)(gate + c);
            v[j] = x + gt * (o * rstd * g);
            *(f32x4*)(xo + c) = v[j]; }
        if (l == 0) prenorm_store(F, v, r, 1);
    }
}
constexpr int RN_RAW = 0;
constexpr int RN_XB = 38016;
constexpr int RN_XF = RN_XB + 36864;
constexpr int RN_WC = RN_XF + 16384;
static_assert(RN_WC + 1024 <= 131072, "rnn LDS map");
#define LDS_BARRIER() asm volatile("s_waitcnt lgkmcnt(0)\n\ts_barrier" ::: "memory")
__device__ __forceinline__ float neg_expm1(float x, float ex) {
    const float s = -x * (1.0f + x * (0.5f + x * (0.16666667f + x * (0.041666668f + x * 0.008333334f))));
    return x > -0.125f ? s : 1.0f - ex;
}
__device__ __forceinline__ void rnn_item(Frame& F, int l, int seq, int n, int qt) {
    const bool dec = seq >= 32;
    const int S = dec ? 2048 : 256, tok0 = dec ? NP + (seq - 32) * 2048 : seq * 256, nck = S / 256;
    const int tid = F.tid, lane = F.lane, wave = F.wave;
    const bf16_t* RX = (const bf16_t*)(F.ws + WS_Y + 2 * Y_SLOT) + (size_t)tok0 * 512 + n * 64;
    bf16_t* HS = (bf16_t*)(F.ws + WS_Y) + (size_t)tok0 * 512 + n * 64 + qt * 16;
    unsigned char* L = F.lds;
    const int oc0 = n * 64 + qt * 16;
    const int jc = lane & 15, g = lane >> 4;
    const int c8 = tid & 7, tb = tid >> 3;
    float cw[4][8], cbv[8];
#pragma unroll
    for (int k = 0; k < 4; ++k) { const f32x4 w0 = *(const f32x4*)(IN_(14) + ((size_t)l * 4 + k) * 512 + n * 64 + c8 * 8), w1 = *(const f32x4*)(IN_(14) + ((size_t)l * 4 + k) * 512 + n * 64 + c8 * 8 + 4);
        cw[k][0] = w0.x; cw[k][1] = w0.y; cw[k][2] = w0.z; cw[k][3] = w0.w; cw[k][4] = w1.x; cw[k][5] = w1.y; cw[k][6] = w1.z; cw[k][7] = w1.w; }
    { const f32x4 b0 = *(const f32x4*)(IN_(15) + l * 512 + n * 64 + c8 * 8), b1 = *(const f32x4*)(IN_(15) + l * 512 + n * 64 + c8 * 8 + 4);
      cbv[0] = b0.x; cbv[1] = b0.y; cbv[2] = b0.z; cbv[3] = b0.w; cbv[4] = b1.x; cbv[5] = b1.y; cbv[6] = b1.z; cbv[7] = b1.w; }
    u32x4 raw[5];
#define RN_LOAD(c0_) do { _Pragma("unroll") for (int i = 0; i < 5; ++i) { const int pc = tid + i * 512, rr = pc >> 3, pc8 = pc & 7, t = (c0_) - 2 + rr; \
        const bool ok = t >= 0 && t < S && pc < 2072; const int tc = ok ? t : 0; \
        if (i < 4 || tid < 24) { raw[i] = *(const u32x4*)(RX + (size_t)tc * 512 + pc8 * 8); if (!ok) raw[i] = (u32x4){0u, 0u, 0u, 0u}; } } } while (0)
#define RN_STORE() do { _Pragma("unroll") for (int i = 0; i < 5; ++i) { const int pc = tid + i * 512, rr = pc >> 3, pc8 = pc & 7; \
        if (i < 4 || tid < 24) *(u32x4*)(L + RN_RAW + rr * 144 + pc8 * 16) = raw[i]; } } while (0)
    for (int dir = 0; dir < 2; ++dir) {
        const float ba = IN_(17)[(l * 2 + dir) * 512 + oc0 + jc], bx = IN_(19)[(l * 2 + dir) * 512 + oc0 + jc];
        const float lam = IN_(20)[(l * 2 + dir) * 512 + oc0 + jc];
        const float sp8 = -8.0f * log1pf(__expf(-lam));
        const bf16_t* wt = (const bf16_t*)(F.ws + WS_W + W_RG);
        bf16x8 wa[2], wx[2];
#pragma unroll
        for (int ks = 0; ks < 2; ++ks) {
            wa[ks] = *(const bf16x8*)(wt + (size_t)((dir * 2 + 0) * 8 + n) * 4096 + (qt * 16 + jc) * 64 + ks * 32 + g * 8);
            wx[ks] = *(const bf16x8*)(wt + (size_t)((dir * 2 + 1) * 8 + n) * 4096 + (qt * 16 + jc) * 64 + ks * 32 + g * 8); }
        float carry = dec ? IN_(6)[(((seq - 32) * 2 + l) * 2 + dir) * 512 + oc0 + jc] : 0.f;
        asm volatile("s_waitcnt vmcnt(0)" ::: "memory");
        RN_LOAD(dir == 0 ? 0 : (nck - 1) * 256);
        for (int cc = 0; cc < nck; ++cc) {
            const int ci = dir == 0 ? cc : nck - 1 - cc, c0 = ci * 256;
            RN_STORE();
            if (cc + 1 < nck) RN_LOAD(dir == 0 ? c0 + 256 : c0 - 256);
            float hfv[2][4];
#pragma unroll
            for (int rb = 0; rb < 2; ++rb)
#pragma unroll
                for (int i = 0; i < 4; ++i) hfv[rb][i] = dir == 1 ? bf2f(HS[(size_t)(c0 + wave * 32 + rb * 16 + 4 * g + i) * 512 + jc]) : 0.f;
            LDS_BARRIER();
            {
                float xr[7][8];
#pragma unroll
                for (int r = 0; r < 7; ++r) unpack8(*(const u32x4*)(L + RN_RAW + (tb * 4 + r) * 144 + c8 * 16), xr[r]);
#pragma unroll
                for (int tt = 0; tt < 4; ++tt) { float acc8[8];
#pragma unroll
                    for (int e = 0; e < 8; ++e) acc8[e] = cbv[e] + xr[tt][e] * cw[0][e] + xr[tt + 1][e] * cw[1][e] + xr[tt + 2][e] * cw[2][e] + xr[tt + 3][e] * cw[3][e];
                    *(u32x4*)(L + RN_XB + (tb * 4 + tt) * 144 + c8 * 16) = pack8(acc8);
                    if ((c8 >> 1) == qt) { float* xf = (float*)(L + RN_XF) + (tb * 4 + tt) * 16 + (c8 & 1) * 8;
                        *(f32x4*)xf = (f32x4){acc8[0], acc8[1], acc8[2], acc8[3]}; *(f32x4*)(xf + 4) = (f32x4){acc8[4], acc8[5], acc8[6], acc8[7]}; } }
            }
            LDS_BARRIER();
            float av[2][4], bv[2][4];
#pragma unroll
            for (int rb = 0; rb < 2; ++rb) {
                f32x4 ga = {0.f, 0.f, 0.f, 0.f}, gx = {0.f, 0.f, 0.f, 0.f};
#pragma unroll
                for (int ks = 0; ks < 2; ++ks) {
                    const bf16x8 af = *(const bf16x8*)(L + RN_XB + (wave * 32 + rb * 16 + jc) * 144 + (ks * 32 + g * 8) * 2);
                    ga = __builtin_amdgcn_mfma_f32_16x16x32_bf16(af, wa[ks], ga, 0, 0, 0);
                    gx = __builtin_amdgcn_mfma_f32_16x16x32_bf16(af, wx[ks], gx, 0, 0, 0);
                }
#pragma unroll
                for (int i = 0; i < 4; ++i) { const int t = wave * 32 + rb * 16 + 4 * g + i;
                    const float r = __builtin_amdgcn_rcpf(1.0f + __expf(-(ga[i] + ba))), ig = __builtin_amdgcn_rcpf(1.0f + __expf(-(gx[i] + bx)));
                    const float la = sp8 * r, a = __expf(la), a2 = a * a;
                    const float xc = ((const float*)(L + RN_XF))[t * 16 + jc];
                    av[rb][i] = a; bv[rb][i] = __builtin_amdgcn_sqrtf(neg_expm1(2.0f * la, a2)) * (ig * xc); }
            }
            float sA[2], sB[2];
#pragma unroll
            for (int rb = 0; rb < 2; ++rb) { float A = 1.f, B = 0.f;
#pragma unroll
                for (int i = 0; i < 4; ++i) { const int ii = dir == 0 ? i : 3 - i; A *= av[rb][ii]; B = av[rb][ii] * B + bv[rb][ii]; }
                sA[rb] = A; sB[rb] = B; }
            float iA[2], iB[2];
#pragma unroll
            for (int rb = 0; rb < 2; ++rb) { float A = sA[rb], B = sB[rb];
#pragma unroll
                for (int st = 1; st < 4; st <<= 1) {
                    const int src = dir == 0 ? lane - 16 * st : lane + 16 * st;
                    const float pA = __shfl(A, src & 63), pB = __shfl(B, src & 63);
                    const bool has = dir == 0 ? (g >= st) : (g + st <= 3);
                    if (has) { B = A * pB + B; A = A * pA; } }
                iA[rb] = A; iB[rb] = B; }
            const int lastl = dir == 0 ? 48 + jc : jc;
            float tA[2], tB[2];
#pragma unroll
            for (int rb = 0; rb < 2; ++rb) { tA[rb] = __shfl(iA[rb], lastl); tB[rb] = __shfl(iB[rb], lastl); }
            const int f0 = dir == 0 ? 0 : 1, f1 = 1 - f0;
            const float wA = tA[f0] * tA[f1], wB = tA[f1] * tB[f0] + tB[f1];
            float* WC = (float*)(L + RN_WC);
            if (g == 0) { WC[(wave * 2 + 0) * 16 + jc] = wA; WC[(wave * 2 + 1) * 16 + jc] = wB; }
            LDS_BARRIER();
            float hin = carry, hout = carry;
#pragma unroll
            for (int w = 0; w < 8; ++w) { const int ws_ = dir == 0 ? w : 7 - w; const float A = WC[(ws_ * 2 + 0) * 16 + jc], B = WC[(ws_ * 2 + 1) * 16 + jc];
                hout = A * hout + B; const bool before = dir == 0 ? (ws_ < wave) : (ws_ > wave); if (before) hin = hout; }
            carry = hout;
#pragma unroll
            for (int rbi = 0; rbi < 2; ++rbi) { const int rb = rbi == 0 ? f0 : f1;
                float h = hin; if (rbi == 1) h = tA[f0] * h + tB[f0];
                const int src = dir == 0 ? lane - 16 : lane + 16; const float pA = __shfl(iA[rb], src & 63), pB = __shfl(iB[rb], src & 63);
                const bool has = dir == 0 ? (g >= 1) : (g <= 2);
                if (has) h = pA * h + pB;
#pragma unroll
                for (int i = 0; i < 4; ++i) { const int ii = dir == 0 ? i : 3 - i;
                    h = av[rb][ii] * h + bv[rb][ii];
                    HS[(size_t)(c0 + wave * 32 + rb * 16 + 4 * g + ii) * 512 + jc] = (bf16_t)(pk2(h + hfv[rb][ii], 0.f) & 0xffffu); } }
        }
        if (!dec && wave == 0 && g == 0) F.out[O_ST + ((size_t)(seq * 2 + l) * 2 + dir) * 512 + oc0 + jc] = carry;
    }
#undef RN_LOAD
#undef RN_STORE
    LDS_BARRIER();
}
__device__ __forceinline__ void phase_rnn_prep(Frame& F, int l, bool do_prep) {
#pragma unroll 1
    for (int k = 0; k < 5; ++k) {
        int seq, n, qt;
        if (k == 0) { const int v = F.vcu; seq = 32 + (v >> 5); n = (v & 31) >> 2; qt = v & 3; }
        else { const int p = F.vcu * 4 + k - 1; seq = p >> 5; n = (p & 31) >> 2; qt = p & 3; }
        rnn_item(F, l, seq, n, qt);
    }
    if (!do_prep) return;
    const int gw = F.vcu * 8 + F.wave, NGW = F.G * 8, lane = F.lane;
    bf16_t* CQ = (bf16_t*)(F.ws + WS_Y + Y_SLOT); bf16_t* CKV = (bf16_t*)(F.ws + WS_A + A_CKV); bf16_t* KR = (bf16_t*)(F.ws + WS_A + A_KR);
    const float* qn = IN_(21) + l * 384; const float* kn = IN_(23) + l * 256;
    for (int r = gw; r < NTOK; r += NGW) {
        float q[8], c[8]; float sq = 0.f, sc = 0.f;
        bf16_t* qp = CQ + (size_t)r * 384 + lane * 8; bf16_t* cp = CKV + (size_t)kvrow_of(r) * 256 + lane * 8;
        if (lane < 48) { unpack8(*(const u32x4*)qp, q);
#pragma unroll
            for (int i = 0; i < 8; ++i) sq += q[i] * q[i]; }
        if (lane < 32) { unpack8(*(const u32x4*)cp, c);
#pragma unroll
            for (int i = 0; i < 8; ++i) sc += c[i] * c[i]; }
        const float rq = 1.0f / sqrtf(wave_sum(sq) * (1.0f / 384.0f) + EPS), rc = 1.0f / sqrtf(wave_sum(sc) * (1.0f / 256.0f) + EPS);
        if (lane < 48) {
#pragma unroll
            for (int i = 0; i < 8; ++i) q[i] = q[i] * rq * qn[lane * 8 + i];
            *(u32x4*)qp = pack8(q); }
        if (lane < 32) {
#pragma unroll
            for (int i = 0; i < 8; ++i) c[i] = c[i] * rc * kn[lane * 8 + i];
            *(u32x4*)cp = pack8(c);
            if (r < NP) st_f32x8(F.out + O_CKV + (size_t)cache_row(r, l) * 256 + lane * 8, c); }
    }
    for (int i = gw; i < 4096; i += NGW) { const int b = i >> 9, j = i & 511; const int kvr = NP + b * 2560 + j;
        const float* s1 = IN_(2) + ((size_t)(b * 2 + l) * 512 + j) * 256;
        if (lane < 32) { const f32x4 a = *(const f32x4*)(s1 + lane * 8), bq = *(const f32x4*)(s1 + lane * 8 + 4); const float v[8] = {a.x, a.y, a.z, a.w, bq.x, bq.y, bq.z, bq.w};
            *(u32x4*)(CKV + (size_t)kvr * 256 + lane * 8) = pack8(v); }
        const float* s2 = IN_(3) + ((size_t)(b * 2 + l) * 512 + j) * 32;
        if (lane < 4) { const f32x4 a = *(const f32x4*)(s2 + lane * 8), bq = *(const f32x4*)(s2 + lane * 8 + 4); const float v[8] = {a.x, a.y, a.z, a.w, bq.x, bq.y, bq.z, bq.w};
            *(u32x4*)(KR + (size_t)kvr * 32 + lane * 8) = pack8(v); }
    }
}
__device__ __forceinline__ void convert_diff_ctx(Frame& F, int l) {
    const int gw = F.vcu * 8 + F.wave, NGW = F.G * 8, lane = F.lane;
    bf16_t* DK = (bf16_t*)(F.ws + WS_A + A_DK); bf16_t* DV = (bf16_t*)(F.ws + WS_A + A_DV);
    for (int i = gw; i < 8192; i += NGW) { const int which = i >> 12, b = (i >> 9) & 7, j = i & 511; const int kvr = NP + b * 2560 + j;
        const float* s = (which ? IN_(5) : IN_(4)) + ((size_t)(b * 2 + l) * 512 + j) * 512 + lane * 8;
        const f32x4 a = *(const f32x4*)s, bq = *(const f32x4*)(s + 4); const float v[8] = {a.x, a.y, a.z, a.w, bq.x, bq.y, bq.z, bq.w};
        *(u32x4*)((which ? DV : DK) + (size_t)kvr * 512 + lane * 8) = pack8(v); }
}
#ifndef MLA_PIPE
#define MLA_PIPE true
#endif
constexpr int ATT_STASH = 75776;
#ifndef ATT_SDEPTH_M
#define ATT_SDEPTH_M 1
#endif
#ifndef ATT_SDEPTH_D
#define ATT_SDEPTH_D 0
#endif
__device__ __forceinline__ void mla_unit(Frame& F, int tok0, int kv0, int nkeys, int h) {
    const bf16_t* Q = (const bf16_t*)(F.ws + WS_A + A_Q); const bf16_t* KV = (const bf16_t*)(F.ws + WS_A + A_KV); const bf16_t* KR = (const bf16_t*)(F.ws + WS_A + A_KR);
    bf16_t* OM = (bf16_t*)(F.ws + WS_Y + Y_SLOT);
    f32x16 o[2]; float l;
    att::attn_core<96, 64, MLA_PIPE>(Q + (size_t)tok0 * 768 + h * 96, 768, KV + (size_t)kv0 * 1024 + h * 128, 1024, KR + (size_t)kv0 * 32, 32,
                           KV + (size_t)kv0 * 1024 + h * 128 + 64, 1024, nkeys, (char*)F.lds, o, l);
    const int lane = F.lane, r32 = lane & 31, hi = lane >> 5;
    float* li = (float*)(F.lds + (MLA_PIPE ? 4 : 3) * 20480) + F.wave * 64 + 32;
    if (hi == 0) li[r32] = l;
    asm volatile("s_waitcnt lgkmcnt(0)" ::: "memory");
#pragma unroll
    for (int r = 0; r < 16; ++r) { const int q = att::crow(r, hi); const float rl = __builtin_amdgcn_rcpf(li[q]);
        bf16_t* op = OM + (size_t)(tok0 + F.wave * 32 + q) * 512 + h * 64 + r32;
#pragma unroll
        for (int d = 0; d < 2; ++d) op[d * 32] = (bf16_t)(pk2(o[d][r] * rl, 0.f) & 0xffffu); }
}
__device__ __forceinline__ void phase_mla(Frame& F) {
    const int x = F.vcu >> 5, j = F.vcu & 31;
#pragma unroll 1
    for (int u = 0; u < 3; ++u) {
        int tok0, kv0, nkeys, h;
        if (u < 2) { const int idx = j * 2 + u, pair = x * 8 + (idx >> 3), qb = idx & 7, b = pair >> 3; h = pair & 7; tok0 = NP + b * 2048 + qb * 256; kv0 = NP + b * 2560; nkeys = 2560; }
        else { const int b = F.vcu >> 3; h = F.vcu & 7; tok0 = b * 256; kv0 = b * 256; nkeys = 256; }
        mla_unit(F, tok0, kv0, nkeys, h);
    }
}
__device__ __forceinline__ void diff_pass(Frame& F, int l, int tok0, int kv0, int nkeys, int h, int pass, float lam, float lam_init) {
    const bf16_t* DQ = (const bf16_t*)(F.ws + WS_A + A_DQ); const bf16_t* DK = (const bf16_t*)(F.ws + WS_A + A_DK); const bf16_t* DV = (const bf16_t*)(F.ws + WS_A + A_DV);
    bf16_t* OD = (bf16_t*)(F.ws + WS_Y + 2 * Y_SLOT);
    const int lane = F.lane, r32 = lane & 31, hi = lane >> 5;
    float* li = (float*)(F.lds + 3 * 24576) + F.wave * 64 + 32;
    unsigned* stash = (unsigned*)(F.lds + ATT_STASH + F.wave * 8192);
    f32x16 o[4]; float lsum;
    const int coff = h * 128 + (pass == 0 ? 64 : 0);
    att::attn_core<64, 128, false>(DQ + (size_t)tok0 * 512 + coff, 512, DK + (size_t)kv0 * 512 + coff, 512, nullptr, 0,
                            DV + (size_t)kv0 * 512 + h * 128, 512, nkeys, (char*)F.lds, o, lsum);
    if (hi == 0) li[r32] = lsum;
    asm volatile("s_waitcnt lgkmcnt(0)" ::: "memory");
    if (pass == 0) {
#pragma unroll
        for (int r = 0; r < 16; r += 2) { const float rl0 = lam * __builtin_amdgcn_rcpf(li[att::crow(r, hi)]), rl1 = lam * __builtin_amdgcn_rcpf(li[att::crow(r + 1, hi)]);
#pragma unroll
            for (int d = 0; d < 4; ++d) stash[(d * 8 + (r >> 1)) * 64 + lane] = pk2(o[d][r] * rl0, o[d][r + 1] * rl1); }
        asm volatile("s_waitcnt lgkmcnt(0)" ::: "memory");
    } else {
        const float* dn = IN_(29) + l * 128;
        const float g0 = dn[r32], g1 = dn[32 + r32], g2 = dn[64 + r32], g3 = dn[96 + r32];
#pragma unroll
        for (int r = 0; r < 16; r += 2) {
            const float rl0 = __builtin_amdgcn_rcpf(li[att::crow(r, hi)]), rl1 = __builtin_amdgcn_rcpf(li[att::crow(r + 1, hi)]);
            float e0[4], e1[4]; float s0 = 0.f, s1 = 0.f;
#pragma unroll
            for (int d = 0; d < 4; ++d) { const unsigned w = stash[(d * 8 + (r >> 1)) * 64 + lane];
                e0[d] = o[d][r] * rl0 - bflo(w); e1[d] = o[d][r + 1] * rl1 - bfhi(w); s0 += e0[d] * e0[d]; s1 += e1[d] * e1[d]; }
#pragma unroll
            for (int m = 1; m < 32; m <<= 1) { s0 += __shfl_xor(s0, m); s1 += __shfl_xor(s1, m); }
            const float k0 = (1.0f - lam_init) / sqrtf(s0 * (1.0f / 128.0f) + EPS), k1 = (1.0f - lam_init) / sqrtf(s1 * (1.0f / 128.0f) + EPS);
            bf16_t* p0 = OD + (size_t)(tok0 + F.wave * 32 + att::crow(r, hi)) * 512 + h * 128 + r32;
            bf16_t* p1 = OD + (size_t)(tok0 + F.wave * 32 + att::crow(r + 1, hi)) * 512 + h * 128 + r32;
            p0[0] = (bf16_t)(pk2(e0[0] * k0 * g0, 0.f) & 0xffffu); p0[32] = (bf16_t)(pk2(e0[1] * k0 * g1, 0.f) & 0xffffu);
            p0[64] = (bf16_t)(pk2(e0[2] * k0 * g2, 0.f) & 0xffffu); p0[96] = (bf16_t)(pk2(e0[3] * k0 * g3, 0.f) & 0xffffu);
            p1[0] = (bf16_t)(pk2(e1[0] * k1 * g0, 0.f) & 0xffffu); p1[32] = (bf16_t)(pk2(e1[1] * k1 * g1, 0.f) & 0xffffu);
            p1[64] = (bf16_t)(pk2(e1[2] * k1 * g2, 0.f) & 0xffffu); p1[96] = (bf16_t)(pk2(e1[3] * k1 * g3, 0.f) & 0xffffu);
        }
    }
}
__device__ __forceinline__ void phase_diff(Frame& F, int l) {
    const float lam_init = 0.8f - 0.6f * expf(-0.3f * (float)l);
    const float d1 = wave_sum(IN_(25)[l * 64 + F.lane] * IN_(26)[l * 64 + F.lane]), d2 = wave_sum(IN_(27)[l * 64 + F.lane] * IN_(28)[l * 64 + F.lane]);
    const float lam = expf(d1) - expf(d2) + lam_init;
    const int x = F.vcu >> 5, j = F.vcu & 31;
    const int nsteps = (F.vcu & 1) == 0 ? 4 : 2;
#pragma unroll 1
    for (int st = 0; st < nsteps; ++st) {
        int tok0, kv0, nkeys, h;
        if (st < 2) { const int pair = x * 4 + (j >> 3), qb = j & 7, b = pair >> 2; h = pair & 3; tok0 = NP + b * 2048 + qb * 256; kv0 = NP + b * 2560; nkeys = 2560; }
        else { const int p = F.vcu >> 1, b = p >> 2; h = p & 3; tok0 = b * 256; kv0 = b * 256; nkeys = 256; }
        diff_pass(F, l, tok0, kv0, nkeys, h, st & 1, lam, lam_init);
    }
}
#define GEMM_CALL(EPI, SCHED, g, S, E) pg8::gemm_phase<EPI, SCHED, true, true>((PG8_LAS unsigned char*)F.lds, g, S, E)
struct BrOrder {
    int c, half;
    __device__ __forceinline__ bool next(int i, pg8::Unit& u) const { if (c >= 192 || i >= 3) return false; u.pm = i * 96 + half * 48 + (c >> 2); u.pn = i * 4 + (c & 3); return true; }
    __device__ __forceinline__ void a_ready(const pg8::Unit&) const {}
    __device__ __forceinline__ void done(const pg8::Unit&) const {}
};
__device__ __forceinline__ void phase_g1(Frame& F, int l) {
    pg8::Gemm g{(const bf16_t*)(F.ws + WS_H), (const bf16_t*)(F.ws + WS_W + W_IN), NTOK, 1280, 1024};
    pg8::StaticOrder S; S.init(NTOK, 1280, F.G, F.bid);
    EpiG1 E{(bf16_t*)(F.ws + WS_Y + 2 * Y_SLOT), (bf16_t*)(F.ws + WS_Y + Y_SLOT), (bf16_t*)(F.ws + WS_A + A_CKV), (bf16_t*)(F.ws + WS_A + A_KR),
            F.out + O_KR, (const float*)(F.ws + CTL_ROPE), l};
    GEMM_CALL(EpiG1, pg8::StaticOrder, g, S, E);
}
__device__ __forceinline__ void phase_g2(Frame& F) {
    { pg8::Gemm g{(const bf16_t*)(F.ws + WS_Y + Y_SLOT), (const bf16_t*)(F.ws + WS_W + W_UQ), NTOK, 768, 384};
      pg8::StaticOrder S; S.init(NTOK, 768, F.G, F.bid);
      EpiQ E{(bf16_t*)(F.ws + WS_A + A_Q), (const float*)(F.ws + CTL_ROPE)};
      GEMM_CALL(EpiQ, pg8::StaticOrder, g, S, E); }
    { pg8::Gemm g{(const bf16_t*)(F.ws + WS_A + A_CKV), (const bf16_t*)(F.ws + WS_W + W_UKV), NKV, 1024, 256};
      pg8::StaticOrder S; S.init(NKV, 1024, F.G, (F.bid + F.G - (288 % F.G)) % F.G);
      EpiPlain E{(bf16_t*)(F.ws + WS_A + A_KV), 1024};
      GEMM_CALL(EpiPlain, pg8::StaticOrder, g, S, E); }
}
__device__ __forceinline__ void phase_g3(Frame& F, int l) {
    convert_diff_ctx(F, l);
    pg8::Gemm g{(const bf16_t*)(F.ws + WS_H), (const bf16_t*)(F.ws + WS_W + W_IN) + (size_t)1280 * 1024, NTOK, 1536, 1024};
    pg8::StaticOrder S; S.init(NTOK, 1536, F.G, F.bid);
    EpiG3 E{(bf16_t*)(F.ws + WS_A + A_DQ), (bf16_t*)(F.ws + WS_A + A_DK), (bf16_t*)(F.ws + WS_A + A_DV), F.out + O_DK, F.out + O_DV, (const float*)(F.ws + CTL_ROPE) + 1024, l};
    GEMM_CALL(EpiG3, pg8::StaticOrder, g, S, E);
}
__device__ __forceinline__ void phase_g4(Frame& F, int half) {
    pg8::Gemm g{(const bf16_t*)(F.ws + WS_H) + (size_t)half * HALF_TOK * 1024, (const bf16_t*)(F.ws + WS_W + W_IN) + (size_t)2816 * 1024, HALF_TOK, 4608, 1024};
    pg8::StaticOrder S; S.init(HALF_TOK, 4608, F.G, F.bid);
    EpiG4 E{(bf16_t*)(F.ws + WS_Y), (bf16_t*)(F.ws + WS_A + A_G), half * HALF_TOK};
    GEMM_CALL(EpiG4, pg8::StaticOrder, g, S, E);
}
__device__ __forceinline__ void phase_g5(Frame& F, int half) {
    pg8::Gemm g{(const bf16_t*)(F.ws + WS_Y), (const bf16_t*)(F.ws + WS_W + W_BR), 3 * NTOK, 3072, 512};
    BrOrder S{F.bid, half};
    EpiG5 E{(const bf16_t*)(F.ws + WS_A + A_G), (bf16_t*)(F.ws + WS_H), half};
    GEMM_CALL(EpiG5, BrOrder, g, S, E);
}
__device__ __forceinline__ void phase_g6(Frame& F) {
    pg8::Gemm g{(const bf16_t*)(F.ws + WS_H), (const bf16_t*)(F.ws + WS_W + W_OUT), NTOK, 1024, 1024};
    pg8::StaticOrder S; S.init(NTOK, 1024, F.G, F.bid);
    EpiG6 E{(bf16_t*)(F.ws + WS_A + A_O), (float*)(F.ws + CTL_SSQ)};
    GEMM_CALL(EpiG6, pg8::StaticOrder, g, S, E);
}

#define XB_TMO      128
#define XB_XCNT(j)  (256  + 64 * (j))
#define XB_XSUB(j)  (1280 + 64 * (j))
#define XB_XGEN(j)  (2304 + 64 * (j))
#define XB_TOP      3328
#define XB_TOPGEN   3392
#define XCD_BAR_WORDS 3456
#define XB_SPIN_CAP (1u << 18)

__device__ __forceinline__ unsigned xb_ld(unsigned* p)              { return __hip_atomic_load(p, __ATOMIC_RELAXED, __HIP_MEMORY_SCOPE_AGENT); }
__device__ __forceinline__ unsigned xb_add(unsigned* p, unsigned v) { return __hip_atomic_fetch_add(p, v, __ATOMIC_RELAXED, __HIP_MEMORY_SCOPE_AGENT); }
__device__ __forceinline__ unsigned xb_xcc_id() { return (unsigned)__builtin_amdgcn_s_getreg((3 << 11) | 20) & 0xFu; }
#define XB_SPIN(cond, bar) do { unsigned _sp = 0; while (cond) { __builtin_amdgcn_s_sleep(1); \
    if ((++_sp & 255u) == 0u) { if (xb_ld(&(bar)[XB_TMO])) break; if (_sp > XB_SPIN_CAP) { atomicAdd(&(bar)[XB_TMO], 1u); break; } } } } while (0)

struct XcdBarrier {
    unsigned* bar; unsigned x;
    volatile LAS unsigned* st;
};

__device__ __forceinline__ XcdBarrier xcd_barrier_post(unsigned* bar, volatile LAS unsigned* st) {
    XcdBarrier b; b.bar = bar; b.x = xb_xcc_id(); b.st = st;
    if (threadIdx.x == 0) (void)xb_add(&bar[XB_XCNT(b.x)], 1u);
    return b;
}
__device__ __forceinline__ void xcd_barrier_complete(unsigned* bar, unsigned x, unsigned& nloc, unsigned& nx) {
    const unsigned G = gridDim.x * gridDim.y * gridDim.z;
    unsigned sum, cnt, mine, sp = 0u;
    for (;;) {
        sum = 0u; cnt = 0u; mine = 0u;
#pragma unroll
        for (unsigned j = 0; j < 16; ++j) { const unsigned c = xb_ld(&bar[XB_XCNT(j)]); sum += c; cnt += (c > 0u) ? 1u : 0u; mine = (j == x) ? c : mine; }
        if (sum == G) break;
        __builtin_amdgcn_s_sleep(1);
        if ((++sp & 255u) == 0u) { if (xb_ld(&bar[XB_TMO])) break; if (sp > XB_SPIN_CAP) { atomicAdd(&bar[XB_TMO], 1u); break; } }
    }
    nloc = mine > 0u ? mine : 1u; nx = cnt > 0u ? cnt : 1u;
}

__device__ __forceinline__ void xcd_barrier(const XcdBarrier& b) {
    asm volatile("s_waitcnt vmcnt(0)" ::: "memory");
    __syncthreads();
    if (threadIdx.x == 0) {
        unsigned* bar = b.bar;
        __builtin_amdgcn_s_waitcnt(0);
        unsigned nloc = b.st[0], nx = b.st[1];
        if (nloc == 0u) { xcd_barrier_complete(bar, b.x, nloc, nx); b.st[0] = nloc; b.st[1] = nx; }
        const unsigned old = xb_add(&bar[XB_XSUB(b.x)], 1u);
        const unsigned gen = old / nloc;
        if (old + 1u == (gen + 1u) * nloc) {
            __builtin_amdgcn_fence(__ATOMIC_RELEASE, "agent");
            asm volatile("s_waitcnt vmcnt(0)" ::: "memory");
            const unsigned og = xb_add(&bar[XB_TOP], 1u);
            const unsigned tg = og / nx;
            if (og + 1u == (tg + 1u) * nx) xb_add(&bar[XB_TOPGEN], 1u);
            else XB_SPIN(xb_ld(&bar[XB_TOPGEN]) == tg, bar);
            __builtin_amdgcn_fence(__ATOMIC_ACQUIRE, "agent");
            xb_add(&bar[XB_XGEN(b.x)], 1u);
            asm volatile("s_waitcnt vmcnt(0)" ::: "memory");
        } else {
            XB_SPIN(xb_ld(&bar[XB_XGEN(b.x)]) == gen, bar);
            __builtin_amdgcn_fence(__ATOMIC_ACQUIRE, "agent");
            asm volatile("s_waitcnt vmcnt(0)" ::: "memory");
        }
    }
    __syncthreads();
}

constexpr int NPHASES = 2 + 2 * 12;
#ifndef PROBE_DUP
#define PROBE_DUP (-1)
#endif
__global__ void __launch_bounds__(NTHREADS, 2) hybrid_step_megakernel(Params p) {
    extern __shared__ __attribute__((aligned(16))) unsigned char lds[];
    cg::grid_group grid = cg::this_grid();
    if (threadIdx.x < 34) ((LAS cfp_t*)(lds + LDS_TAB))[threadIdx.x] = (cfp_t)p.in[threadIdx.x];
    __syncthreads();
    volatile LAS unsigned* bst = (volatile LAS unsigned*)(lds + LDS_TAB + 512);
    XcdBarrier xbar; xbar.bar = nullptr; xbar.x = 0; xbar.st = bst;
#pragma unroll 1
    for (int pi = 0; pi < NPHASES + (PROBE_DUP >= 0 ? 1 : 0); ++pi) {
        const int ph = (PROBE_DUP >= 0 && pi > PROBE_DUP) ? pi - 1 : pi; const bool rep = PROBE_DUP >= 0 && pi == PROBE_DUP + 1;
        const int l = ph < 2 ? 0 : (ph - 2) / 12, k = ph < 2 ? ph : 2 + (ph - 2) % 12;
#define FRAME() int zv, zs; asm volatile("v_mov_b32 %0, 0" : "=v"(zv)); asm volatile("s_mov_b32 %0, 0" : "=s"(zs)); Frame F; \
        F.lds = lds; F.ws = p.ws + zs; F.out = p.out + zs; F.in = (const LAS cfp_t*)(lds + LDS_TAB); \
        F.tid = threadIdx.x + zv; F.lane = F.tid & 63; F.wave = __builtin_amdgcn_readfirstlane(F.tid >> 6); \
        F.G = gridDim.x; F.bid = blockIdx.x + zs; F.vcu = (F.bid % 8) * (F.G / 8) + F.bid / 8;
        switch (k) {
            case 0: { FRAME(); if (F.bid == 0) { for (int i = F.tid; i < XCD_BAR_WORDS; i += NTHREADS) ((unsigned*)(F.ws + WS_CTL))[i] = 0u; } phase0_mod_rope(F); convert_weights(F, 0); } break;
            case 1: { FRAME(); phase0_h(F); } break;
            case 2: { FRAME(); phase_g1(F, l); } break;
            case 3: { FRAME(); phase_rnn_prep(F, l, !rep); } break;
            case 4: { FRAME(); phase_g2(F); } break;
            case 5: { FRAME(); phase_mla(F); } break;
            case 6: { FRAME(); phase_g3(F, l); } break;
            case 7: { FRAME(); phase_diff(F, l); } break;
            case 8: { FRAME(); phase_g4(F, 0); } break;
            case 9: { FRAME(); phase_g5(F, 0); } break;
            case 10: { FRAME(); phase_g4(F, 1); } break;
            case 11: { FRAME(); phase_g5(F, 1); } break;
            case 12: { FRAME(); phase_g6(F); } break;
            default: { FRAME(); phase_post(F, l); if (l == 0) convert_weights(F, 1); } break;
        }
#undef FRAME
        if (pi == 0) {
            grid.sync();
            if (threadIdx.x == 0) { bst[0] = 0u; bst[1] = 0u; }
            __syncthreads();
            xbar = xcd_barrier_post((unsigned*)(p.ws + WS_CTL), bst);
        } else if (pi + 1 < NPHASES + (PROBE_DUP >= 0 ? 1 : 0)) xcd_barrier(xbar);
    }
}

extern "C" void kernel_launch(void* const* d_in, const int* in_sizes, int n_in, void* d_out, int out_size, void* d_ws, size_t ws_size, hipStream_t stream) {
    static int grid = 0;
    if (grid == 0) {
        if (n_in != 34 || out_size != (int)O_TOTAL || ws_size < WS_END) { fprintf(stderr, "kernel_launch: unexpected shapes: n_in %d out %d ws %zu (need >= %zu)\n", n_in, out_size, ws_size, (size_t)WS_END); grid = -1; return; }
        int dev = 0, cus = 0, per_cu = 0;
        if (hipGetDevice(&dev) != hipSuccess || hipDeviceGetAttribute(&cus, hipDeviceAttributeMultiprocessorCount, dev) != hipSuccess) { grid = -1; return; }
        if (hipFuncSetAttribute((const void*)hybrid_step_megakernel, hipFuncAttributeMaxDynamicSharedMemorySize, LDS_BYTES) != hipSuccess) { fprintf(stderr, "kernel_launch: hipFuncSetAttribute failed\n"); grid = -1; return; }
        if (hipOccupancyMaxActiveBlocksPerMultiprocessor(&per_cu, (const void*)hybrid_step_megakernel, NTHREADS, LDS_BYTES) != hipSuccess || per_cu < 1) { fprintf(stderr, "kernel_launch: occupancy query says %d blocks/CU\n", per_cu); per_cu = 1; }
        (void)hipGetLastError();
        grid = cus;
        if (grid != 256) fprintf(stderr, "kernel_launch: %d CUs (expected 256)\n", grid);
    }
    if (grid < 0) return;
    Params p{};
    for (int i = 0; i < 34; ++i) p.in[i] = (const float*)d_in[i];
    p.out = (float*)d_out; p.ws = (unsigned char*)d_ws;
    void* args[] = {&p};
    hipError_t e = hipLaunchCooperativeKernel((const void*)hybrid_step_megakernel, dim3(grid), dim3(NTHREADS), args, LDS_BYTES, stream);
    if (e != hipSuccess) fprintf(stderr, "kernel_launch: cooperative launch failed: %s (grid %d)\n", hipGetErrorString(e), grid);
}
```

```cpp
#include <hip/hip_runtime.h>
#include <hip/hip_cooperative_groups.h>
#include <cstdio>
#include <cstdint>
namespace cg = cooperative_groups;

#define LAS __attribute__((address_space(3)))
typedef unsigned short bf16_t;
typedef short bf16x8 __attribute__((ext_vector_type(8)));
typedef short s16x4 __attribute__((ext_vector_type(4)));
typedef float f32x2 __attribute__((ext_vector_type(2)));
typedef float f32x4 __attribute__((ext_vector_type(4)));
typedef float f32x16 __attribute__((ext_vector_type(16)));
typedef unsigned u32x2 __attribute__((ext_vector_type(2)));
typedef unsigned u32x4 __attribute__((ext_vector_type(4)));
typedef __bf16 bf16x2_t __attribute__((ext_vector_type(2)));

constexpr int DM = 1024, NP = 8192, ND = 16384, NTOK = 24576, NKV = 28672, HALF_TOK = 12288;
constexpr int IN_COLS = 7328;
constexpr float EPS = 1e-6f;
constexpr float LOG2E = 1.4426950408889634f;
constexpr float SCALE_M = 0.10206207261596577f * LOG2E;
constexpr float SCALE_D = 0.125f * LOG2E;
constexpr size_t O_Y = 0, O_CKV = 25165824, O_KR = 29360128, O_DK = 29884416, O_DV = 38273024, O_ST = 46661632, O_TOTAL = 46727168;

constexpr size_t MiB = 1u << 20;
constexpr size_t WS_CTL = 0;
constexpr size_t CTL_MOD = 64 * 1024;
constexpr size_t CTL_ROPE = 320 * 1024;
constexpr size_t CTL_SSQ = 1 * MiB;
constexpr size_t WS_W = 3 * MiB;
constexpr size_t W_IN = 0;
constexpr size_t W_UQ = W_IN + (size_t)7424 * 1024 * 2;
constexpr size_t W_UKV = W_UQ + (size_t)768 * 384 * 2;
constexpr size_t W_BR = W_UKV + (size_t)1024 * 256 * 2;
constexpr size_t W_OUT = W_BR + (size_t)3072 * 512 * 2;
constexpr size_t W_RG = W_OUT + (size_t)1024 * 1024 * 2;
constexpr size_t W_END = W_RG + (size_t)32 * 4096 * 2;
static_assert(W_END <= 21 * MiB, "weight region");
constexpr size_t WS_H = 24 * MiB;
constexpr size_t WS_Y = 72 * MiB;
constexpr size_t Y_SLOT = (size_t)NTOK * 512 * 2;
constexpr size_t WS_A = 144 * MiB;
constexpr size_t A_CKV = 0;
constexpr size_t A_KR = 14 * MiB;
constexpr size_t A_Q = 16 * MiB;
constexpr size_t A_KV = 52 * MiB;
constexpr size_t A_DQ = 0;
constexpr size_t A_DK = 24 * MiB;
constexpr size_t A_DV = 52 * MiB;
constexpr size_t A_G = 0;
constexpr size_t A_O = 0;
constexpr size_t WS_END = 256 * MiB;
static_assert(A_KV + (size_t)NKV * 1024 * 2 <= 112 * MiB, "A region");

constexpr int LDS_BYTES = 147456;
constexpr int NTHREADS = 512;

struct Params { const float* in[34]; float* out; unsigned char* ws; };

__device__ __forceinline__ unsigned pk2(float lo, float hi) { f32x2 v = {lo, hi}; bf16x2_t b = __builtin_convertvector(v, bf16x2_t); return __builtin_bit_cast(unsigned, b); }
__device__ __forceinline__ float bflo(unsigned w) { return __uint_as_float(w << 16); }
__device__ __forceinline__ float bfhi(unsigned w) { return __uint_as_float(w & 0xffff0000u); }
__device__ __forceinline__ float bf2f(bf16_t x) { return __uint_as_float(((unsigned)x) << 16); }
__device__ __forceinline__ u32x4 pack8(const float* v) { u32x4 w; w.x = pk2(v[0], v[1]); w.y = pk2(v[2], v[3]); w.z = pk2(v[4], v[5]); w.w = pk2(v[6], v[7]); return w; }
__device__ __forceinline__ void unpack8(u32x4 w, float* v) { v[0] = bflo(w.x); v[1] = bfhi(w.x); v[2] = bflo(w.y); v[3] = bfhi(w.y); v[4] = bflo(w.z); v[5] = bfhi(w.z); v[6] = bflo(w.w); v[7] = bfhi(w.w); }
__device__ __forceinline__ float wave_sum(float v) {
#pragma unroll
    for (int o = 1; o < 64; o <<= 1) v += __shfl_xor(v, o);
    return v;
}
__device__ __forceinline__ float sigmoidf_(float x) { return 1.0f / (1.0f + __expf(-x)); }
__device__ __forceinline__ float siluf_(float x) { return x / (1.0f + __expf(-x)); }
__device__ __forceinline__ int kvrow_of(int r) { return r < NP ? r : NP + ((r - NP) >> 11) * 2560 + 512 + ((r - NP) & 2047); }
__device__ __forceinline__ int grp_of(int r) { return r < NP ? 0 : 1 + ((r - NP) >> 11); }
__device__ __forceinline__ int cache_row(int r, int l) { return r + 256 * ((r >> 8) + l); }
__device__ __forceinline__ int tid_now() { int t = threadIdx.x; asm volatile("; tid" : "+v"(t)); return t; }
namespace pg8 {
#define PG8_LAS __attribute__((address_space(3)))
constexpr int BM = 256, BK = 64, HALF = 128, HTB = HALF * BK * 2  , STAGE_BYTES = 8 * HTB, NXCD = 8, WGM = 8;
__host__ __device__ __forceinline__ int lds_byte(int r, int c) { const int st = (r >> 4) * 2 + (c >> 5), rr = r & 15, cc = c & 31, ob = rr * 64 + cc * 2; return st * 1024 + (ob ^ (((ob >> 9) & 1) << 5)); }
__host__ __device__ __forceinline__ void stage_rc(int b, int& R, int& C) { const int st = b / 1024, sb = b % 1024, swz = sb ^ (((sb >> 9) & 1) << 5); R = (st >> 1) * 16 + swz / 64; C = (st & 1) * 32 + (swz % 64) / 2; }
__host__ __device__ __forceinline__ int perm32(int rho) { const int n = rho >> 4, i = rho & 15; return 8 * (i >> 2) + 4 * n + (i & 3); }
struct Unit { int pm, pn; };
struct Gemm { const bf16_t* A; const bf16_t* Bt; int M, N, K; };
struct StaticOrder {
    int nM, nN, nwg, G, c;
    __host__ __device__ void init(int M, int N, int G_, int c_) { nM = M / BM; nN = N / BM; nwg = nM * nN; G = G_; c = c_; }
    __host__ __device__ bool next(int i, Unit& u) const {
        const long L = (long)i * G + c; if (L >= nwg) return false;
        int wgid = (int)L; { const int q = nwg / NXCD, r = nwg % NXCD, xcd = wgid % NXCD, off = wgid / NXCD; wgid = (xcd < r ? xcd * (q + 1) : r * (q + 1) + (xcd - r) * q) + off; }
        const int nig = WGM * nN, gid = wgid / nig, fm = gid * WGM, gsz = (nM - fm) < WGM ? (nM - fm) : WGM;
        u.pm = fm + ((wgid % nig) % gsz); u.pn = (wgid % nig) / gsz; return true;
    }
    __device__ __forceinline__ void a_ready(const Unit&) const {}
    __device__ __forceinline__ void done(const Unit&) const {}
};
template <class Epi, class Sched, bool ALIGN_EPI = false, bool SP2 = false>
__device__ __forceinline__ void gemm_phase(PG8_LAS unsigned char* lds, const Gemm g, const Sched& S, const Epi& E) {
    const int tid = tid_now(), wid = __builtin_amdgcn_readfirstlane(tid >> 6), lane = tid & 63, wr = wid >> 2, wc = wid & 3, fr = lane & 15, fq = lane >> 4;
    const int K = g.K, nt = K / BK;
    unsigned voffA[2], voffB[2];
#pragma unroll
    for (int i = 0; i < 2; ++i) { int R, C; stage_rc(tid * 16 + i * 8192, R, C); const int Rb = Epi::PERM ? ((R & ~31) + perm32(R & 31)) : R;
        voffA[i] = (unsigned)(R * K + C) * 2u; voffB[i] = (unsigned)(Rb * K + C) * 2u; }
    const size_t kstep = (size_t)(BK * 2);
    const size_t hstep = (size_t)HALF * K * 2;
    const size_t tstep = 2 * hstep;
    const unsigned ldsw = (unsigned)wid * 1024u;
    const int aoff = lds_byte(wr * 64 + fr, fq * 8), boff = lds_byte(wc * 32 + fr, fq * 8);
#define PG8_SA(b, h) (((b) * 2 + (h)) * HTB)
#define PG8_SB(b, h) ((4 + (b) * 2 + (h)) * HTB)
#define PG8_STAGE(bufoff, gbase, voff) do { _Pragma("unroll") for (int _i = 0; _i < 2; ++_i) \
        __builtin_amdgcn_global_load_lds((const unsigned*)((const char*)(gbase) + (voff)[_i]), (PG8_LAS unsigned*)(lds + (bufoff) + ldsw + _i * 8192), 16, 0, 0); } while (0)
#define PG8_LDA(dst, b, h) do { _Pragma("unroll") for (int m = 0; m < 4; ++m) _Pragma("unroll") for (int k = 0; k < 2; ++k) dst[m][k] = *(const PG8_LAS bf16x8*)(lds + PG8_SA(b, h) + aoff + m * 2048 + k * 1024); } while (0)
#define PG8_LDB(dst, b, h) do { _Pragma("unroll") for (int n = 0; n < 2; ++n) _Pragma("unroll") for (int k = 0; k < 2; ++k) dst[n][k] = *(const PG8_LAS bf16x8*)(lds + PG8_SB(b, h) + boff + n * 2048 + k * 1024); } while (0)
#define PG8_MMA(ai, bj, At, Bt) do { __builtin_amdgcn_s_setprio(1); _Pragma("unroll") for (int m = 0; m < 4; ++m) _Pragma("unroll") for (int n = 0; n < 2; ++n) _Pragma("unroll") for (int k = 0; k < 2; ++k) \
        acc[ai][bj][m][n] = __builtin_amdgcn_mfma_f32_16x16x32_bf16(Bt[n][k], At[m][k], acc[ai][bj][m][n], 0, 0, 0); __builtin_amdgcn_s_setprio(0); } while (0)
#define PG8_WAIT_V(n) asm volatile("s_waitcnt vmcnt(" #n ")" ::: "memory")
#define PG8_WAIT_L(n) asm volatile("s_waitcnt lgkmcnt(" #n ")" ::: "memory")
#define PG8_BAR __builtin_amdgcn_s_barrier()
#define PG8_SCHED __builtin_amdgcn_sched_barrier(0)
    Unit cur, nxt; int ui = 0;
    if (!S.next(0, cur)) return;
    f32x4 acc[2][2][4][2];
#pragma unroll
    for (int a = 0; a < 2; ++a)
#pragma unroll
        for (int b = 0; b < 2; ++b)
#pragma unroll
            for (int m = 0; m < 4; ++m)
#pragma unroll
                for (int n = 0; n < 2; ++n) acc[a][b][m][n] = (f32x4){0.f, 0.f, 0.f, 0.f};
    bf16x8 At[4][2], B0[2][2], B1[2][2];
    const char* cA = (const char*)g.A + (size_t)cur.pm * tstep; const char* cB = (const char*)g.Bt + (size_t)cur.pn * tstep;
    S.a_ready(cur);
    if constexpr (SP2) {
        PG8_STAGE(PG8_SB(0, 0), cB, voffB); PG8_STAGE(PG8_SB(0, 1), cB + hstep, voffB); PG8_STAGE(PG8_SA(0, 0), cA, voffA); PG8_STAGE(PG8_SA(0, 1), cA + hstep, voffA);
        if (wr == 1) PG8_BAR;
        PG8_WAIT_V(2); PG8_BAR;
        PG8_STAGE(PG8_SB(1, 0), cB + kstep, voffB); PG8_STAGE(PG8_SA(1, 0), cA + kstep, voffA); PG8_STAGE(PG8_SB(1, 1), cB + hstep + kstep, voffB);
        PG8_WAIT_V(6); PG8_BAR;
    } else {
        PG8_STAGE(PG8_SB(0, 0), cB, voffB); PG8_STAGE(PG8_SA(0, 0), cA, voffA); PG8_STAGE(PG8_SB(0, 1), cB + hstep, voffB); PG8_STAGE(PG8_SA(0, 1), cA + hstep, voffA);
        if (wr == 1) PG8_BAR;
        PG8_WAIT_V(4); PG8_BAR;
        PG8_STAGE(PG8_SB(1, 0), cB + kstep, voffB); PG8_STAGE(PG8_SA(1, 0), cA + kstep, voffA); PG8_STAGE(PG8_SB(1, 1), cB + hstep + kstep, voffB);
        PG8_WAIT_V(6); PG8_BAR;
    }
    for (;;) {
        const bool has_next = S.next(ui + 1, nxt);
        const char* nA = has_next ? (const char*)g.A + (size_t)nxt.pm * tstep : cA; const char* nB = has_next ? (const char*)g.Bt + (size_t)nxt.pn * tstep : cB;
#pragma unroll 1
        for (int t = 0; t < nt; t += 2) {
            const bool last = (t == nt - 2);
            const char* a1 = cA + (size_t)(t + 1) * kstep;
            const char* a2 = last ? nA : cA + (size_t)(t + 2) * kstep; const char* b2 = last ? nB : cB + (size_t)(t + 2) * kstep;
            const char* a3 = a2 + kstep; const char* b3 = b2 + kstep;
            if (last && has_next) S.a_ready(nxt);
            if constexpr (SP2) {
            PG8_LDB(B0, 0, 0); PG8_LDB(B1, 0, 1); PG8_SCHED; PG8_LDA(At, 0, 0); PG8_STAGE(PG8_SA(1, 1), a1 + hstep, voffA);
            PG8_WAIT_V(8); PG8_WAIT_L(0); PG8_BAR; PG8_MMA(0, 0, At, B0); PG8_MMA(0, 1, At, B1); PG8_BAR; PG8_SCHED;
            PG8_LDA(At, 0, 1); PG8_STAGE(PG8_SB(0, 0), b2, voffB); PG8_STAGE(PG8_SB(0, 1), b2 + hstep, voffB); PG8_STAGE(PG8_SA(0, 0), a2, voffA);
            PG8_WAIT_V(8); PG8_WAIT_L(0); PG8_BAR; PG8_MMA(1, 0, At, B0); PG8_MMA(1, 1, At, B1); PG8_BAR; PG8_SCHED;
            PG8_LDB(B0, 1, 0); PG8_LDB(B1, 1, 1); PG8_SCHED; PG8_LDA(At, 1, 0); PG8_STAGE(PG8_SA(0, 1), a2 + hstep, voffA);
            PG8_WAIT_V(8); PG8_WAIT_L(0); PG8_BAR; PG8_MMA(0, 0, At, B0); PG8_MMA(0, 1, At, B1); PG8_BAR; PG8_SCHED;
            PG8_LDA(At, 1, 1); PG8_STAGE(PG8_SB(1, 0), b3, voffB); PG8_STAGE(PG8_SB(1, 1), b3 + hstep, voffB); PG8_STAGE(PG8_SA(1, 0), a3, voffA);
            PG8_WAIT_V(8); PG8_WAIT_L(0); PG8_BAR; PG8_MMA(1, 0, At, B0); PG8_MMA(1, 1, At, B1); PG8_BAR; PG8_SCHED;
            } else {
            PG8_LDB(B0, 0, 0); PG8_SCHED; PG8_LDA(At, 0, 0); PG8_STAGE(PG8_SA(1, 1), a1 + hstep, voffA);
            PG8_WAIT_L(8); PG8_BAR; PG8_WAIT_L(0); PG8_MMA(0, 0, At, B0); PG8_BAR; PG8_SCHED;
            PG8_LDB(B1, 0, 1); PG8_STAGE(PG8_SB(0, 0), b2, voffB);
            PG8_BAR; PG8_WAIT_L(0); PG8_MMA(0, 1, At, B1); PG8_BAR;
            PG8_LDA(At, 0, 1); PG8_STAGE(PG8_SA(0, 0), a2, voffA);
            PG8_BAR; PG8_WAIT_L(0); PG8_MMA(1, 0, At, B0); PG8_BAR; PG8_SCHED;
            PG8_STAGE(PG8_SB(0, 1), b2 + hstep, voffB);
            PG8_WAIT_V(6); PG8_BAR; PG8_MMA(1, 1, At, B1); PG8_BAR;
            PG8_LDB(B0, 1, 0); PG8_SCHED; PG8_LDA(At, 1, 0); PG8_STAGE(PG8_SA(0, 1), a2 + hstep, voffA);
            PG8_WAIT_L(8); PG8_BAR; PG8_WAIT_L(0); PG8_MMA(0, 0, At, B0); PG8_BAR; PG8_SCHED;
            PG8_LDB(B1, 1, 1); PG8_STAGE(PG8_SB(1, 0), b3, voffB);
            PG8_BAR; PG8_WAIT_L(0); PG8_MMA(0, 1, At, B1); PG8_BAR;
            PG8_LDA(At, 1, 1); PG8_STAGE(PG8_SA(1, 0), a3, voffA);
            PG8_BAR; PG8_WAIT_L(0); PG8_MMA(1, 0, At, B0); PG8_BAR; PG8_SCHED;
            PG8_STAGE(PG8_SB(1, 1), b3 + hstep, voffB);
            PG8_WAIT_V(6); PG8_BAR; PG8_MMA(1, 1, At, B1); PG8_BAR;
            }
        }
        if constexpr (ALIGN_EPI) { if (wr == 0) PG8_BAR; }
        bool rst_ = true; if constexpr (!Epi::AFTER_DRAIN) { rst_ = E(acc, cur, wr, wc, fr, fq); S.done(cur); }
        if (!has_next) break;
        if (rst_) {
#pragma unroll
        for (int a = 0; a < 2; ++a)
#pragma unroll
            for (int b = 0; b < 2; ++b)
#pragma unroll
                for (int m = 0; m < 4; ++m)
#pragma unroll
                    for (int n = 0; n < 2; ++n) acc[a][b][m][n] = (f32x4){0.f, 0.f, 0.f, 0.f};
        }
        cur = nxt; cA = nA; cB = nB; ++ui;
        if constexpr (ALIGN_EPI) { if (wr == 1) PG8_BAR; }
    }
    PG8_WAIT_V(0);
    if constexpr (!ALIGN_EPI) { if (wr == 0) PG8_BAR; }
    PG8_BAR;
    if constexpr (Epi::AFTER_DRAIN) { E.fused(acc, cur, wr, wc, fr, fq, lds, wid, lane); S.done(cur); }
#undef PG8_SA
#undef PG8_SB
#undef PG8_STAGE
#undef PG8_LDA
#undef PG8_LDB
#undef PG8_MMA
#undef PG8_WAIT_V
#undef PG8_WAIT_L
#undef PG8_BAR
#undef PG8_SCHED
}
}
using pg8::Unit;
#define EPI_ROWS_BEGIN _Pragma("unroll") for (int ai = 0; ai < 2; ++ai) _Pragma("unroll") for (int m = 0; m < 4; ++m) { const int row = u.pm * 256 + ai * 128 + wr * 64 + m * 16 + fr;
#define EPI_COLS_BEGIN _Pragma("unroll") for (int bj = 0; bj < 2; ++bj) { const int col = u.pn * 256 + bj * 128 + wc * 32 + 8 * fq; \
    float v[8]; { const f32x4 a0 = acc[ai][bj][m][0], a1 = acc[ai][bj][m][1]; v[0] = a0[0]; v[1] = a0[1]; v[2] = a0[2]; v[3] = a0[3]; v[4] = a1[0]; v[5] = a1[1]; v[6] = a1[2]; v[7] = a1[3]; }
#define EPI_END } asm volatile("" ::: "memory"); }
__device__ __forceinline__ void st_bf16x8(bf16_t* p, const float* v) { *(u32x4*)p = pack8(v); }
__device__ __forceinline__ void st_f32x8(float* p, const float* v) { *(f32x4*)p = (f32x4){v[0], v[1], v[2], v[3]}; *(f32x4*)(p + 4) = (f32x4){v[4], v[5], v[6], v[7]}; }

template <int XL> __device__ __forceinline__ void rope8(float* v, bool second, const float* cs, const float* sn) {
    const f32x4 c0 = *(const f32x4*)cs, c1 = *(const f32x4*)(cs + 4), s0 = *(const f32x4*)sn, s1 = *(const f32x4*)(sn + 4);
    const float c[8] = {c0[0], c0[1], c0[2], c0[3], c1[0], c1[1], c1[2], c1[3]}, s[8] = {s0[0], s0[1], s0[2], s0[3], s1[0], s1[1], s1[2], s1[3]};
#pragma unroll
    for (int i = 0; i < 8; ++i) { const float p = __shfl_xor(v[i], XL); v[i] = v[i] * c[i] + (second ? p : -p) * s[i]; }
}

struct EpiG1 {
    static constexpr bool PERM = true, AFTER_DRAIN = false;
    bf16_t *RX, *CQ, *CKV, *KR; float* okr; const float* rope; int l;
    __device__ __forceinline__ bool operator()(f32x4 (&acc)[2][2][4][2], const Unit& u, int wr, int wc, int fr, int fq) const {
        const bool dec = u.pm >= 32;
        EPI_ROWS_BEGIN
            const int kvr = kvrow_of(row);
            EPI_COLS_BEGIN
                if (col < 512) st_bf16x8(RX + (size_t)row * 512 + col, v);
                else if (col < 896) st_bf16x8(CQ + (size_t)row * 384 + (col - 512), v);
                else if (col < 1152) st_bf16x8(CKV + (size_t)kvr * 256 + (col - 896), v);
                else if (col < 1184) {
                    const int e = col - 1152;
                    if (dec) { const int t = (row - NP) & 2047, pos = (fq & 2) ? (t & 63) : (t >> 6);
                        rope8<16>(v, (fq & 1) != 0, rope + pos * 8, rope + 512 + pos * 8); }
                    else st_f32x8(okr + (size_t)cache_row(row, l) * 32 + e, v);
                    st_bf16x8(KR + (size_t)kvr * 32 + e, v);
                }
            EPI_END
        return true;
    }
};
struct EpiQ {
    static constexpr bool PERM = true, AFTER_DRAIN = false;
    bf16_t* Q; const float* rope;
    __device__ __forceinline__ bool operator()(f32x4 (&acc)[2][2][4][2], const Unit& u, int wr, int wc, int fr, int fq) const {
        const bool dec = u.pm >= 32;
        EPI_ROWS_BEGIN
            EPI_COLS_BEGIN
                const int g32 = col >> 5;
                if (dec && (g32 % 3) == 2) { const int t = (row - NP) & 2047, pos = (fq & 2) ? (t & 63) : (t >> 6);
                    rope8<16>(v, (fq & 1) != 0, rope + pos * 8, rope + 512 + pos * 8); }
#pragma unroll
                for (int i = 0; i < 8; ++i) v[i] *= SCALE_M;
                st_bf16x8(Q + (size_t)row * 768 + col, v);
            EPI_END
        return true;
    }
};
struct EpiPlain {
    static constexpr bool PERM = true, AFTER_DRAIN = false;
    bf16_t* O; int ldc;
    __device__ __forceinline__ bool operator()(f32x4 (&acc)[2][2][4][2], const Unit& u, int wr, int wc, int fr, int fq) const {
        EPI_ROWS_BEGIN
            EPI_COLS_BEGIN
                st_bf16x8(O + (size_t)row * ldc + col, v);
            EPI_END
        return true;
    }
};
struct EpiG3 {
    static constexpr bool PERM = true, AFTER_DRAIN = false;
    bf16_t *DQ, *DK, *DV; float *odk, *odv; const float* rope; int l;
    __device__ __forceinline__ bool operator()(f32x4 (&acc)[2][2][4][2], const Unit& u, int wr, int wc, int fr, int fq) const {
        const bool dec = u.pm >= 32;
        EPI_ROWS_BEGIN
            const int kvr = kvrow_of(row);
            EPI_COLS_BEGIN
                if (col < 1024) {
                    if (dec) { const int t = (row - NP) & 2047, pos = ((col >> 5) & 1) ? (t & 63) : (t >> 6);
                        rope8<32>(v, (fq & 2) != 0, rope + pos * 16 + (fq & 1) * 8, rope + 1024 + pos * 16 + (fq & 1) * 8); }
                    if (col < 512) {
#pragma unroll
                        for (int i = 0; i < 8; ++i) v[i] *= SCALE_D;
                        st_bf16x8(DQ + (size_t)row * 512 + col, v);
                    } else {
                        if (!dec) st_f32x8(odk + (size_t)cache_row(row, l) * 512 + (col - 512), v);
                        st_bf16x8(DK + (size_t)kvr * 512 + (col - 512), v);
                    }
                } else {
                    if (!dec) st_f32x8(odv + (size_t)cache_row(row, l) * 512 + (col - 1024), v);
                    st_bf16x8(DV + (size_t)kvr * 512 + (col - 1024), v);
                }
            EPI_END
        return true;
    }
};
struct EpiG4 {
    static constexpr bool PERM = true, AFTER_DRAIN = false;
    bf16_t* Y; unsigned char* G;
    __device__ __forceinline__ bool operator()(f32x4 (&acc)[2][2][4][2], const Unit& u, int wr, int wc, int fr, int fq) const {
        EPI_ROWS_BEGIN
            EPI_COLS_BEGIN
                if (col < 1536) {
                    const int slot = col >> 9, cc = col & 511;
                    bf16_t* p = Y + (size_t)slot * ((size_t)NTOK * 512) + (size_t)row * 512 + cc;
                    float pre[8]; unpack8(*(const u32x4*)p, pre);
#pragma unroll
                    for (int i = 0; i < 8; ++i) v[i] = pre[i] * siluf_(v[i]);
                    st_bf16x8(p, v);
                } else {
                    unsigned q[8];
#pragma unroll
                    for (int i = 0; i < 8; ++i) q[i] = (unsigned)(255.0f * sigmoidf_(v[i]) + 0.5f);
                    u32x2 w; w.x = q[0] | (q[1] << 8) | (q[2] << 16) | (q[3] << 24); w.y = q[4] | (q[5] << 8) | (q[6] << 16) | (q[7] << 24);
                    *(u32x2*)(G + (size_t)row * 3072 + (col - 1536)) = w;
                }
            EPI_END
        return true;
    }
};
struct EpiG5 {
    static constexpr bool PERM = true, AFTER_DRAIN = false;
    const unsigned char* G; bf16_t* MG;
    __device__ __forceinline__ bool operator()(f32x4 (&acc)[2][2][4][2], const Unit& u, int wr, int wc, int fr, int fq) const {
        const int br = u.pn >> 2, pn = u.pn & 3, pm = u.pm - br * 96;
#pragma unroll
        for (int ai = 0; ai < 2; ++ai)
#pragma unroll
            for (int m = 0; m < 4; ++m) { const int row = pm * 256 + ai * 128 + wr * 64 + m * 16 + fr;
#pragma unroll
                for (int bj = 0; bj < 2; ++bj) { const int col = pn * 256 + bj * 128 + wc * 32 + 8 * fq;
                    const u32x2 w0 = *(const u32x2*)(G + (size_t)row * 3072 + br * 1024 + col);
                    float f[8];
#pragma unroll
                    for (int i = 0; i < 8; ++i) f[i] = fmaxf((float)(((i < 4 ? w0.x : w0.y) >> (8 * (i & 3))) & 255u), 0.25f);
                    if (br < 2) { const u32x2 w1 = *(const u32x2*)(G + (size_t)row * 3072 + (br + 1) * 1024 + col);
#pragma unroll
                        for (int i = 0; i < 8; ++i) f[i] = f[i] * __builtin_amdgcn_rcpf(fmaxf((float)(((i < 4 ? w1.x : w1.y) >> (8 * (i & 3))) & 255u), 0.25f));
                    } else {
#pragma unroll
                        for (int i = 0; i < 8; ++i) f[i] *= (1.0f / 255.0f);
                    }
                    f32x4& a0 = acc[ai][bj][m][0]; f32x4& a1 = acc[ai][bj][m][1];
                    a0[0] *= f[0]; a0[1] *= f[1]; a0[2] *= f[2]; a0[3] *= f[3]; a1[0] *= f[4]; a1[1] *= f[5]; a1[2] *= f[6]; a1[3] *= f[7];
                    if (br == 2) { const float v[8] = {a0[0], a0[1], a0[2], a0[3], a1[0], a1[1], a1[2], a1[3]};
                        st_bf16x8(MG + (size_t)row * 1024 + col, v); }
                }
                asm volatile("" ::: "memory"); }
        return br == 2;
    }
};
struct EpiG6 {
    static constexpr bool PERM = true, AFTER_DRAIN = false;
    bf16_t* O; float* ssq;
    __device__ __forceinline__ bool operator()(f32x4 (&acc)[2][2][4][2], const Unit& u, int wr, int wc, int fr, int fq) const {
        EPI_ROWS_BEGIN
            float s = 0.f;
            EPI_COLS_BEGIN
#pragma unroll
                for (int i = 0; i < 8; ++i) s += v[i] * v[i];
                st_bf16x8(O + (size_t)row * 1024 + col, v);
            }
            s += __shfl_xor(s, 16); s += __shfl_xor(s, 32);
            if (fq == 0) ssq[(size_t)row * 16 + u.pn * 4 + wc] = s;
        }
        return true;
    }
};
namespace att {
#define SBAR() __builtin_amdgcn_sched_barrier(0)
__device__ __forceinline__ int crow(int r, int hi) { return (r & 3) + 8 * (r >> 2) + 4 * hi; }
template <int DQK> __device__ __forceinline__ int kswz(int row, int chunk) {
    if constexpr (DQK == 64) return row * 128 + ((chunk ^ ((row >> 1) & 7)) << 4);
    else return row * 256 + ((chunk ^ (row & 15)) << 4);
}
template <int DQK> struct KTile { static constexpr int BYTES = DQK == 64 ? 8192 : 16384; };
template <int DV> __device__ __forceinline__ int v_st(int k, int c) { return ((k >> 3) * (DV / 32) + (c >> 5)) * 512 + ((k & 7) * 32 + (c & 31)) * 2; }
__device__ __forceinline__ int v_rd_base(int lane) { return ((lane >> 4) & 1) * 32 + (lane & 3) * 8 + (4 * (lane >> 5) + ((lane & 15) >> 2)) * 64; }
template <int OFF> __device__ __forceinline__ s16x4 tr_read(int vb) {
    s16x4 r; asm volatile("ds_read_b64_tr_b16 %0, %1 offset:%2" : "=&v"(r) : "v"(vb), "i"(OFF) : "memory"); return r;
}
template <int DV, int D0> __device__ __forceinline__ void pv_one(f32x16& od, int vb, bf16x8 pa0, bf16x8 pa1, bf16x8 pa2, bf16x8 pa3) {
    constexpr int NB = DV / 32;
#define VOFF(ks, half) (D0 * 4096 + (ks) * 1024 + (half) * 512)
    const s16x4 l0 = tr_read<VOFF(0, 0)>(vb), h0 = tr_read<VOFF(0, 1)>(vb), l1 = tr_read<VOFF(1, 0)>(vb), h1 = tr_read<VOFF(1, 1)>(vb);
    const s16x4 l2 = tr_read<VOFF(2, 0)>(vb), h2 = tr_read<VOFF(2, 1)>(vb), l3 = tr_read<VOFF(3, 0)>(vb), h3 = tr_read<VOFF(3, 1)>(vb);
#undef VOFF
    asm volatile("s_waitcnt lgkmcnt(0)" ::: "memory"); SBAR();
#define PK(L, H) (bf16x8){L[0], L[1], L[2], L[3], H[0], H[1], H[2], H[3]}
    od = __builtin_amdgcn_mfma_f32_32x32x16_bf16(pa0, PK(l0, h0), od, 0, 0, 0);
    od = __builtin_amdgcn_mfma_f32_32x32x16_bf16(pa1, PK(l1, h1), od, 0, 0, 0);
    od = __builtin_amdgcn_mfma_f32_32x32x16_bf16(pa2, PK(l2, h2), od, 0, 0, 0);
    od = __builtin_amdgcn_mfma_f32_32x32x16_bf16(pa3, PK(l3, h3), od, 0, 0, 0);
#undef PK
}
template <int DV> __device__ __forceinline__ void pv_all(f32x16* o, int vb, bf16x8 pa0, bf16x8 pa1, bf16x8 pa2, bf16x8 pa3) {
    pv_one<DV, 0>(o[0], vb, pa0, pa1, pa2, pa3); pv_one<DV, 1>(o[1], vb, pa0, pa1, pa2, pa3);
    if constexpr (DV == 128) { pv_one<DV, 2>(o[2], vb, pa0, pa1, pa2, pa3); pv_one<DV, 3>(o[3], vb, pa0, pa1, pa2, pa3); }
}
template <int DV> __device__ __forceinline__ void pv_vis(f32x16* o, const LAS char* vrd, bf16x8 pa0, bf16x8 pa1, bf16x8 pa2, bf16x8 pa3) {
    typedef short v4i16_t __attribute__((ext_vector_type(4)));
#define TRR(off) __builtin_bit_cast(s16x4, __builtin_amdgcn_ds_read_tr16_b64_v4i16((LAS v4i16_t*)(vrd + (off))))
#define PKV(L, H) (bf16x8){L[0], L[1], L[2], L[3], H[0], H[1], H[2], H[3]}
#pragma unroll
    for (int d0 = 0; d0 < DV / 32; ++d0) {
        const s16x4 l0 = TRR(d0 * 4096), h0 = TRR(d0 * 4096 + 512), l1 = TRR(d0 * 4096 + 1024), h1 = TRR(d0 * 4096 + 1536);
        const s16x4 l2 = TRR(d0 * 4096 + 2048), h2 = TRR(d0 * 4096 + 2560), l3 = TRR(d0 * 4096 + 3072), h3 = TRR(d0 * 4096 + 3584);
        o[d0] = __builtin_amdgcn_mfma_f32_32x32x16_bf16(pa0, PKV(l0, h0), o[d0], 0, 0, 0);
        o[d0] = __builtin_amdgcn_mfma_f32_32x32x16_bf16(pa1, PKV(l1, h1), o[d0], 0, 0, 0);
        o[d0] = __builtin_amdgcn_mfma_f32_32x32x16_bf16(pa2, PKV(l2, h2), o[d0], 0, 0, 0);
        o[d0] = __builtin_amdgcn_mfma_f32_32x32x16_bf16(pa3, PKV(l3, h3), o[d0], 0, 0, 0); }
#undef TRR
#undef PKV
}
constexpr float THRL = 6.0f;
__device__ __forceinline__ void partialSM(f32x16& p0, f32x16& p1, float& m_reg, float& alpha) {
    float pmax = p0[0];
#pragma unroll
    for (int r = 1; r < 16; ++r) pmax = fmaxf(pmax, p0[r]);
#pragma unroll
    for (int r = 0; r < 16; ++r) pmax = fmaxf(pmax, p1[r]);
    { auto rr = __builtin_amdgcn_permlane32_swap(__float_as_uint(pmax), __float_as_uint(pmax), false, false);
      pmax = fmaxf(__uint_as_float(rr[0]), __uint_as_float(rr[1])); }
    float mn;
    if (__builtin_expect(__all(pmax - m_reg <= THRL), 1)) { mn = m_reg; alpha = 1.f; }
    else { mn = fmaxf(m_reg, pmax); alpha = __builtin_amdgcn_exp2f(m_reg - mn); m_reg = mn; }
#pragma unroll
    for (int r = 0; r < 16; ++r) p0[r] = __builtin_amdgcn_exp2f(p0[r] - mn);
#pragma unroll
    for (int r = 0; r < 16; ++r) p1[r] -= mn;
}
__device__ __forceinline__ void finishSM(f32x16& p0, f32x16& p1, float alpha, float& l_reg, bf16x8& pa0, bf16x8& pa1, bf16x8& pa2, bf16x8& pa3) {
#pragma unroll
    for (int r = 0; r < 16; ++r) p1[r] = __builtin_amdgcn_exp2f(p1[r]);
    float ps = 0.f;
#pragma unroll
    for (int r = 0; r < 16; ++r) ps += p0[r];
#pragma unroll
    for (int r = 0; r < 16; ++r) ps += p1[r];
    l_reg = l_reg * alpha + ps;
#define PK4(P, B, OUT) do { u32x4 w = {pk2(P[B + 0], P[B + 1]), pk2(P[B + 2], P[B + 3]), pk2(P[B + 4], P[B + 5]), pk2(P[B + 6], P[B + 7])}; OUT = __builtin_bit_cast(bf16x8, w); } while (0)
    PK4(p0, 0, pa0); PK4(p0, 8, pa1); PK4(p1, 0, pa2); PK4(p1, 8, pa3);
#undef PK4
}
template <int DQK> __device__ __forceinline__ void qkt(f32x16& p0, f32x16& p1, const char* Ks, const bf16x8* qr, int r32, int hi) {
    p0 = f32x16{}; p1 = f32x16{};
#pragma unroll
    for (int d0 = 0; d0 < DQK / 16; ++d0) {
        const bf16x8 b0 = *reinterpret_cast<const bf16x8*>(Ks + d0 * 2048 + hi * 1024 + r32 * 16);
        const bf16x8 b1 = *reinterpret_cast<const bf16x8*>(Ks + d0 * 2048 + hi * 1024 + 512 + r32 * 16);
        p0 = __builtin_amdgcn_mfma_f32_32x32x16_bf16(b0, qr[d0], p0, 0, 0, 0);
        p1 = __builtin_amdgcn_mfma_f32_32x32x16_bf16(b1, qr[d0], p1, 0, 0, 0);
    }
}
template <int DQK, int DV, bool PIPE>
__device__ __forceinline__ void attn_core(const bf16_t* __restrict__ Qw, int ldq, const bf16_t* __restrict__ K1, int ldk1, const bf16_t* __restrict__ K2, int ldk2,
                                          const bf16_t* __restrict__ Vp, int ldv, int nkeys, char* lds, f32x16 (&o)[DV / 32], float& l_out) {
    constexpr int KB = DQK * 128, VB = DV * 128, SLOT = KB + VB, NS = PIPE ? 4 : 3, NPK = DQK / 8, NPV = DV / 8, NP_ = NPK + NPV;
    static_assert(NP_ <= 24, "3 pieces per wave");
    const int tid = tid_now(), lane = tid & 63, r32 = lane & 31, hi = lane >> 5; const int wid = __builtin_amdgcn_readfirstlane(tid >> 6);
    float* al_l = (float*)(lds + NS * SLOT) + wid * 64;
    float m_reg = -1e30f, l_reg = 0.f;
#pragma unroll
    for (int d = 0; d < DV / 32; ++d) o[d] = f32x16{};
    const bf16_t* psrc[3]; int pstep[3]; int pdst[3];
#pragma unroll
    for (int i = 0; i < 3; ++i) { int p = wid + 8 * i; if (p >= NP_) p -= 8;
        if (p < NPK) { if (DQK == 96 && p >= 8) { psrc[i] = K2 + (size_t)lane * ldk2 + (p - 8) * 8; pstep[i] = 64 * ldk2; } else { psrc[i] = K1 + (size_t)lane * ldk1 + p * 8; pstep[i] = 64 * ldk1; } pdst[i] = p * 1024; }
        else { const int q = p - NPK, d0 = q >> 2, kq = q & 3; psrc[i] = Vp + (size_t)(16 * kq + (lane >> 2)) * ldv + d0 * 32 + (lane & 3) * 8; pstep[i] = 64 * ldv; pdst[i] = KB + q * 1024; } }
#define DMA_TILE(t, slotoff) do { _Pragma("unroll") for (int i = 0; i < 3; ++i) \
        __builtin_amdgcn_global_load_lds((const unsigned*)(psrc[i] + (size_t)(t) * pstep[i]), (LAS unsigned*)(lds + (slotoff) + pdst[i]), 16, 0, 0); } while (0)
#define WAITV(n) asm volatile("s_waitcnt vmcnt(" #n ")" ::: "memory")
#define BAR() asm volatile("s_waitcnt lgkmcnt(0)\n\ts_barrier" ::: "memory")
#define RESC(a) do { if (__any((a) < 1.f)) { if (hi == 0) al_l[r32] = (a); asm volatile("s_waitcnt lgkmcnt(0)" ::: "memory"); \
        _Pragma("unroll") for (int d = 0; d < DV / 32; ++d) _Pragma("unroll") for (int r = 0; r < 16; ++r) o[d][r] *= al_l[crow(r, hi)]; } } while (0)
    const int NT = nkeys / 64;
    WAITV(0);
    bf16x8 qr[DQK / 16];
    { const bf16_t* q = Qw + (size_t)(wid * 32 + r32) * ldq + hi * 8;
#pragma unroll
      for (int d0 = 0; d0 < DQK / 16; ++d0) qr[d0] = *reinterpret_cast<const bf16x8*>(q + d0 * 16); }
    BAR();
    DMA_TILE(0, 0); DMA_TILE(1, SLOT);
    const int vb0 = (int)(uintptr_t)lds + KB + v_rd_base(lane);
    bf16x8 pa0, pa1, pa2, pa3;
    if constexpr (!PIPE) {
        typedef short v4i16_t __attribute__((ext_vector_type(4)));
        constexpr int NB = DV / 32;
        const LAS char* vrd = (const LAS char*)(LAS char*)(lds) + KB + v_rd_base(lane);
        const LAS char* krd = (const LAS char*)(LAS char*)(lds) + hi * 1024 + r32 * 16;
        f32x16 p0, p1; float al; int sl = 0, sl2 = 2 * SLOT;
#pragma unroll 1
        for (int t = 0; t < NT; ++t) {
            if (t + 1 < NT) WAITV(3); else WAITV(0);
            BAR();
            if (t + 2 < NT) DMA_TILE(t + 2, sl2);
            SBAR();
            bf16x8 kf[DQK / 16][2]; s16x4 vl[NB][4], vh[NB][4];
#pragma unroll
            for (int d0 = 0; d0 < DQK / 16; ++d0) { kf[d0][0] = *(const LAS bf16x8*)(krd + sl + d0 * 2048); kf[d0][1] = *(const LAS bf16x8*)(krd + sl + d0 * 2048 + 512); }
#pragma unroll
            for (int d0 = 0; d0 < NB; ++d0)
#pragma unroll
                for (int ks = 0; ks < 4; ++ks) {
                    vl[d0][ks] = __builtin_bit_cast(s16x4, __builtin_amdgcn_ds_read_tr16_b64_v4i16((LAS v4i16_t*)(vrd + sl + d0 * 4096 + ks * 1024)));
                    vh[d0][ks] = __builtin_bit_cast(s16x4, __builtin_amdgcn_ds_read_tr16_b64_v4i16((LAS v4i16_t*)(vrd + sl + d0 * 4096 + ks * 1024 + 512))); }
            SBAR();
            p0 = f32x16{}; p1 = f32x16{};
#pragma unroll
            for (int d0 = 0; d0 < DQK / 16; ++d0) {
                p0 = __builtin_amdgcn_mfma_f32_32x32x16_bf16(kf[d0][0], qr[d0], p0, 0, 0, 0);
                p1 = __builtin_amdgcn_mfma_f32_32x32x16_bf16(kf[d0][1], qr[d0], p1, 0, 0, 0); }
            partialSM(p0, p1, m_reg, al); RESC(al);
            finishSM(p0, p1, al, l_reg, pa0, pa1, pa2, pa3);
#define PKV(L, H) (bf16x8){L[0], L[1], L[2], L[3], H[0], H[1], H[2], H[3]}
#pragma unroll
            for (int d0 = 0; d0 < NB; ++d0) {
                o[d0] = __builtin_amdgcn_mfma_f32_32x32x16_bf16(pa0, PKV(vl[d0][0], vh[d0][0]), o[d0], 0, 0, 0);
                o[d0] = __builtin_amdgcn_mfma_f32_32x32x16_bf16(pa1, PKV(vl[d0][1], vh[d0][1]), o[d0], 0, 0, 0);
                o[d0] = __builtin_amdgcn_mfma_f32_32x32x16_bf16(pa2, PKV(vl[d0][2], vh[d0][2]), o[d0], 0, 0, 0);
                o[d0] = __builtin_amdgcn_mfma_f32_32x32x16_bf16(pa3, PKV(vl[d0][3], vh[d0][3]), o[d0], 0, 0, 0); }
#undef PKV
            sl = sl == (NS - 1) * SLOT ? 0 : sl + SLOT; sl2 = sl2 == (NS - 1) * SLOT ? 0 : sl2 + SLOT;
        }
    } else {
        f32x16 pA0, pA1, pB0, pB1; float alA, alB;
        const LAS char* vrd = (const LAS char*)(LAS char*)(lds) + KB + v_rd_base(lane);
        WAITV(3); BAR(); DMA_TILE(2, 2 * SLOT);
        qkt<DQK>(pA0, pA1, lds, qr, r32, hi); partialSM(pA0, pA1, m_reg, alA);
        int sp = 0, sc = SLOT, sn = 3 * SLOT;
#define ROT() do { sp = sc; sc = sc == 3 * SLOT ? 0 : sc + SLOT; sn = sn == 3 * SLOT ? 0 : sn + SLOT; } while (0)
#pragma unroll 1
        for (int j = 1; j + 1 < NT; j += 2) {
            WAITV(3); BAR(); if (j + 2 < NT) DMA_TILE(j + 2, sn);
            SBAR(); qkt<DQK>(pB0, pB1, lds + sc, qr, r32, hi);
            finishSM(pA0, pA1, alA, l_reg, pa0, pa1, pa2, pa3); SBAR();
            pv_all<DV>(o, vb0 + sp, pa0, pa1, pa2, pa3); partialSM(pB0, pB1, m_reg, alB);
            RESC(alB); ROT();
            if (j + 2 < NT) WAITV(3); else WAITV(0);
            BAR(); if (j + 3 < NT) DMA_TILE(j + 3, sn);
            SBAR(); qkt<DQK>(pA0, pA1, lds + sc, qr, r32, hi);
            finishSM(pB0, pB1, alB, l_reg, pa0, pa1, pa2, pa3); SBAR();
            pv_all<DV>(o, vb0 + sp, pa0, pa1, pa2, pa3); partialSM(pA0, pA1, m_reg, alA);
            RESC(alA); ROT();
        }
        WAITV(0); BAR();
        SBAR(); qkt<DQK>(pB0, pB1, lds + sc, qr, r32, hi);
        finishSM(pA0, pA1, alA, l_reg, pa0, pa1, pa2, pa3); SBAR();
        pv_all<DV>(o, vb0 + sp, pa0, pa1, pa2, pa3); partialSM(pB0, pB1, m_reg, alB);
        RESC(alB);
        finishSM(pB0, pB1, alB, l_reg, pa0, pa1, pa2, pa3); SBAR();
        pv_all<DV>(o, vb0 + sc, pa0, pa1, pa2, pa3);
#undef ROT
    }
    { auto rr = __builtin_amdgcn_permlane32_swap(__float_as_uint(l_reg), __float_as_uint(l_reg), false, false);
      l_out = __uint_as_float(rr[0]) + __uint_as_float(rr[1]); }
#undef DMA_TILE
#undef WAITV
#undef BAR
#undef RESC
}
}
typedef const float __attribute__((address_space(1)))* cfp_t;
constexpr int LDS_TAB = 146432;
struct Frame {
    unsigned char* lds; unsigned char* ws; float* out; const LAS cfp_t* in;
    int tid, lane, wave, vcu, G, bid;
};
#define IN_(k) ((const float*)F.in[k])

__device__ __forceinline__ void tr_item(const float* W, int ldw, int col0, int K, bf16_t* WT, int drow0, int kb, int nb, LAS float* scr, int lane, bool zero) {
    const int k0 = 64 * kb, n0 = 32 * nb;
    if (!zero) {
        float v[32];
        const float* src = W + (size_t)(k0 + (lane >> 5)) * ldw + col0 + n0 + (lane & 31);
#pragma unroll
        for (int i = 0; i < 32; ++i) v[i] = src[(size_t)(2 * i) * ldw];
#pragma unroll
        for (int i = 0; i < 32; ++i) scr[(2 * i + (lane >> 5)) * 33 + (lane & 31)] = v[i];
    }
    asm volatile("s_waitcnt lgkmcnt(0)" ::: "memory");
    const int c = lane & 7;
#pragma unroll
    for (int j = 0; j < 4; ++j) { const int n = (lane >> 3) + 8 * j; const LAS float* s = scr + (8 * c) * 33 + n;
        u32x4 o; o.x = pk2(s[0 * 33], s[1 * 33]); o.y = pk2(s[2 * 33], s[3 * 33]); o.z = pk2(s[4 * 33], s[5 * 33]); o.w = pk2(s[6 * 33], s[7 * 33]);
        if (zero) o = (u32x4){0u, 0u, 0u, 0u};
        *(u32x4*)(WT + (size_t)(drow0 + n0 + n) * K + k0 + 8 * c) = o; }
    asm volatile("s_waitcnt lgkmcnt(0)" ::: "memory");
}
__device__ __forceinline__ int win_src_col(int r) {
    if (r < 512) return r;
    if (r < 896) return 1024 + (r - 512);
    if (r < 1152) return 1408 + (r - 896);
    if (r < 1184) return 1664;
    if (r < 1280) return -1;
    if (r < 1792) return 2208 + (r - 1280);
    if (r < 2304) return 2720 + (r - 1792);
    if (r < 2816) return 3232 + (r - 2304);
    if (r < 3328) return 512 + (r - 2816);
    if (r < 3840) return 1696 + (r - 3328);
    if (r < 4352) return 3744 + (r - 3840);
    return 4256 + (r - 4352);
}
__device__ __forceinline__ void convert_weights(Frame& F, int l) {
    LAS float* scr = (LAS float*)(F.lds) + F.wave * 2176;
    unsigned char* Wb = F.ws + WS_W;
    const int gw = F.vcu * 8 + F.wave, NGW = F.G * 8;
    constexpr int I_IN = 16 * 232, I_UQ = 6 * 24, I_UKV = 4 * 32, I_BR = 8 * 32, I_OUT = 16 * 32, I_RG = 64;
    constexpr int NITEMS = I_IN + I_UQ + I_UKV + 3 * I_BR + I_OUT + I_RG;
    for (int it = gw; it < NITEMS; it += NGW) {
        int r = it;
        if (r < I_IN) { const int db = r % 232, kb = r / 232; const int sc = win_src_col(db * 32);
            tr_item(IN_(13) + (size_t)l * 1024 * IN_COLS, IN_COLS, sc < 0 ? 0 : sc, 1024, (bf16_t*)(Wb + W_IN), db * 32, kb, 0, scr, F.lane, sc < 0); continue; } r -= I_IN;
        if (r < I_UQ) { tr_item(IN_(22) + (size_t)l * 384 * 768, 768, 0, 384, (bf16_t*)(Wb + W_UQ), 0, r / 24, r % 24, scr, F.lane, false); continue; } r -= I_UQ;
        if (r < I_UKV) { tr_item(IN_(24) + (size_t)l * 256 * 1024, 1024, 0, 256, (bf16_t*)(Wb + W_UKV), 0, r / 32, r % 32, scr, F.lane, false); continue; } r -= I_UKV;
        if (r < 3 * I_BR) { const int b = r / I_BR, q = r % I_BR;
            tr_item((b == 0 ? IN_(30) : b == 1 ? IN_(31) : IN_(32)) + (size_t)l * 512 * 1024, 1024, 0, 512, (bf16_t*)(Wb + W_BR), b * 1024, q / 32, q % 32, scr, F.lane, false); continue; } r -= 3 * I_BR;
        if (r < I_OUT) { tr_item(IN_(33) + (size_t)l * 1024 * 1024, 1024, 0, 1024, (bf16_t*)(Wb + W_OUT), 0, r / 32, r % 32, scr, F.lane, false); continue; } r -= I_OUT;
        { const int mat = r >> 1, nb = r & 1, gate = mat >> 4, dn = mat & 15;
          const float* src = (gate ? IN_(18) : IN_(16)) + ((size_t)l * 16 + dn) * 4096;
          const int d = dn >> 3, n = dn & 7;
          tr_item(src, 64, 0, 64, (bf16_t*)(Wb + W_RG) + (size_t)((d * 2 + gate) * 8 + n) * 4096, 0, 0, nb, scr, F.lane, false); }
    }
}
__device__ __forceinline__ void phase0_mod_rope(Frame& F) {
    float* mod = (float*)(F.ws + CTL_MOD);
    if (F.bid < 96) {
        const int l = F.bid / 48, c0 = (F.bid % 48) * 64;
        LAS float* sc = (LAS float*)F.lds + 8 * 2176;
        LAS float* red = sc + 9 * 1024;
        for (int i = F.tid; i < 9 * 1024; i += NTHREADS) { const int g = i >> 10, k = i & 1023; const float x = g == 0 ? IN_(8)[k] : IN_(7)[(g - 1) * 1024 + k]; sc[i] = siluf_(x); }
        __syncthreads();
        float a[9];
#pragma unroll
        for (int g = 0; g < 9; ++g) a[g] = 0.f;
        const float* w = IN_(9) + (size_t)l * 1024 * 3072 + c0 + F.lane;
        for (int k = F.wave * 128; k < F.wave * 128 + 128; ++k) { const float wv = w[(size_t)k * 3072];
#pragma unroll
            for (int g = 0; g < 9; ++g) a[g] += sc[g * 1024 + k] * wv; }
#pragma unroll
        for (int g = 0; g < 9; ++g) red[(F.wave * 9 + g) * 64 + F.lane] = a[g];
        __syncthreads();
        for (int i = F.tid; i < 9 * 64; i += NTHREADS) { const int g = i >> 6, c = i & 63; float s = IN_(10)[l * 3072 + c0 + c];
#pragma unroll
            for (int wv = 0; wv < 8; ++wv) s += red[(wv * 9 + g) * 64 + c];
            mod[((size_t)l * 9 + g) * 3072 + c0 + c] = s; }
        __syncthreads();
    } else if (F.bid == 96) {
        float* rp = (float*)(F.ws + CTL_ROPE);
        for (int i = F.tid; i < 64 * 8; i += NTHREADS) { const int pos = i >> 3, j = i & 7; const float ang = (float)pos * powf(10000.0f, -(float)j / 8.0f); rp[i] = cosf(ang); rp[512 + i] = sinf(ang); }
        for (int i = F.tid; i < 64 * 16; i += NTHREADS) { const int pos = i >> 4, j = i & 15; const float ang = (float)pos * powf(10000.0f, -(float)j / 16.0f); rp[1024 + i] = cosf(ang); rp[2048 + i] = sinf(ang); }
    }
}
__device__ __forceinline__ const float* x_row_l0(Frame& F, int r) { return r < NP ? IN_(0) + (size_t)r * DM : IN_(1) + (size_t)(r - NP) * DM; }
__device__ __forceinline__ void prenorm_store(Frame& F, const f32x4* v, int r, int l) {
    float s = 0.f;
#pragma unroll
    for (int j = 0; j < 4; ++j) s += (v[j].x * v[j].x + v[j].y * v[j].y) + (v[j].z * v[j].z + v[j].w * v[j].w);
    const float rstd = 1.0f / sqrtf(wave_sum(s) * (1.0f / DM) + EPS);
    const float* mod = (const float*)(F.ws + CTL_MOD) + ((size_t)l * 9 + grp_of(r)) * 3072;
    const float* gp = IN_(11) + l * DM;
    bf16_t* h = (bf16_t*)(F.ws + WS_H) + (size_t)r * DM;
#pragma unroll
    for (int j = 0; j < 4; ++j) { const int c = 4 * F.lane + 256 * j;
        const f32x4 g = *(const f32x4*)(gp + c), sh = *(const f32x4*)(mod + c), sc = *(const f32x4*)(mod + 1024 + c);
        const f32x4 y = (v[j] * rstd * g) * (sc + 1.0f) + sh;
        u32x2 w; w.x = pk2(y.x, y.y); w.y = pk2(y.z, y.w); *(u32x2*)(h + c) = w; }
}
__device__ __forceinline__ void phase0_h(Frame& F) {
    const int gw = F.vcu * 8 + F.wave, NGW = F.G * 8;
    for (int r = gw; r < NTOK; r += NGW) { const f32x4* xr = (const f32x4*)x_row_l0(F, r) + F.lane; f32x4 v[4];
#pragma unroll
        for (int j = 0; j < 4; ++j) v[j] = xr[64 * j];
        prenorm_store(F, v, r, 0); }
}
__device__ __forceinline__ void phase_post(Frame& F, int l) {
    const int gw = F.vcu * 8 + F.wave, NGW = F.G * 8;
    const bf16_t* O = (const bf16_t*)(F.ws + WS_A + A_O);
    const float* ssq = (const float*)(F.ws + CTL_SSQ);
    const float* gpost = IN_(12) + l * DM;
    for (int r = gw; r < NTOK; r += NGW) {
        float sq = F.lane < 16 ? ssq[(size_t)r * 16 + F.lane] : 0.f;
        const float rstd = 1.0f / sqrtf(wave_sum(sq) * (1.0f / DM) + EPS);
        const float* xin = l == 0 ? x_row_l0(F, r) : F.out + O_Y + (size_t)r * DM;
        float* xo = F.out + O_Y + (size_t)r * DM;
        const float* gate = (const float*)(F.ws + CTL_MOD) + ((size_t)l * 9 + grp_of(r)) * 3072 + 2048;
        f32x4 v[4];
#pragma unroll
        for (int j = 0; j < 4; ++j) { const int c = 4 * F.lane + 256 * j;
            const u32x2 ow = *(const u32x2*)(O + (size_t)r * DM + c);
            const f32x4 o = {bflo(ow.x), bfhi(ow.x), bflo(ow.y), bfhi(ow.y)};
            const f32x4 x = *(const f32x4*)(xin + c), g = *(const f32x4*)(gpost + c), gt = *(const f32x4*)(gate + c);
            v[j] = x + gt * (o * rstd * g);
            *(f32x4*)(xo + c) = v[j]; }
        if (l == 0) prenorm_store(F, v, r, 1);
    }
}
constexpr int RNW_BYTES = 12288;
constexpr int RNW_XB = 5376, RNW_XF = 10240;
constexpr int RN_WC = 8 * RNW_BYTES;
#define LDS_BARRIER() asm volatile("s_waitcnt lgkmcnt(0)\n\ts_barrier" ::: "memory")
#define LDS_WAVE_SYNC() asm volatile("s_waitcnt lgkmcnt(0)" ::: "memory")
__device__ __forceinline__ float neg_expm1(float x, float ex) {
    const float s = -x * (1.0f + x * (0.5f + x * (0.16666667f + x * (0.041666668f + x * 0.008333334f))));
    return x > -0.125f ? s : 1.0f - ex;
}
template <int DIR>
__device__ __forceinline__ float rnn_dir(unsigned char* LW, float* WC, const bf16x8 (&wa)[2], const bf16x8 (&wx)[2], float ba_, float bx_, float sp_, float cin, float (&hacc)[2][4], int lane, int wave) {
    const int jc = lane & 15, g = lane >> 4;
    float av[2][4], bv[2][4], iA[2], iB[2], tA[2], tB[2];
#pragma unroll
    for (int rb = 0; rb < 2; ++rb) {
        f32x4 ga = {0.f, 0.f, 0.f, 0.f}, gx = {0.f, 0.f, 0.f, 0.f};
#pragma unroll
        for (int ks = 0; ks < 2; ++ks) {
            const bf16x8 af = *(const bf16x8*)(LW + RNW_XB + (rb * 16 + jc) * 144 + (ks * 32 + g * 8) * 2);
            ga = __builtin_amdgcn_mfma_f32_16x16x32_bf16(af, wa[ks], ga, 0, 0, 0);
            gx = __builtin_amdgcn_mfma_f32_16x16x32_bf16(af, wx[ks], gx, 0, 0, 0);
        }
#pragma unroll
        for (int i = 0; i < 4; ++i) { const int t = rb * 16 + 4 * g + i;
            const float r = __builtin_amdgcn_rcpf(1.0f + __expf(-(ga[i] + ba_))), ig = __builtin_amdgcn_rcpf(1.0f + __expf(-(gx[i] + bx_)));
            const float la = sp_ * r, a = __expf(la), a2 = a * a;
            const float xc = ((const float*)(LW + RNW_XF))[t * 16 + jc];
            av[rb][i] = a; bv[rb][i] = __builtin_amdgcn_sqrtf(neg_expm1(2.0f * la, a2)) * (ig * xc); }
    }
#pragma unroll
    for (int rb = 0; rb < 2; ++rb) { float A = 1.f, B = 0.f;
#pragma unroll
        for (int i = 0; i < 4; ++i) { constexpr int dummy = 0; const int ii = DIR == 0 ? i : 3 - i; (void)dummy; A *= av[rb][ii]; B = av[rb][ii] * B + bv[rb][ii]; }
#pragma unroll
        for (int st = 1; st < 4; st <<= 1) {
            const int src = DIR == 0 ? lane - 16 * st : lane + 16 * st;
            const float pA = __shfl(A, src & 63), pB = __shfl(B, src & 63);
            const bool has = DIR == 0 ? (g >= st) : (g + st <= 3);
            if (has) { B = A * pB + B; A = A * pA; } }
        iA[rb] = A; iB[rb] = B;
        const int lastl = DIR == 0 ? 48 + jc : jc;
        tA[rb] = __shfl(A, lastl); tB[rb] = __shfl(B, lastl); }
    constexpr int f0 = DIR == 0 ? 0 : 1, f1 = 1 - f0;
    { const float wA = tA[f0] * tA[f1], wB = tA[f1] * tB[f0] + tB[f1];
      if (g == 0) { WC[(wave * 2 + 0) * 16 + jc] = wA; WC[(wave * 2 + 1) * 16 + jc] = wB; } }
    LDS_BARRIER();
    float hin = cin, hout = cin;
#pragma unroll
    for (int w = 0; w < 8; ++w) { const int ws_ = DIR == 0 ? w : 7 - w; const float A = WC[(ws_ * 2 + 0) * 16 + jc], B = WC[(ws_ * 2 + 1) * 16 + jc];
        hout = A * hout + B; const bool before = DIR == 0 ? (ws_ < wave) : (ws_ > wave); if (before) hin = hout; }
#pragma unroll
    for (int rbi = 0; rbi < 2; ++rbi) { constexpr int dummy2 = 0; (void)dummy2; const int rb = rbi == 0 ? f0 : f1;
        float h = hin; if (rbi == 1) h = tA[f0] * h + tB[f0];
        const int src = DIR == 0 ? lane - 16 : lane + 16; const float pA = __shfl(iA[rb], src & 63), pB = __shfl(iB[rb], src & 63);
        const bool has = DIR == 0 ? (g >= 1) : (g <= 2);
        if (has) h = pA * h + pB;
#pragma unroll
        for (int i = 0; i < 4; ++i) { const int ii = DIR == 0 ? i : 3 - i; h = av[rb][ii] * h + bv[rb][ii]; hacc[rb][ii] += h; } }
    return hout;
}
__device__ __forceinline__ void rnn_item(Frame& F, int l, int seq, int n, int qt) {
    const bool dec = seq >= 32;
    const int S = dec ? 2048 : 256, tok0 = dec ? NP + (seq - 32) * 2048 : seq * 256, nck = S / 256;
    const int tid = F.tid, lane = F.lane, wave = F.wave;
    const bf16_t* RX = (const bf16_t*)(F.ws + WS_Y + 2 * Y_SLOT) + (size_t)tok0 * 512 + n * 64;
    bf16_t* HS = (bf16_t*)(F.ws + WS_Y) + (size_t)tok0 * 512 + n * 64 + qt * 16;
    unsigned char* LW = F.lds + wave * RNW_BYTES;
    const int oc0 = n * 64 + qt * 16;
    const int jc = lane & 15, g = lane >> 4;
    const int c8 = lane & 7, tb = lane >> 3;
    float cw[4][8], cbv[8];
#pragma unroll
    for (int k = 0; k < 4; ++k) { const f32x4 w0 = *(const f32x4*)(IN_(14) + ((size_t)l * 4 + k) * 512 + n * 64 + c8 * 8), w1 = *(const f32x4*)(IN_(14) + ((size_t)l * 4 + k) * 512 + n * 64 + c8 * 8 + 4);
        cw[k][0] = w0.x; cw[k][1] = w0.y; cw[k][2] = w0.z; cw[k][3] = w0.w; cw[k][4] = w1.x; cw[k][5] = w1.y; cw[k][6] = w1.z; cw[k][7] = w1.w; }
    { const f32x4 b0 = *(const f32x4*)(IN_(15) + l * 512 + n * 64 + c8 * 8), b1 = *(const f32x4*)(IN_(15) + l * 512 + n * 64 + c8 * 8 + 4);
      cbv[0] = b0.x; cbv[1] = b0.y; cbv[2] = b0.z; cbv[3] = b0.w; cbv[4] = b1.x; cbv[5] = b1.y; cbv[6] = b1.z; cbv[7] = b1.w; }
    const bf16_t* wt = (const bf16_t*)(F.ws + WS_W + W_RG);
    bf16x8 wa[2][2], wx[2][2]; float ba[2], bx[2], sp8[2];
#pragma unroll
    for (int d = 0; d < 2; ++d) {
#pragma unroll
        for (int ks = 0; ks < 2; ++ks) {
            wa[d][ks] = *(const bf16x8*)(wt + (size_t)((d * 2 + 0) * 8 + n) * 4096 + (qt * 16 + jc) * 64 + ks * 32 + g * 8);
            wx[d][ks] = *(const bf16x8*)(wt + (size_t)((d * 2 + 1) * 8 + n) * 4096 + (qt * 16 + jc) * 64 + ks * 32 + g * 8); }
        ba[d] = IN_(17)[(l * 2 + d) * 512 + oc0 + jc]; bx[d] = IN_(19)[(l * 2 + d) * 512 + oc0 + jc];
        sp8[d] = -8.0f * log1pf(__expf(-IN_(20)[(l * 2 + d) * 512 + oc0 + jc])); }
    u32x4 raw[5];
#define RN_LOAD(c0_) do { _Pragma("unroll") for (int i = 0; i < 5; ++i) { const int pc = lane + i * 64, rr = pc >> 3, pc8 = pc & 7, t = (c0_) + wave * 32 - 2 + rr; \
        const bool ok = t >= 0 && t < S && rr < 36; const int tc = ok ? t : 0; \
        raw[i] = *(const u32x4*)(RX + (size_t)tc * 512 + pc8 * 8); if (!ok) raw[i] = (u32x4){0u, 0u, 0u, 0u}; } } while (0)
#define RN_STORE() do { _Pragma("unroll") for (int i = 0; i < 5; ++i) { const int pc = lane + i * 64, rr = pc >> 3, pc8 = pc & 7; \
        if (rr < 36) *(u32x4*)(LW + rr * 144 + pc8 * 16) = raw[i]; } } while (0)
    const int npass = dec ? 2 : 1, ndirs = dec ? 1 : 2;
    int par = 0;
    LDS_BARRIER();
    for (int pass = 0; pass < npass; ++pass) {
        float carry[2];
#pragma unroll
        for (int dd = 0; dd < 2; ++dd) { const int dir = dec ? pass : dd; carry[dd] = dec ? IN_(6)[(((seq - 32) * 2 + l) * 2 + dir) * 512 + oc0 + jc] : 0.f; }
        asm volatile("s_waitcnt vmcnt(0)" ::: "memory");
        RN_LOAD(pass == 0 ? 0 : (nck - 1) * 256);
        for (int cc = 0; cc < nck; ++cc) {
            const int ci = pass == 0 ? cc : nck - 1 - cc, c0 = ci * 256;
            RN_STORE();
            if (cc + 1 < nck) RN_LOAD(pass == 0 ? c0 + 256 : c0 - 256);
            float hacc[2][4];
#pragma unroll
            for (int rb = 0; rb < 2; ++rb)
#pragma unroll
                for (int i = 0; i < 4; ++i) hacc[rb][i] = (dec && pass == 1) ? bf2f(HS[(size_t)(c0 + wave * 32 + rb * 16 + 4 * g + i) * 512 + jc]) : 0.f;
            LDS_WAVE_SYNC();
            {
                float xr[7][8];
#pragma unroll
                for (int r = 0; r < 7; ++r) unpack8(*(const u32x4*)(LW + (tb * 4 + r) * 144 + c8 * 16), xr[r]);
#pragma unroll
                for (int tt = 0; tt < 4; ++tt) { float acc8[8];
#pragma unroll
                    for (int e = 0; e < 8; ++e) acc8[e] = cbv[e] + xr[tt][e] * cw[0][e] + xr[tt + 1][e] * cw[1][e] + xr[tt + 2][e] * cw[2][e] + xr[tt + 3][e] * cw[3][e];
                    *(u32x4*)(LW + RNW_XB + (tb * 4 + tt) * 144 + c8 * 16) = pack8(acc8);
                    if ((c8 >> 1) == qt) { float* xf = (float*)(LW + RNW_XF) + (tb * 4 + tt) * 16 + (c8 & 1) * 8;
                        *(f32x4*)xf = (f32x4){acc8[0], acc8[1], acc8[2], acc8[3]}; *(f32x4*)(xf + 4) = (f32x4){acc8[4], acc8[5], acc8[6], acc8[7]}; } }
            }
            LDS_WAVE_SYNC();
#pragma unroll 1
            for (int dd = 0; dd < ndirs; ++dd) {
                const int dir = dec ? pass : dd;
                float* WC = (float*)(F.lds + RN_WC) + par * 256;
                float cin = dd ? carry[1] : carry[0], cout;
                if (dir == 0) cout = rnn_dir<0>(LW, WC, wa[0], wx[0], ba[0], bx[0], sp8[0], cin, hacc, lane, wave);
                else cout = rnn_dir<1>(LW, WC, wa[1], wx[1], ba[1], bx[1], sp8[1], cin, hacc, lane, wave);
                if (dd) carry[1] = cout; else carry[0] = cout;
                par ^= 1;
            }
#pragma unroll
            for (int rb = 0; rb < 2; ++rb)
#pragma unroll
                for (int i = 0; i < 4; ++i) HS[(size_t)(c0 + wave * 32 + rb * 16 + 4 * g + i) * 512 + jc] = (bf16_t)(pk2(hacc[rb][i], 0.f) & 0xffffu);
        }
        if (!dec && wave == 0 && g == 0) {
#pragma unroll
            for (int dd = 0; dd < 2; ++dd) F.out[O_ST + ((size_t)(seq * 2 + l) * 2 + dd) * 512 + oc0 + jc] = carry[dd]; }
    }
#undef RN_LOAD
#undef RN_STORE
}
__device__ __forceinline__ void phase_rnn_prep(Frame& F, int l, bool do_prep) {
#pragma unroll 1
    for (int k = 0; k < 5; ++k) {
        int seq, n, qt;
        if (k == 0) { const int v = F.vcu; seq = 32 + (v >> 5); n = (v & 31) >> 2; qt = v & 3; }
        else { const int p = F.vcu * 4 + k - 1; seq = p >> 5; n = (p & 31) >> 2; qt = p & 3; }
        rnn_item(F, l, seq, n, qt);
    }
    if (!do_prep) return;
    const int gw = F.vcu * 8 + F.wave, NGW = F.G * 8, lane = F.lane;
    bf16_t* CQ = (bf16_t*)(F.ws + WS_Y + Y_SLOT); bf16_t* CKV = (bf16_t*)(F.ws + WS_A + A_CKV); bf16_t* KR = (bf16_t*)(F.ws + WS_A + A_KR);
    const float* qn = IN_(21) + l * 384; const float* kn = IN_(23) + l * 256;
    for (int r = gw; r < NTOK; r += NGW) {
        float q[8], c[8]; float sq = 0.f, sc = 0.f;
        bf16_t* qp = CQ + (size_t)r * 384 + lane * 8; bf16_t* cp = CKV + (size_t)kvrow_of(r) * 256 + lane * 8;
        if (lane < 48) { unpack8(*(const u32x4*)qp, q);
#pragma unroll
            for (int i = 0; i < 8; ++i) sq += q[i] * q[i]; }
        if (lane < 32) { unpack8(*(const u32x4*)cp, c);
#pragma unroll
            for (int i = 0; i < 8; ++i) sc += c[i] * c[i]; }
        const float rq = 1.0f / sqrtf(wave_sum(sq) * (1.0f / 384.0f) + EPS), rc = 1.0f / sqrtf(wave_sum(sc) * (1.0f / 256.0f) + EPS);
        if (lane < 48) {
#pragma unroll
            for (int i = 0; i < 8; ++i) q[i] = q[i] * rq * qn[lane * 8 + i];
            *(u32x4*)qp = pack8(q); }
        if (lane < 32) {
#pragma unroll
            for (int i = 0; i < 8; ++i) c[i] = c[i] * rc * kn[lane * 8 + i];
            *(u32x4*)cp = pack8(c);
            if (r < NP) st_f32x8(F.out + O_CKV + (size_t)cache_row(r, l) * 256 + lane * 8, c); }
    }
    for (int i = gw; i < 4096; i += NGW) { const int b = i >> 9, j = i & 511; const int kvr = NP + b * 2560 + j;
        const float* s1 = IN_(2) + ((size_t)(b * 2 + l) * 512 + j) * 256;
        if (lane < 32) { const f32x4 a = *(const f32x4*)(s1 + lane * 8), bq = *(const f32x4*)(s1 + lane * 8 + 4); const float v[8] = {a.x, a.y, a.z, a.w, bq.x, bq.y, bq.z, bq.w};
            *(u32x4*)(CKV + (size_t)kvr * 256 + lane * 8) = pack8(v); }
        const float* s2 = IN_(3) + ((size_t)(b * 2 + l) * 512 + j) * 32;
        if (lane < 4) { const f32x4 a = *(const f32x4*)(s2 + lane * 8), bq = *(const f32x4*)(s2 + lane * 8 + 4); const float v[8] = {a.x, a.y, a.z, a.w, bq.x, bq.y, bq.z, bq.w};
            *(u32x4*)(KR + (size_t)kvr * 32 + lane * 8) = pack8(v); }
    }
}
__device__ __forceinline__ void convert_diff_ctx(Frame& F, int l) {
    const int gw = F.vcu * 8 + F.wave, NGW = F.G * 8, lane = F.lane;
    bf16_t* DK = (bf16_t*)(F.ws + WS_A + A_DK); bf16_t* DV = (bf16_t*)(F.ws + WS_A + A_DV);
    for (int i = gw; i < 8192; i += NGW) { const int which = i >> 12, b = (i >> 9) & 7, j = i & 511; const int kvr = NP + b * 2560 + j;
        const float* s = (which ? IN_(5) : IN_(4)) + ((size_t)(b * 2 + l) * 512 + j) * 512 + lane * 8;
        const f32x4 a = *(const f32x4*)s, bq = *(const f32x4*)(s + 4); const float v[8] = {a.x, a.y, a.z, a.w, bq.x, bq.y, bq.z, bq.w};
        *(u32x4*)((which ? DV : DK) + (size_t)kvr * 512 + lane * 8) = pack8(v); }
}
#ifndef MLA_PIPE
#define MLA_PIPE true
#endif
constexpr int ATT_STASH = 75776;
#ifndef ATT_SDEPTH_M
#define ATT_SDEPTH_M 1
#endif
#ifndef ATT_SDEPTH_D
#define ATT_SDEPTH_D 0
#endif
__device__ __forceinline__ void mla_unit(Frame& F, int tok0, int kv0, int nkeys, int h) {
    const bf16_t* Q = (const bf16_t*)(F.ws + WS_A + A_Q); const bf16_t* KV = (const bf16_t*)(F.ws + WS_A + A_KV); const bf16_t* KR = (const bf16_t*)(F.ws + WS_A + A_KR);
    bf16_t* OM = (bf16_t*)(F.ws + WS_Y + Y_SLOT);
    f32x16 o[2]; float l;
    att::attn_core<96, 64, MLA_PIPE>(Q + (size_t)tok0 * 768 + h * 96, 768, KV + (size_t)kv0 * 1024 + h * 128, 1024, KR + (size_t)kv0 * 32, 32,
                           KV + (size_t)kv0 * 1024 + h * 128 + 64, 1024, nkeys, (char*)F.lds, o, l);
    const int lane = F.lane, r32 = lane & 31, hi = lane >> 5;
    float* li = (float*)(F.lds + (MLA_PIPE ? 4 : 3) * 20480) + F.wave * 64 + 32;
    if (hi == 0) li[r32] = l;
    asm volatile("s_waitcnt lgkmcnt(0)" ::: "memory");
#pragma unroll
    for (int r = 0; r < 16; ++r) { const int q = att::crow(r, hi); const float rl = __builtin_amdgcn_rcpf(li[q]);
        bf16_t* op = OM + (size_t)(tok0 + F.wave * 32 + q) * 512 + h * 64 + r32;
#pragma unroll
        for (int d = 0; d < 2; ++d) op[d * 32] = (bf16_t)(pk2(o[d][r] * rl, 0.f) & 0xffffu); }
}
__device__ __forceinline__ void phase_mla(Frame& F) {
    const int x = F.vcu >> 5, j = F.vcu & 31;
#pragma unroll 1
    for (int u = 0; u < 3; ++u) {
        int tok0, kv0, nkeys, h;
        if (u < 2) { const int idx = j * 2 + u, pair = x * 8 + (idx >> 3), qb = idx & 7, b = pair >> 3; h = pair & 7; tok0 = NP + b * 2048 + qb * 256; kv0 = NP + b * 2560; nkeys = 2560; }
        else { const int b = F.vcu >> 3; h = F.vcu & 7; tok0 = b * 256; kv0 = b * 256; nkeys = 256; }
        mla_unit(F, tok0, kv0, nkeys, h);
    }
}
__device__ __forceinline__ void diff_pass(Frame& F, int l, int tok0, int kv0, int nkeys, int h, int pass, float lam, float lam_init) {
    const bf16_t* DQ = (const bf16_t*)(F.ws + WS_A + A_DQ); const bf16_t* DK = (const bf16_t*)(F.ws + WS_A + A_DK); const bf16_t* DV = (const bf16_t*)(F.ws + WS_A + A_DV);
    bf16_t* OD = (bf16_t*)(F.ws + WS_Y + 2 * Y_SLOT);
    const int lane = F.lane, r32 = lane & 31, hi = lane >> 5;
    float* li = (float*)(F.lds + 3 * 24576) + F.wave * 64 + 32;
    unsigned* stash = (unsigned*)(F.lds + ATT_STASH + F.wave * 8192);
    f32x16 o[4]; float lsum;
    const int coff = h * 128 + (pass == 0 ? 64 : 0);
    att::attn_core<64, 128, false>(DQ + (size_t)tok0 * 512 + coff, 512, DK + (size_t)kv0 * 512 + coff, 512, nullptr, 0,
                            DV + (size_t)kv0 * 512 + h * 128, 512, nkeys, (char*)F.lds, o, lsum);
    if (hi == 0) li[r32] = lsum;
    asm volatile("s_waitcnt lgkmcnt(0)" ::: "memory");
    if (pass == 0) {
#pragma unroll
        for (int r = 0; r < 16; r += 2) { const float rl0 = lam * __builtin_amdgcn_rcpf(li[att::crow(r, hi)]), rl1 = lam * __builtin_amdgcn_rcpf(li[att::crow(r + 1, hi)]);
#pragma unroll
            for (int d = 0; d < 4; ++d) stash[(d * 8 + (r >> 1)) * 64 + lane] = pk2(o[d][r] * rl0, o[d][r + 1] * rl1); }
        asm volatile("s_waitcnt lgkmcnt(0)" ::: "memory");
    } else {
        const float* dn = IN_(29) + l * 128;
        const float g0 = dn[r32], g1 = dn[32 + r32], g2 = dn[64 + r32], g3 = dn[96 + r32];
#pragma unroll
        for (int r = 0; r < 16; r += 2) {
            const float rl0 = __builtin_amdgcn_rcpf(li[att::crow(r, hi)]), rl1 = __builtin_amdgcn_rcpf(li[att::crow(r + 1, hi)]);
            float e0[4], e1[4]; float s0 = 0.f, s1 = 0.f;
#pragma unroll
            for (int d = 0; d < 4; ++d) { const unsigned w = stash[(d * 8 + (r >> 1)) * 64 + lane];
                e0[d] = o[d][r] * rl0 - bflo(w); e1[d] = o[d][r + 1] * rl1 - bfhi(w); s0 += e0[d] * e0[d]; s1 += e1[d] * e1[d]; }
#pragma unroll
            for (int m = 1; m < 32; m <<= 1) { s0 += __shfl_xor(s0, m); s1 += __shfl_xor(s1, m); }
            const float k0 = (1.0f - lam_init) / sqrtf(s0 * (1.0f / 128.0f) + EPS), k1 = (1.0f - lam_init) / sqrtf(s1 * (1.0f / 128.0f) + EPS);
            bf16_t* p0 = OD + (size_t)(tok0 + F.wave * 32 + att::crow(r, hi)) * 512 + h * 128 + r32;
            bf16_t* p1 = OD + (size_t)(tok0 + F.wave * 32 + att::crow(r + 1, hi)) * 512 + h * 128 + r32;
            p0[0] = (bf16_t)(pk2(e0[0] * k0 * g0, 0.f) & 0xffffu); p0[32] = (bf16_t)(pk2(e0[1] * k0 * g1, 0.f) & 0xffffu);
            p0[64] = (bf16_t)(pk2(e0[2] * k0 * g2, 0.f) & 0xffffu); p0[96] = (bf16_t)(pk2(e0[3] * k0 * g3, 0.f) & 0xffffu);
            p1[0] = (bf16_t)(pk2(e1[0] * k1 * g0, 0.f) & 0xffffu); p1[32] = (bf16_t)(pk2(e1[1] * k1 * g1, 0.f) & 0xffffu);
            p1[64] = (bf16_t)(pk2(e1[2] * k1 * g2, 0.f) & 0xffffu); p1[96] = (bf16_t)(pk2(e1[3] * k1 * g3, 0.f) & 0xffffu);
        }
    }
}
__device__ __forceinline__ void phase_diff(Frame& F, int l) {
    const float lam_init = 0.8f - 0.6f * expf(-0.3f * (float)l);
    const float d1 = wave_sum(IN_(25)[l * 64 + F.lane] * IN_(26)[l * 64 + F.lane]), d2 = wave_sum(IN_(27)[l * 64 + F.lane] * IN_(28)[l * 64 + F.lane]);
    const float lam = expf(d1) - expf(d2) + lam_init;
    const int x = F.vcu >> 5, j = F.vcu & 31;
    const int nsteps = (F.vcu & 1) == 0 ? 4 : 2;
#pragma unroll 1
    for (int st = 0; st < nsteps; ++st) {
        int tok0, kv0, nkeys, h;
        if (st < 2) { const int pair = x * 4 + (j >> 3), qb = j & 7, b = pair >> 2; h = pair & 3; tok0 = NP + b * 2048 + qb * 256; kv0 = NP + b * 2560; nkeys = 2560; }
        else { const int p = F.vcu >> 1, b = p >> 2; h = p & 3; tok0 = b * 256; kv0 = b * 256; nkeys = 256; }
        diff_pass(F, l, tok0, kv0, nkeys, h, st & 1, lam, lam_init);
    }
}
#define GEMM_CALL(EPI, SCHED, g, S, E) pg8::gemm_phase<EPI, SCHED, true, true>((PG8_LAS unsigned char*)F.lds, g, S, E)
struct BrOrder {
    int c;
    __device__ __forceinline__ bool next(int i, pg8::Unit& u) const { const int t = c + 256 * (i / 3), br = i % 3; if (i >= 6 || t >= 384) return false; u.pm = br * 96 + (t >> 2); u.pn = br * 4 + (t & 3); return true; }
    __device__ __forceinline__ void a_ready(const pg8::Unit&) const {}
    __device__ __forceinline__ void done(const pg8::Unit&) const {}
};
__device__ __forceinline__ void phase_g1(Frame& F, int l) {
    pg8::Gemm g{(const bf16_t*)(F.ws + WS_H), (const bf16_t*)(F.ws + WS_W + W_IN), NTOK, 1280, 1024};
    pg8::StaticOrder S; S.init(NTOK, 1280, F.G, F.bid);
    EpiG1 E{(bf16_t*)(F.ws + WS_Y + 2 * Y_SLOT), (bf16_t*)(F.ws + WS_Y + Y_SLOT), (bf16_t*)(F.ws + WS_A + A_CKV), (bf16_t*)(F.ws + WS_A + A_KR),
            F.out + O_KR, (const float*)(F.ws + CTL_ROPE), l};
    GEMM_CALL(EpiG1, pg8::StaticOrder, g, S, E);
}
__device__ __forceinline__ void phase_g2(Frame& F) {
    { pg8::Gemm g{(const bf16_t*)(F.ws + WS_Y + Y_SLOT), (const bf16_t*)(F.ws + WS_W + W_UQ), NTOK, 768, 384};
      pg8::StaticOrder S; S.init(NTOK, 768, F.G, F.bid);
      EpiQ E{(bf16_t*)(F.ws + WS_A + A_Q), (const float*)(F.ws + CTL_ROPE)};
      GEMM_CALL(EpiQ, pg8::StaticOrder, g, S, E); }
    { pg8::Gemm g{(const bf16_t*)(F.ws + WS_A + A_CKV), (const bf16_t*)(F.ws + WS_W + W_UKV), NKV, 1024, 256};
      pg8::StaticOrder S; S.init(NKV, 1024, F.G, (F.bid + F.G - (288 % F.G)) % F.G);
      EpiPlain E{(bf16_t*)(F.ws + WS_A + A_KV), 1024};
      GEMM_CALL(EpiPlain, pg8::StaticOrder, g, S, E); }
}
__device__ __forceinline__ void phase_g3(Frame& F, int l) {
    convert_diff_ctx(F, l);
    pg8::Gemm g{(const bf16_t*)(F.ws + WS_H), (const bf16_t*)(F.ws + WS_W + W_IN) + (size_t)1280 * 1024, NTOK, 1536, 1024};
    pg8::StaticOrder S; S.init(NTOK, 1536, F.G, F.bid);
    EpiG3 E{(bf16_t*)(F.ws + WS_A + A_DQ), (bf16_t*)(F.ws + WS_A + A_DK), (bf16_t*)(F.ws + WS_A + A_DV), F.out + O_DK, F.out + O_DV, (const float*)(F.ws + CTL_ROPE) + 1024, l};
    GEMM_CALL(EpiG3, pg8::StaticOrder, g, S, E);
}
__device__ __forceinline__ void phase_g4(Frame& F) {
    pg8::Gemm g{(const bf16_t*)(F.ws + WS_H), (const bf16_t*)(F.ws + WS_W + W_IN) + (size_t)2816 * 1024, NTOK, 4608, 1024};
    pg8::StaticOrder S; S.init(NTOK, 4608, F.G, F.bid);
    EpiG4 E{(bf16_t*)(F.ws + WS_Y), (unsigned char*)(F.ws + WS_A + A_G)};
    GEMM_CALL(EpiG4, pg8::StaticOrder, g, S, E);
}
__device__ __forceinline__ void phase_g5(Frame& F) {
    pg8::Gemm g{(const bf16_t*)(F.ws + WS_Y), (const bf16_t*)(F.ws + WS_W + W_BR), 3 * NTOK, 3072, 512};
    BrOrder S{F.bid};
    EpiG5 E{(const unsigned char*)(F.ws + WS_A + A_G), (bf16_t*)(F.ws + WS_H)};
    GEMM_CALL(EpiG5, BrOrder, g, S, E);
}
__device__ __forceinline__ void phase_g6(Frame& F) {
    pg8::Gemm g{(const bf16_t*)(F.ws + WS_H), (const bf16_t*)(F.ws + WS_W + W_OUT), NTOK, 1024, 1024};
    pg8::StaticOrder S; S.init(NTOK, 1024, F.G, F.bid);
    EpiG6 E{(bf16_t*)(F.ws + WS_A + A_O), (float*)(F.ws + CTL_SSQ)};
    GEMM_CALL(EpiG6, pg8::StaticOrder, g, S, E);
}

#define XB_TMO      128
#define XB_XCNT(j)  (256  + 64 * (j))
#define XB_XSUB(j)  (1280 + 64 * (j))
#define XB_XGEN(j)  (2304 + 64 * (j))
#define XB_TOP      3328
#define XB_TOPGEN   3392
#define XCD_BAR_WORDS 3456
#define XB_SPIN_CAP (1u << 18)

__device__ __forceinline__ unsigned xb_ld(unsigned* p)              { return __hip_atomic_load(p, __ATOMIC_RELAXED, __HIP_MEMORY_SCOPE_AGENT); }
__device__ __forceinline__ unsigned xb_add(unsigned* p, unsigned v) { return __hip_atomic_fetch_add(p, v, __ATOMIC_RELAXED, __HIP_MEMORY_SCOPE_AGENT); }
__device__ __forceinline__ unsigned xb_xcc_id() { return (unsigned)__builtin_amdgcn_s_getreg((3 << 11) | 20) & 0xFu; }
#define XB_SPIN(cond, bar) do { unsigned _sp = 0; while (cond) { __builtin_amdgcn_s_sleep(1); \
    if ((++_sp & 255u) == 0u) { if (xb_ld(&(bar)[XB_TMO])) break; if (_sp > XB_SPIN_CAP) { atomicAdd(&(bar)[XB_TMO], 1u); break; } } } } while (0)

struct XcdBarrier {
    unsigned* bar; unsigned x;
    volatile LAS unsigned* st;
};

__device__ __forceinline__ XcdBarrier xcd_barrier_post(unsigned* bar, volatile LAS unsigned* st) {
    XcdBarrier b; b.bar = bar; b.x = xb_xcc_id(); b.st = st;
    if (threadIdx.x == 0) (void)xb_add(&bar[XB_XCNT(b.x)], 1u);
    return b;
}
__device__ __forceinline__ void xcd_barrier_complete(unsigned* bar, unsigned x, unsigned& nloc, unsigned& nx) {
    const unsigned G = gridDim.x * gridDim.y * gridDim.z;
    unsigned sum, cnt, mine, sp = 0u;
    for (;;) {
        sum = 0u; cnt = 0u; mine = 0u;
#pragma unroll
        for (unsigned j = 0; j < 16; ++j) { const unsigned c = xb_ld(&bar[XB_XCNT(j)]); sum += c; cnt += (c > 0u) ? 1u : 0u; mine = (j == x) ? c : mine; }
        if (sum == G) break;
        __builtin_amdgcn_s_sleep(1);
        if ((++sp & 255u) == 0u) { if (xb_ld(&bar[XB_TMO])) break; if (sp > XB_SPIN_CAP) { atomicAdd(&bar[XB_TMO], 1u); break; } }
    }
    nloc = mine > 0u ? mine : 1u; nx = cnt > 0u ? cnt : 1u;
}

__device__ __forceinline__ void xcd_barrier(const XcdBarrier& b) {
    asm volatile("s_waitcnt vmcnt(0)" ::: "memory");
    __syncthreads();
    if (threadIdx.x == 0) {
        unsigned* bar = b.bar;
        __builtin_amdgcn_s_waitcnt(0);
        unsigned nloc = b.st[0], nx = b.st[1];
        if (nloc == 0u) { xcd_barrier_complete(bar, b.x, nloc, nx); b.st[0] = nloc; b.st[1] = nx; }
        const unsigned old = xb_add(&bar[XB_XSUB(b.x)], 1u);
        const unsigned gen = old / nloc;
        if (old + 1u == (gen + 1u) * nloc) {
            __builtin_amdgcn_fence(__ATOMIC_RELEASE, "agent");
            asm volatile("s_waitcnt vmcnt(0)" ::: "memory");
            const unsigned og = xb_add(&bar[XB_TOP], 1u);
            const unsigned tg = og / nx;
            if (og + 1u == (tg + 1u) * nx) xb_add(&bar[XB_TOPGEN], 1u);
            else XB_SPIN(xb_ld(&bar[XB_TOPGEN]) == tg, bar);
            __builtin_amdgcn_fence(__ATOMIC_ACQUIRE, "agent");
            xb_add(&bar[XB_XGEN(b.x)], 1u);
            asm volatile("s_waitcnt vmcnt(0)" ::: "memory");
        } else {
            XB_SPIN(xb_ld(&bar[XB_XGEN(b.x)]) == gen, bar);
            __builtin_amdgcn_fence(__ATOMIC_ACQUIRE, "agent");
            asm volatile("s_waitcnt vmcnt(0)" ::: "memory");
        }
    }
    __syncthreads();
}

constexpr int NPL = 10;
constexpr int NPHASES = 2 + 2 * NPL;
#ifndef PROBE_DUP
#define PROBE_DUP (-1)
#endif
__global__ void __launch_bounds__(NTHREADS, 2) hybrid_step_megakernel(Params p) {
    extern __shared__ __attribute__((aligned(16))) unsigned char lds[];
    cg::grid_group grid = cg::this_grid();
    if (threadIdx.x < 34) ((LAS cfp_t*)(lds + LDS_TAB))[threadIdx.x] = (cfp_t)p.in[threadIdx.x];
    __syncthreads();
    volatile LAS unsigned* bst = (volatile LAS unsigned*)(lds + LDS_TAB + 512);
    XcdBarrier xbar; xbar.bar = nullptr; xbar.x = 0; xbar.st = bst;
#pragma unroll 1
    for (int pi = 0; pi < NPHASES + (PROBE_DUP >= 0 ? 1 : 0); ++pi) {
        const int ph = (PROBE_DUP >= 0 && pi > PROBE_DUP) ? pi - 1 : pi; const bool rep = PROBE_DUP >= 0 && pi == PROBE_DUP + 1;
        const int l = ph < 2 ? 0 : (ph - 2) / NPL, k = ph < 2 ? ph : 2 + (ph - 2) % NPL;
#define FRAME() int zv, zs; asm volatile("v_mov_b32 %0, 0" : "=v"(zv)); asm volatile("s_mov_b32 %0, 0" : "=s"(zs)); Frame F; \
        F.lds = lds; F.ws = p.ws + zs; F.out = p.out + zs; F.in = (const LAS cfp_t*)(lds + LDS_TAB); \
        F.tid = threadIdx.x + zv; F.lane = F.tid & 63; F.wave = __builtin_amdgcn_readfirstlane(F.tid >> 6); \
        F.G = gridDim.x; F.bid = blockIdx.x + zs; F.vcu = (F.bid % 8) * (F.G / 8) + F.bid / 8;
        switch (k) {
            case 0: { FRAME(); if (F.bid == 0) { for (int i = F.tid; i < XCD_BAR_WORDS; i += NTHREADS) ((unsigned*)(F.ws + WS_CTL))[i] = 0u; } phase0_mod_rope(F); convert_weights(F, 0); } break;
            case 1: { FRAME(); phase0_h(F); } break;
            case 2: { FRAME(); phase_g1(F, l); } break;
            case 3: { FRAME(); phase_rnn_prep(F, l, !rep); } break;
            case 4: { FRAME(); phase_g2(F); } break;
            case 5: { FRAME(); phase_mla(F); } break;
            case 6: { FRAME(); phase_g3(F, l); } break;
            case 7: { FRAME(); phase_diff(F, l); } break;
            case 8: { FRAME(); phase_g4(F); } break;
            case 9: { FRAME(); phase_g5(F); } break;
            case 10: { FRAME(); phase_g6(F); } break;
            default: { FRAME(); phase_post(F, l); if (l == 0) convert_weights(F, 1); } break;
        }
#undef FRAME
        if (pi == 0) {
            grid.sync();
            if (threadIdx.x == 0) { bst[0] = 0u; bst[1] = 0u; }
            __syncthreads();
            xbar = xcd_barrier_post((unsigned*)(p.ws + WS_CTL), bst);
        } else if (pi + 1 < NPHASES + (PROBE_DUP >= 0 ? 1 : 0)) xcd_barrier(xbar);
    }
}

extern "C" void kernel_launch(void* const* d_in, const int* in_sizes, int n_in, void* d_out, int out_size, void* d_ws, size_t ws_size, hipStream_t stream) {
    static int grid = 0;
    if (grid == 0) {
        if (n_in != 34 || out_size != (int)O_TOTAL || ws_size < WS_END) { fprintf(stderr, "kernel_launch: unexpected shapes: n_in %d out %d ws %zu (need >= %zu)\n", n_in, out_size, ws_size, (size_t)WS_END); grid = -1; return; }
        int dev = 0, cus = 0, per_cu = 0;
        if (hipGetDevice(&dev) != hipSuccess || hipDeviceGetAttribute(&cus, hipDeviceAttributeMultiprocessorCount, dev) != hipSuccess) { grid = -1; return; }
        if (hipFuncSetAttribute((const void*)hybrid_step_megakernel, hipFuncAttributeMaxDynamicSharedMemorySize, LDS_BYTES) != hipSuccess) { fprintf(stderr, "kernel_launch: hipFuncSetAttribute failed\n"); grid = -1; return; }
        if (hipOccupancyMaxActiveBlocksPerMultiprocessor(&per_cu, (const void*)hybrid_step_megakernel, NTHREADS, LDS_BYTES) != hipSuccess || per_cu < 1) { fprintf(stderr, "kernel_launch: occupancy query says %d blocks/CU\n", per_cu); per_cu = 1; }
        (void)hipGetLastError();
        grid = cus;
        if (grid != 256) fprintf(stderr, "kernel_launch: %d CUs (expected 256)\n", grid);
    }
    if (grid < 0) return;
    Params p{};
    for (int i = 0; i < 34; ++i) p.in[i] = (const float*)d_in[i];
    p.out = (float*)d_out; p.ws = (unsigned char*)d_ws;
    void* args[] = {&p};
    hipError_t e = hipLaunchCooperativeKernel((const void*)hybrid_step_megakernel, dim3(grid), dim3(NTHREADS), args, LDS_BYTES, stream);
    if (e != hipSuccess) fprintf(stderr, "kernel_launch: cooperative launch failed: %s (grid %d)\n", hipGetErrorString(e), grid);
}
```
